# Optimizing an MI355X kernel written in HIP

```python
import math
import jax
import jax.numpy as jnp
from jax import lax
import numpy as np

D_MODEL = 1024
BATCH = 8
SEQ = 4096
DEPTH = 2

GRID_W = 64
CTX_LEN = 256
HEAD_DIM = 64
ROPE_THETA = 10000.0
NORM_EPS = 1e-6
Q_BLOCK = 128
NEG_INF = -1e30
ADA_CHUNKS = 6

NA_HEADS = 8
NA_WIN_H = 8
NA_WIN_W = 16
DIFF_HEADS = 4
DIFF_V_DIM = 2 * HEAD_DIM
GQA_Q_HEADS = 8
GQA_KV_HEADS = 2
GQA_GROUP = GQA_Q_HEADS // GQA_KV_HEADS
MLA_HEADS = 8
MLA_NOPE = 64
MLA_ROPE = 32
MLA_QK = MLA_NOPE + MLA_ROPE
MLA_V = 64
MLA_Q_RANK = 256
MLA_KV_RANK = 128
D_FF = 2816
N_EXPERTS = 8
TOP_K = 2
D_FF_EXPERT = 3584
MOE_BLOCK = 128

N_EVEN = (DEPTH + 1) // 2
N_ODD = DEPTH // 2

EVEN_COLS = (NA_HEADS * HEAD_DIM, NA_HEADS * HEAD_DIM, NA_HEADS * HEAD_DIM,
             DIFF_HEADS * 2 * HEAD_DIM, DIFF_HEADS * 2 * HEAD_DIM, DIFF_HEADS * DIFF_V_DIM)
ODD_COLS = (GQA_Q_HEADS * HEAD_DIM, GQA_KV_HEADS * HEAD_DIM, GQA_KV_HEADS * HEAD_DIM,
            MLA_Q_RANK, MLA_KV_RANK, MLA_ROPE)
EVEN_IN = sum(EVEN_COLS)
ODD_IN = sum(ODD_COLS)
EVEN_SPLITS = tuple(int(s) for s in np.cumsum(EVEN_COLS)[:-1])
ODD_SPLITS = tuple(int(s) for s in np.cumsum(ODD_COLS)[:-1])
EVEN_OUT = NA_HEADS * HEAD_DIM + DIFF_HEADS * DIFF_V_DIM
ODD_OUT = GQA_Q_HEADS * HEAD_DIM + MLA_HEADS * MLA_V

kernel_name = 'hybrid_na_diff_gqa_mla_moe_dit'


def rms_norm(x, g):
    xf = x.astype(jnp.float32)
    y = xf * lax.rsqrt(jnp.mean(xf * xf, axis=-1, keepdims=True) + NORM_EPS)
    return (y * g.astype(jnp.float32)).astype(x.dtype)


def modulate(h, shift, scale):
    return h * (1.0 + scale) + shift


def rope_1d(x, pos):
    half = x.shape[-1] // 2
    freqs = ROPE_THETA ** (-jnp.arange(half, dtype=jnp.float32) / half)
    ang = pos.astype(jnp.float32)[:, None] * freqs[None, :]
    cos = jnp.cos(ang).astype(x.dtype)
    sin = jnp.sin(ang).astype(x.dtype)
    x1, x2 = x[..., :half], x[..., half:]
    return jnp.concatenate([x1 * cos - x2 * sin, x1 * sin + x2 * cos], axis=-1)


def rope_2d(x, rows, cols):
    half = x.shape[-1] // 2
    return jnp.concatenate([rope_1d(x[..., :half], rows), rope_1d(x[..., half:], cols)], axis=-1)


def split_heads(t, n_heads, d):
    B, S, _ = t.shape
    return t.reshape(B, S, n_heads, d).transpose(0, 2, 1, 3)


def merge_heads(o):
    B, S = o.shape[0], o.shape[-2]
    return jnp.moveaxis(o, -2, 1).reshape(B, S, -1)


def over_query_blocks(fn, q):
    *lead, S, d = q.shape
    nb = S // Q_BLOCK
    qb = jnp.moveaxis(q.reshape(*lead, nb, Q_BLOCK, d), -3, 0)
    ob = jnp.moveaxis(lax.map(fn, qb), 0, -3)
    return ob.reshape(*ob.shape[:-3], S, ob.shape[-1])


def softmax_attend(q, k, v, scale):
    s = jnp.einsum('bhgqd,bhkd->bhgqk', q, k).astype(jnp.float32) * scale
    p = jax.nn.softmax(s, axis=-1).astype(v.dtype)
    return jnp.einsum('bhgqk,bhkd->bhgqd', p, v)


def diff_attend(q, k, v, lam, scale):
    s = jnp.einsum('bhmqd,bhmkd->bhmqk', q, k).astype(jnp.float32) * scale
    p = jax.nn.softmax(s, axis=-1)
    pd = (p[:, :, 0] - lam * p[:, :, 1]).astype(v.dtype)
    return jnp.einsum('bhqk,bhkd->bhqd', pd, v)


def neighbourhood_attention(q, k, v, k_ctx, v_ctx, rpb, scale):
    B, H, S, d = q.shape
    rows_n = S // GRID_W
    kh = min(NA_WIN_H, rows_n)
    qg = q.reshape(B, H, rows_n, GRID_W, d)
    kg = k.reshape(B, H, rows_n, GRID_W, d)
    vg = v.reshape(B, H, rows_n, GRID_W, d)
    col = jnp.arange(GRID_W)
    c0 = jnp.clip(col - NA_WIN_W // 2, 0, GRID_W - NA_WIN_W)
    col_in = (col[None, :] >= c0[:, None]) & (col[None, :] < c0[:, None] + NA_WIN_W)
    mask = jnp.broadcast_to(col_in[:, None, :], (GRID_W, kh, GRID_W)).reshape(GRID_W, kh * GRID_W)
    dc = jnp.clip(col[None, :] - col[:, None], -(NA_WIN_W - 1), NA_WIN_W - 1) + NA_WIN_W - 1
    n_lat = kh * GRID_W

    def one_row(r):
        r0 = jnp.clip(r - kh // 2, 0, rows_n - kh)
        kb = lax.dynamic_slice_in_dim(kg, r0, kh, axis=2).reshape(B, H, n_lat, d)
        vb = lax.dynamic_slice_in_dim(vg, r0, kh, axis=2).reshape(B, H, n_lat, d)
        qr = lax.dynamic_index_in_dim(qg, r, axis=2, keepdims=False)
        dr = r0 + jnp.arange(kh) - r + NA_WIN_H - 1
        bias = rpb[:, dr[None, :, None], dc[:, None, :]].reshape(H, GRID_W, n_lat)
        s_lat = jnp.einsum('bhqd,bhkd->bhqk', qr, kb).astype(jnp.float32) * scale + bias.astype(jnp.float32)
        s_lat = jnp.where(mask, s_lat, NEG_INF)
        s_ctx = jnp.einsum('bhqd,bhkd->bhqk', qr, k_ctx).astype(jnp.float32) * scale
        p = jax.nn.softmax(jnp.concatenate([s_lat, s_ctx], axis=-1), axis=-1).astype(v.dtype)
        return (jnp.einsum('bhqk,bhkd->bhqd', p[..., :n_lat], vb)
                + jnp.einsum('bhqk,bhkd->bhqd', p[..., n_lat:], v_ctx))

    o = lax.map(one_row, jnp.arange(rows_n))
    return jnp.moveaxis(o, 0, 2).reshape(B, H, S, d)


def even_project(t, w_in, na_q_g, na_k_g, diff_q_g, diff_k_g):
    B, S, _ = t.shape
    qa, ka, va, qb, kb, vb = jnp.split(t @ w_in, EVEN_SPLITS, axis=-1)
    qa = rms_norm(split_heads(qa, NA_HEADS, HEAD_DIM), na_q_g)
    ka = rms_norm(split_heads(ka, NA_HEADS, HEAD_DIM), na_k_g)
    va = split_heads(va, NA_HEADS, HEAD_DIM)
    qb = rms_norm(qb.reshape(B, S, DIFF_HEADS, 2, HEAD_DIM).transpose(0, 2, 3, 1, 4), diff_q_g)
    kb = rms_norm(kb.reshape(B, S, DIFF_HEADS, 2, HEAD_DIM).transpose(0, 2, 3, 1, 4), diff_k_g)
    vb = split_heads(vb, DIFF_HEADS, DIFF_V_DIM)
    return qa, ka, va, qb, kb, vb


def even_mixer(h, hc, w_in, w_out, na_q_g, na_k_g, na_rpb, diff_q_g, diff_k_g,
               lq1, lk1, lq2, lk2, subln_g, layer_idx, need_ctx):
    S = h.shape[1]
    pos = jnp.arange(S)
    rows, cols = pos // GRID_W, pos % GRID_W
    scale = HEAD_DIM ** -0.5
    lam_init = 0.8 - 0.6 * math.exp(-0.3 * layer_idx)
    lam = (jnp.exp(jnp.sum(lq1.astype(jnp.float32) * lk1.astype(jnp.float32)))
           - jnp.exp(jnp.sum(lq2.astype(jnp.float32) * lk2.astype(jnp.float32))) + lam_init)
    qa, ka, va, qb, kb, vb = even_project(h, w_in, na_q_g, na_k_g, diff_q_g, diff_k_g)
    qca, kca, vca, qcb, kcb, vcb = even_project(hc, w_in, na_q_g, na_k_g, diff_q_g, diff_k_g)
    out_a = neighbourhood_attention(qa, ka, va, kca, vca, na_rpb, scale)
    qb = rope_2d(qb, rows, cols)
    kb = rope_2d(kb, rows, cols)
    kb_all = jnp.concatenate([kb, kcb], axis=3)
    vb_all = jnp.concatenate([vb, vcb], axis=2)
    out_b = over_query_blocks(lambda qi: diff_attend(qi, kb_all, vb_all, lam, scale), qb)
    out_b = rms_norm(out_b, subln_g) * (1.0 - lam_init)
    y = jnp.concatenate([merge_heads(out_a), merge_heads(out_b)], axis=-1) @ w_out
    if not need_ctx:
        return y, None
    oca = softmax_attend(qca[:, :, None], kca, vca, scale)[:, :, 0]
    ocb = rms_norm(diff_attend(qcb, kcb, vcb, lam, scale), subln_g) * (1.0 - lam_init)
    yc = jnp.concatenate([merge_heads(oca), merge_heads(ocb)], axis=-1) @ w_out
    return y, yc


def odd_project(t, w_in, gqa_q_g, gqa_k_g, cq_g, w_uq, ckv_g, w_ukv, mla_q_g, mla_k_g):
    B, S, _ = t.shape
    qc, kc, vc, cq, ckv, kr = jnp.split(t @ w_in, ODD_SPLITS, axis=-1)
    qc = rms_norm(qc.reshape(B, S, GQA_KV_HEADS, GQA_GROUP, HEAD_DIM).transpose(0, 2, 3, 1, 4), gqa_q_g)
    kc = rms_norm(split_heads(kc, GQA_KV_HEADS, HEAD_DIM), gqa_k_g)
    vc = split_heads(vc, GQA_KV_HEADS, HEAD_DIM)
    qd = split_heads(rms_norm(cq, cq_g) @ w_uq, MLA_HEADS, MLA_QK)
    kv = split_heads(rms_norm(ckv, ckv_g) @ w_ukv, MLA_HEADS, MLA_NOPE + MLA_V)
    kr = jnp.broadcast_to(split_heads(kr, 1, MLA_ROPE), (B, MLA_HEADS, S, MLA_ROPE))
    kd = jnp.concatenate([kv[..., :MLA_NOPE], kr], axis=-1)
    vd = kv[..., MLA_NOPE:]
    return qc, kc, vc, rms_norm(qd, mla_q_g), rms_norm(kd, mla_k_g), vd


def odd_mixer(h, hc, w_in, w_out, gqa_q_g, gqa_k_g, cq_g, w_uq, ckv_g, w_ukv, mla_q_g, mla_k_g, need_ctx):
    S = h.shape[1]
    pos = jnp.arange(S)
    rows, cols = pos // GRID_W, pos % GRID_W
    qc, kc, vc, qd, kd, vd = odd_project(h, w_in, gqa_q_g, gqa_k_g, cq_g, w_uq, ckv_g, w_ukv, mla_q_g, mla_k_g)
    qcc, kcc, vcc, qcd, kcd, vcd = odd_project(hc, w_in, gqa_q_g, gqa_k_g, cq_g, w_uq, ckv_g, w_ukv, mla_q_g, mla_k_g)
    scale_c = HEAD_DIM ** -0.5
    qc = rope_2d(qc, rows, cols)
    kc_all = jnp.concatenate([rope_2d(kc, rows, cols), kcc], axis=2)
    vc_all = jnp.concatenate([vc, vcc], axis=2)
    out_c = over_query_blocks(lambda qi: softmax_attend(qi, kc_all, vc_all, scale_c), qc)
    scale_d = MLA_QK ** -0.5

    def rope_mla(t):
        return jnp.concatenate([t[..., :MLA_NOPE], rope_2d(t[..., MLA_NOPE:], rows, cols)], axis=-1)

    qd = rope_mla(qd)[:, :, None]
    kd_all = jnp.concatenate([rope_mla(kd), kcd], axis=2)
    vd_all = jnp.concatenate([vd, vcd], axis=2)
    out_d = over_query_blocks(lambda qi: softmax_attend(qi, kd_all, vd_all, scale_d), qd)
    y = jnp.concatenate([merge_heads(out_c), merge_heads(out_d)], axis=-1) @ w_out
    if not need_ctx:
        return y, None
    occ = softmax_attend(qcc, kcc, vcc, scale_c)
    ocd = softmax_attend(qcd[:, :, None], kcd, vcd, scale_d)
    yc = jnp.concatenate([merge_heads(occ), merge_heads(ocd)], axis=-1) @ w_out
    return y, yc


def swiglu(h, w_gate, w_up, w_down):
    return (jax.nn.silu(h @ w_gate) * (h @ w_up)) @ w_down


def moe_swiglu(h, router, w1, w3, w2):
    B, S, D = h.shape
    t = h.reshape(-1, D)
    N = t.shape[0]
    logits = (t @ router).astype(jnp.float32)
    top_val, top_idx = lax.top_k(logits, TOP_K)
    gates = jax.nn.softmax(top_val, axis=-1)
    flat_e = top_idx.reshape(-1)
    flat_tok = jnp.repeat(jnp.arange(N), TOP_K)
    flat_g = gates.reshape(-1)
    order = jnp.argsort(flat_e)
    e_sorted, tok_sorted, g_sorted = flat_e[order], flat_tok[order], flat_g[order]
    counts = jnp.bincount(flat_e, length=N_EXPERTS)
    padded = ((counts + MOE_BLOCK - 1) // MOE_BLOCK) * MOE_BLOCK
    bounds = jnp.cumsum(padded)
    pad_start = bounds - padded
    start = jnp.cumsum(counts) - counts
    dest = pad_start[e_sorted] + jnp.arange(N * TOP_K) - start[e_sorted]
    cap = (-(-(N * TOP_K) // MOE_BLOCK)) * MOE_BLOCK + N_EXPERTS * MOE_BLOCK
    nb = cap // MOE_BLOCK
    slot_tok = jnp.zeros((cap,), jnp.int32).at[dest].set(tok_sorted.astype(jnp.int32))
    slot_g = jnp.zeros((cap,), jnp.float32).at[dest].set(g_sorted)
    block_e = jnp.minimum(jnp.sum(jnp.arange(nb)[:, None] * MOE_BLOCK >= bounds[None, :], axis=1), N_EXPERTS - 1)
    xb = t[slot_tok].reshape(nb, MOE_BLOCK, D)

    def one_block(args):
        xi, e = args
        return (jax.nn.silu(xi @ w1[e]) * (xi @ w3[e])) @ w2[e]

    yb = lax.map(one_block, (xb, block_e)).reshape(cap, D)
    out = jnp.zeros_like(t).at[slot_tok].add(yb * slot_g[:, None].astype(yb.dtype))
    return out.reshape(B, S, D)


def setup_inputs(seed: int = 0) -> dict:
    key = jax.random.key(seed)
    keys = iter(jax.random.split(key, 48))

    def normal(shape, scale):
        return jax.random.normal(next(keys), shape, dtype=jnp.float32) * scale

    def gain(shape):
        return 1.0 + normal(shape, 0.05)

    D = D_MODEL
    return {
        'x': normal((BATCH, SEQ, D), 1.0),
        'c': normal((BATCH, D), 1.0),
        'ctx': normal((BATCH, CTX_LEN, D), 1.0),
        'c_ctx': normal((D,), 1.0),
        'ada_w': normal((DEPTH, D, ADA_CHUNKS * D), 0.5 * D ** -0.5),
        'ada_b': normal((DEPTH, ADA_CHUNKS * D), 0.02),
        'norm1_g': gain((DEPTH, D)),
        'norm2_g': gain((DEPTH, D)),
        'ev_w_in': normal((N_EVEN, D, EVEN_IN), D ** -0.5),
        'ev_w_out': normal((N_EVEN, EVEN_OUT, D), EVEN_OUT ** -0.5),
        'na_q_g': gain((N_EVEN, HEAD_DIM)),
        'na_k_g': gain((N_EVEN, HEAD_DIM)),
        'na_rpb': normal((N_EVEN, NA_HEADS, 2 * NA_WIN_H - 1, 2 * NA_WIN_W - 1), 0.1),
        'diff_q_g': gain((N_EVEN, HEAD_DIM)),
        'diff_k_g': gain((N_EVEN, HEAD_DIM)),
        'diff_lq1': normal((N_EVEN, HEAD_DIM), 0.1),
        'diff_lk1': normal((N_EVEN, HEAD_DIM), 0.1),
        'diff_lq2': normal((N_EVEN, HEAD_DIM), 0.1),
        'diff_lk2': normal((N_EVEN, HEAD_DIM), 0.1),
        'diff_subln_g': gain((N_EVEN, DIFF_V_DIM)),
        'ffn_w_gate': normal((N_EVEN, D, D_FF), D ** -0.5),
        'ffn_w_up': normal((N_EVEN, D, D_FF), D ** -0.5),
        'ffn_w_down': normal((N_EVEN, D_FF, D), D_FF ** -0.5),
        'od_w_in': normal((N_ODD, D, ODD_IN), D ** -0.5),
        'od_w_out': normal((N_ODD, ODD_OUT, D), ODD_OUT ** -0.5),
        'gqa_q_g': gain((N_ODD, HEAD_DIM)),
        'gqa_k_g': gain((N_ODD, HEAD_DIM)),
        'mla_cq_g': gain((N_ODD, MLA_Q_RANK)),
        'mla_w_uq': normal((N_ODD, MLA_Q_RANK, MLA_HEADS * MLA_QK), MLA_Q_RANK ** -0.5),
        'mla_ckv_g': gain((N_ODD, MLA_KV_RANK)),
        'mla_w_ukv': normal((N_ODD, MLA_KV_RANK, MLA_HEADS * (MLA_NOPE + MLA_V)), MLA_KV_RANK ** -0.5),
        'mla_q_g': gain((N_ODD, MLA_QK)),
        'mla_k_g': gain((N_ODD, MLA_QK)),
        'moe_router': normal((N_ODD, D, N_EXPERTS), D ** -0.5),
        'moe_w1': normal((N_ODD, N_EXPERTS, D, D_FF_EXPERT), D ** -0.5),
        'moe_w3': normal((N_ODD, N_EXPERTS, D, D_FF_EXPERT), D ** -0.5),
        'moe_w2': normal((N_ODD, N_EXPERTS, D_FF_EXPERT, D), D_FF_EXPERT ** -0.5),
    }


def reference(x, c, ctx, c_ctx, ada_w, ada_b, norm1_g, norm2_g,
              ev_w_in, ev_w_out, na_q_g, na_k_g, na_rpb, diff_q_g, diff_k_g,
              diff_lq1, diff_lk1, diff_lq2, diff_lk2, diff_subln_g,
              ffn_w_gate, ffn_w_up, ffn_w_down,
              od_w_in, od_w_out, gqa_q_g, gqa_k_g, mla_cq_g, mla_w_uq, mla_ckv_g, mla_w_ukv,
              mla_q_g, mla_k_g, moe_router, moe_w1, moe_w3, moe_w2):
    xc = ctx
    silu_c = jax.nn.silu(c)
    silu_cc = jax.nn.silu(c_ctx)
    for l in range(DEPTH):
        need_ctx = l < DEPTH - 1
        i = l // 2
        even = l % 2 == 0
        sh1, sc1, g1, sh2, sc2, g2 = jnp.split((silu_c @ ada_w[l] + ada_b[l])[:, None, :], ADA_CHUNKS, axis=-1)
        csh1, csc1, cg1, csh2, csc2, cg2 = jnp.split(silu_cc @ ada_w[l] + ada_b[l], ADA_CHUNKS, axis=-1)
        h = modulate(rms_norm(x, norm1_g[l]), sh1, sc1)
        hc = modulate(rms_norm(xc, norm1_g[l]), csh1, csc1)
        if even:
            y, yc = even_mixer(h, hc, ev_w_in[i], ev_w_out[i], na_q_g[i], na_k_g[i], na_rpb[i],
                               diff_q_g[i], diff_k_g[i], diff_lq1[i], diff_lk1[i], diff_lq2[i], diff_lk2[i],
                               diff_subln_g[i], l, need_ctx)
        else:
            y, yc = odd_mixer(h, hc, od_w_in[i], od_w_out[i], gqa_q_g[i], gqa_k_g[i], mla_cq_g[i], mla_w_uq[i],
                              mla_ckv_g[i], mla_w_ukv[i], mla_q_g[i], mla_k_g[i], need_ctx)

        def channel_mix(t):
            if even:
                return swiglu(t, ffn_w_gate[i], ffn_w_up[i], ffn_w_down[i])
            return moe_swiglu(t, moe_router[i], moe_w1[i], moe_w3[i], moe_w2[i])

        x = x + g1 * y
        x = x + g2 * channel_mix(modulate(rms_norm(x, norm2_g[l]), sh2, sc2))
        if need_ctx:
            xc = xc + cg1 * yc
            xc = xc + cg2 * channel_mix(modulate(rms_norm(xc, norm2_g[l]), csh2, csc2))
    return x
```

```cpp
#include <hip/hip_runtime.h>
#include <cstdint>
#include <cstdio>
#include <cstring>
#include <cmath>
namespace nv {
constexpr int D = 1024, NB = 8, S = 4096, CL = 256, RB = S + CL;
constexpr int GW = 64;
constexpr float EPS = 1e-6f;

__device__ __forceinline__ float silu_f(float x) { return x / (1.f + expf(-x)); }

__global__ void nk_mod(const float* c, const float* c_ctx, const float* ada_w, const float* ada_b, float* mod) {
    __shared__ float sc[D];
    const int v = blockIdx.y, l = blockIdx.z, j = blockIdx.x * 256 + threadIdx.x;
    const float* cv = v < 8 ? c + v * D : c_ctx;
    for (int k = threadIdx.x; k < D; k += 256) sc[k] = silu_f(cv[k]);
    __syncthreads();
    const float* W = ada_w + (size_t)l * D * 6144;
    float acc = 0.f;
    for (int k = 0; k < D; ++k) acc += sc[k] * W[(size_t)k * 6144 + j];
    mod[((size_t)l * 9 + v) * 6144 + j] = acc + ada_b[l * 6144 + j];
}

__global__ void nk_normmod(const float* xlat, const float* xctx, const float* g, const float* modl, int b, int sh_chunk, float* out, int nrows_lat) {
    const int row = blockIdx.x, t = threadIdx.x;
    const float* src; int v;
    if (row < nrows_lat) { src = xlat + (size_t)row * D; v = b; } else { src = xctx + (size_t)(row - nrows_lat) * D; v = 8; }
    if (b < 0) v = row / S;
    float x[4]; float ss = 0.f;
    for (int i = 0; i < 4; ++i) { x[i] = src[t + 256 * i]; ss += x[i] * x[i]; }
    __shared__ float red[256];
    red[t] = ss; __syncthreads();
    for (int o = 128; o > 0; o >>= 1) { if (t < o) red[t] += red[t + o]; __syncthreads(); }
    const float rstd = rsqrtf(red[0] / D + EPS);
    const float* sh = modl + (size_t)v * 6144 + sh_chunk * D; const float* sc = sh + D;
    for (int i = 0; i < 4; ++i) { const int col = t + 256 * i; out[(size_t)row * D + col] = x[i] * rstd * g[col] * (1.f + sc[col]) + sh[col]; }
}

struct GP {
    const float* A; const int* rowidx; const int* oidx;
    const float* B; const float* B2;
    const int* tile_e;
    float* C;
    const float* base; const float* gate;
    const float* slot_g; const float* modl;
    size_t estride;
    int lda, ldb, ldc, M, N, K, gchunk, pad;
};
template <int EPI> __global__ void __launch_bounds__(256) nk_gemm(GP p) {
    __shared__ float As[16][68], Bs[16][68], Bs2[EPI == 2 ? 16 : 1][68];
    const int t = threadIdx.x, tx = t & 15, ty = t >> 4;
    const int row0 = blockIdx.y * 64, col0 = blockIdx.x * 64;
    const float* B = p.B; const float* B2 = p.B2;
    if (p.tile_e) { const int e = p.tile_e[blockIdx.y]; if (e < 0) return; B += (size_t)e * p.estride; if (EPI == 2) B2 += (size_t)e * p.estride; }
    const int ar = t >> 2, ak = (t & 3) * 4;
    int arow = row0 + ar; if (p.rowidx) { int ri = p.rowidx[arow]; arow = ri < 0 ? 0 : ri; }
    const float* Ap = p.A + (size_t)arow * p.lda + ak;
    const int bk = t >> 4, bc = (t & 15) * 4;
    const bool bok = (col0 + bc) < p.N;
    float acc[4][4] = {}, acc2[4][4] = {};
    for (int k0 = 0; k0 < p.K; k0 += 16) {
        const float4 av = *(const float4*)(Ap + k0);
        As[ak + 0][ar] = av.x; As[ak + 1][ar] = av.y; As[ak + 2][ar] = av.z; As[ak + 3][ar] = av.w;
        float4 bv = bok ? *(const float4*)(B + (size_t)(k0 + bk) * p.ldb + col0 + bc) : make_float4(0, 0, 0, 0);
        Bs[bk][bc] = bv.x; Bs[bk][bc + 1] = bv.y; Bs[bk][bc + 2] = bv.z; Bs[bk][bc + 3] = bv.w;
        if (EPI == 2) { float4 b2 = bok ? *(const float4*)(B2 + (size_t)(k0 + bk) * p.ldb + col0 + bc) : make_float4(0, 0, 0, 0);
            Bs2[bk][bc] = b2.x; Bs2[bk][bc + 1] = b2.y; Bs2[bk][bc + 2] = b2.z; Bs2[bk][bc + 3] = b2.w; }
        __syncthreads();
#pragma unroll
        for (int kk = 0; kk < 16; ++kk) {
            float a[4], b[4], b2[4];
#pragma unroll
            for (int i = 0; i < 4; ++i) { a[i] = As[kk][ty * 4 + i]; b[i] = Bs[kk][tx * 4 + i]; if (EPI == 2) b2[i] = Bs2[kk][tx * 4 + i]; }
#pragma unroll
            for (int i = 0; i < 4; ++i)
#pragma unroll
                for (int j = 0; j < 4; ++j) { acc[i][j] += a[i] * b[j]; if (EPI == 2) acc2[i][j] += a[i] * b2[j]; }
        }
        __syncthreads();
    }
#pragma unroll
    for (int i = 0; i < 4; ++i) {
        const int r = row0 + ty * 4 + i;
        int orow = r; float sg = 1.f; int tokb = 0;
        if (EPI == 3) { orow = p.oidx[r]; if (orow < 0) continue; sg = p.slot_g[r]; tokb = orow / S; }
#pragma unroll
        for (int j = 0; j < 4; ++j) {
            const int col = col0 + tx * 4 + j; if (col >= p.N) continue;
            float* cp = p.C + (size_t)orow * p.ldc + col;
            if (EPI == 0) *cp = acc[i][j];
            else if (EPI == 1) *cp = p.base[(size_t)r * p.ldc + col] + p.gate[col] * acc[i][j];
            else if (EPI == 2) *cp = silu_f(acc[i][j]) * acc2[i][j];
            else *cp = *cp + p.modl[(size_t)tokb * 6144 + p.gchunk * D + col] * sg * acc[i][j];
        }
    }
}

__device__ __forceinline__ float rope_freq(int i, int half) { return powf(10000.f, -(float)i / (float)half); }
__device__ __forceinline__ void normrope(float* p, const float* g, int n, bool rope, int r0, int rn, int gr, int gc) {
    float ss = 0.f;
    for (int i = 0; i < n; ++i) ss += p[i] * p[i];
    const float rstd = rsqrtf(ss / n + EPS);
    for (int i = 0; i < n; ++i) p[i] = p[i] * rstd * g[i];
    if (rope) {
        const int hb = rn / 2, hh = rn / 4;
        for (int blk = 0; blk < 2; ++blk) {
            const float pos = (float)(blk == 0 ? gr : gc);
            for (int i = 0; i < hh; ++i) {
                const float ang = pos * rope_freq(i, hh);
                const float cs = cosf(ang), sn = sinf(ang);
                float* q = p + r0 + blk * hb;
                const float x1 = q[i], x2 = q[hh + i];
                q[i] = x1 * cs - x2 * sn; q[hh + i] = x1 * sn + x2 * cs;
            }
        }
    }
}
__global__ void nk_prep_even(float* P, const float* na_q_g, const float* na_k_g, const float* diff_q_g, const float* diff_k_g) {
    const int id = blockIdx.x * 256 + threadIdx.x; if (id >= RB * 32) return;
    const int row = id >> 5, seg = id & 31;
    float* p = P + (size_t)row * 3072 + (seg < 16 ? seg * 64 : 1536 + (seg - 16) * 64);
    const float* g = seg < 8 ? na_q_g : seg < 16 ? na_k_g : seg < 24 ? diff_q_g : diff_k_g;
    normrope(p, g, 64, seg >= 16 && row < S, 0, 64, row / GW, row % GW);
}
__global__ void nk_prep_odd(float* P, const float* gqa_q_g, const float* gqa_k_g, const float* cq_g, const float* ckv_g) {
    const int id = blockIdx.x * 256 + threadIdx.x; if (id >= RB * 12) return;
    const int row = id / 12, seg = id % 12;
    float* pr = P + (size_t)row * 1184;
    if (seg < 8) normrope(pr + seg * 64, gqa_q_g, 64, row < S, 0, 64, row / GW, row % GW);
    else if (seg < 10) normrope(pr + 512 + (seg - 8) * 64, gqa_k_g, 64, row < S, 0, 64, row / GW, row % GW);
    else if (seg == 10) normrope(pr + 768, cq_g, 256, false, 0, 0, 0, 0);
    else normrope(pr + 1024, ckv_g, 128, false, 0, 0, 0, 0);
}
__global__ void nk_prep_mla(float* QD, const float* KV, const float* P, float* KD, const float* mla_q_g, const float* mla_k_g) {
    const int id = blockIdx.x * 256 + threadIdx.x; if (id >= RB * 16) return;
    const int row = id >> 4, h = (id >> 1) & 7, which = id & 1;
    if (which == 0) normrope(QD + (size_t)row * 768 + h * 96, mla_q_g, 96, row < S, 64, 32, row / GW, row % GW);
    else {
        float* kd = KD + (size_t)row * 768 + h * 96;
        for (int i = 0; i < 64; ++i) kd[i] = KV[(size_t)row * 1024 + h * 128 + i];
        for (int i = 0; i < 32; ++i) kd[64 + i] = P[(size_t)row * 1184 + 1152 + i];
        normrope(kd, mla_k_g, 96, row < S, 64, 32, row / GW, row % GW);
    }
}

struct AP {
    const float* Q; const float* K; const float* V; float* O;
    int ldq, qcol0, qhs;
    int ldk, kcol0, khs, kgrp;
    int ldv, vcol0, vhs, vgrp;
    int ldo, ocol0, ohs;
    int q0; int ka0, na, kb0, nb; float scale;
};
template <int DK, int DV> __global__ void __launch_bounds__(64) nk_attn(AP p) {
    const int qrow = p.q0 + blockIdx.x * 64 + threadIdx.x, head = blockIdx.y;
    const float* qp = p.Q + (size_t)qrow * p.ldq + p.qcol0 + head * p.qhs;
    float q[DK], o[DV];
#pragma unroll
    for (int i = 0; i < DK; ++i) q[i] = qp[i] * p.scale;
#pragma unroll
    for (int i = 0; i < DV; ++i) o[i] = 0.f;
    float m = -INFINITY, l = 0.f;
    const int kc = p.kcol0 + (head / p.kgrp) * p.khs, vc = p.vcol0 + (head / p.vgrp) * p.vhs;
    for (int seg = 0; seg < 2; ++seg) {
        const int k0 = seg ? p.kb0 : p.ka0, n = seg ? p.nb : p.na;
        for (int j = 0; j < n; ++j) {
            const float* kp = p.K + (size_t)(k0 + j) * p.ldk + kc;
            const float* vp = p.V + (size_t)(k0 + j) * p.ldv + vc;
            float s = 0.f;
#pragma unroll
            for (int i = 0; i < DK; ++i) s += q[i] * kp[i];
            const float mn = fmaxf(m, s), al = expf(m - mn), pe = expf(s - mn);
            l = l * al + pe; m = mn;
#pragma unroll
            for (int i = 0; i < DV; ++i) o[i] = o[i] * al + pe * vp[i];
        }
    }
    float* op = p.O + (size_t)qrow * p.ldo + p.ocol0 + head * p.ohs;
    const float il = 1.f / l;
#pragma unroll
    for (int i = 0; i < DV; ++i) op[i] = o[i] * il;
}
__global__ void __launch_bounds__(64) nk_na(const float* P, const float* rpb, float* AO) {
    const int pos = blockIdx.x * 64 + threadIdx.x, h = blockIdx.y;
    const int r = pos / GW, c = pos % GW;
    int r0 = r - 4; r0 = r0 < 0 ? 0 : (r0 > 56 ? 56 : r0);
    int c0 = c - 8; c0 = c0 < 0 ? 0 : (c0 > 48 ? 48 : c0);
    const float* qp = P + (size_t)pos * 3072 + h * 64;
    float q[64], o[64];
#pragma unroll
    for (int i = 0; i < 64; ++i) { q[i] = qp[i] * 0.125f; o[i] = 0.f; }
    float m = -INFINITY, l = 0.f;
    for (int j = 0; j < 128 + CL; ++j) {
        int krow; float bias = 0.f;
        if (j < 128) { const int kr = r0 + (j >> 4), kc = c0 + (j & 15); krow = kr * GW + kc;
            int dc = kc - c; dc = dc < -15 ? -15 : (dc > 15 ? 15 : dc);
            bias = rpb[(h * 15 + (kr - r + 7)) * 31 + dc + 15]; }
        else krow = S + (j - 128);
        const float* kp = P + (size_t)krow * 3072 + 512 + h * 64;
        const float* vp = P + (size_t)krow * 3072 + 1024 + h * 64;
        float s = 0.f;
#pragma unroll
        for (int i = 0; i < 64; ++i) s += q[i] * kp[i];
        s += bias;
        const float mn = fmaxf(m, s), al = expf(m - mn), pe = expf(s - mn);
        l = l * al + pe; m = mn;
#pragma unroll
        for (int i = 0; i < 64; ++i) o[i] = o[i] * al + pe * vp[i];
    }
    float* op = AO + (size_t)pos * 1024 + h * 64;
    const float il = 1.f / l;
#pragma unroll
    for (int i = 0; i < 64; ++i) op[i] = o[i] * il;
}
__global__ void nk_diffcomb(const float* T, const float* lq1, const float* lk1, const float* lq2, const float* lk2, const float* subln_g, float lam_init, float* AO) {
    const int id = blockIdx.x * 256 + threadIdx.x; if (id >= RB * 4) return;
    const int row = id >> 2, h = id & 3;
    float s1 = 0.f, s2 = 0.f;
    for (int i = 0; i < 64; ++i) { s1 += lq1[i] * lk1[i]; s2 += lq2[i] * lk2[i]; }
    const float lam = expf(s1) - expf(s2) + lam_init;
    const float* o1 = T + ((size_t)row * 8 + h * 2) * 128; const float* o2 = o1 + 128;
    float ss = 0.f;
    for (int i = 0; i < 128; ++i) { const float o = o1[i] - lam * o2[i]; ss += o * o; }
    const float rstd = rsqrtf(ss / 128.f + EPS);
    float* op = AO + (size_t)row * 1024 + 512 + h * 128;
    for (int i = 0; i < 128; ++i) op[i] = (o1[i] - lam * o2[i]) * rstd * subln_g[i] * (1.f - lam_init);
}

__global__ void nk_router(const float* H2, const float* router, int* idx, float* gate, int ntok) {
    const int t = blockIdx.x * 256 + threadIdx.x; if (t >= ntok) return;
    float lg[8] = {};
    const float* h = H2 + (size_t)t * D;
    for (int k = 0; k < D; ++k) { const float x = h[k];
#pragma unroll
        for (int e = 0; e < 8; ++e) lg[e] += x * router[k * 8 + e]; }
    int i0 = 0; for (int e = 1; e < 8; ++e) if (lg[e] > lg[i0]) i0 = e;
    int i1 = -1; for (int e = 0; e < 8; ++e) if (e != i0 && (i1 < 0 || lg[e] > lg[i1])) i1 = e;
    const float e1 = expf(lg[i1] - lg[i0]);
    idx[t * 2] = i0; idx[t * 2 + 1] = i1; gate[t * 2] = 1.f / (1.f + e1); gate[t * 2 + 1] = e1 / (1.f + e1);
}
constexpr int MAXSLOT = 33280, MAXTILE = MAXSLOT / 64;
__global__ void __launch_bounds__(1024) nk_sort(const int* idx, const float* gate, int ntok, int* slot_tok, float* slot_g, int* tile_e) {
    __shared__ int cnt[16], start[16], cur[16];
    const int t = threadIdx.x;
    for (int i = t; i < 2 * MAXSLOT; i += 1024) { slot_tok[i] = -1; slot_g[i] = 0.f; }
    for (int i = t; i < 2 * MAXTILE; i += 1024) tile_e[i] = -1;
    if (t < 16) { cnt[t] = 0; cur[t] = 0; }
    __syncthreads();
    for (int i = t; i < ntok * 2; i += 1024) atomicAdd(&cnt[(i & 1) * 8 + idx[i]], 1);
    __syncthreads();
    if (t < 2) { int s = 0; for (int e = 0; e < 8; ++e) { start[t * 8 + e] = s; s += (cnt[t * 8 + e] + 63) / 64 * 64; } }
    __syncthreads();
    for (int i = t; i < ntok * 2; i += 1024) { const int c = i & 1, e = idx[i]; const int pos = start[c * 8 + e] + atomicAdd(&cur[c * 8 + e], 1);
        slot_tok[c * MAXSLOT + pos] = i >> 1; slot_g[c * MAXSLOT + pos] = gate[i]; }
    if (t < 16) { const int c = t >> 3, e = t & 7; const int t0 = start[t] / 64, nt = (cnt[t] + 63) / 64; for (int i = 0; i < nt; ++i) tile_e[c * MAXTILE + t0 + i] = e; }
}
}
namespace nv {
struct In {
    const float *x, *c, *ctx, *c_ctx, *ada_w, *ada_b, *norm1_g, *norm2_g, *ev_w_in, *ev_w_out, *na_q_g, *na_k_g, *na_rpb, *diff_q_g, *diff_k_g,
        *lq1, *lk1, *lq2, *lk2, *subln_g, *ffn_wg, *ffn_wu, *ffn_wd, *od_w_in, *od_w_out, *gqa_q_g, *gqa_k_g, *cq_g, *w_uq, *ckv_g, *w_ukv, *mla_q_g, *mla_k_g,
        *router, *w1, *w3, *w2;
};
static In make_in(void* const* d) {
    In I; const float** p = (const float**)&I; for (int i = 0; i < 37; ++i) p[i] = (const float*)d[i]; return I;
}
struct Bump { char* base; size_t off; void* get(size_t bytes) { void* r = base + off; off += (bytes + 1048575) & ~(size_t)1048575; return r; } };

template <int EPI> static void gemm(hipStream_t st, GP p) {
    dim3 grid((p.N + 63) / 64, p.M / 64);
    hipLaunchKernelGGL(nk_gemm<EPI>, grid, dim3(256), 0, st, p);
}
static void run(hipStream_t st, const In& I, float* X, char* ws, int nbatch, float* ckpt) {
    Bump bp{ws, 0};
    float* MOD = (float*)bp.get(2 * 9 * 6144 * 4);
    float* XC = (float*)bp.get((size_t)NB * CL * D * 4);
    float* Hb = (float*)bp.get((size_t)RB * D * 4);
    float* Pb = (float*)bp.get((size_t)RB * 3072 * 4);
    float* AOb = (float*)bp.get((size_t)RB * D * 4);
    float* Tb = (float*)bp.get((size_t)RB * 1024 * 4);
    float* QDb = (float*)bp.get((size_t)RB * 768 * 4);
    float* KDb = (float*)bp.get((size_t)RB * 768 * 4);
    float* MIDb = (float*)bp.get((size_t)RB * 2816 * 4);
    const int ntok = nbatch * S;
    hipMemcpyAsync(X, I.x, (size_t)ntok * D * 4, hipMemcpyDeviceToDevice, st);
    hipMemcpyAsync(XC, I.ctx, (size_t)nbatch * CL * D * 4, hipMemcpyDeviceToDevice, st);
    hipLaunchKernelGGL(nk_mod, dim3(24, 9, 2), dim3(256), 0, st, I.c, I.c_ctx, I.ada_w, I.ada_b, MOD);
    const size_t CK = (size_t)RB * D;
    for (int l = 0; l < 2; ++l) {
        const float* modl = MOD + (size_t)l * 9 * 6144;
        for (int b = 0; b < nbatch; ++b) {
            float* Xb = X + (size_t)b * S * D; float* XCb = XC + (size_t)b * CL * D;
            hipLaunchKernelGGL(nk_normmod, dim3(RB), dim3(256), 0, st, Xb, XCb, I.norm1_g + l * D, modl, b, 0, Hb, S);
            if (l == 0) {
                { GP p; memset(&p, 0, sizeof p); p.A = Hb; p.lda = D; p.B = I.ev_w_in; p.ldb = 3072; p.C = Pb; p.ldc = 3072; p.M = RB; p.N = 3072; p.K = D; gemm<0>(st, p); }
                hipLaunchKernelGGL(nk_prep_even, dim3(RB * 32 / 256), dim3(256), 0, st, Pb, I.na_q_g, I.na_k_g, I.diff_q_g, I.diff_k_g);
                hipLaunchKernelGGL(nk_na, dim3(S / 64, 8), dim3(64), 0, st, Pb, I.na_rpb, AOb);
                { AP a; memset(&a, 0, sizeof a); a.Q = Pb; a.ldq = 3072; a.qcol0 = 0; a.qhs = 64; a.K = Pb; a.ldk = 3072; a.kcol0 = 512; a.khs = 64; a.kgrp = 1; a.V = Pb; a.ldv = 3072; a.vcol0 = 1024; a.vhs = 64; a.vgrp = 1;
                  a.O = AOb; a.ldo = 1024; a.ocol0 = 0; a.ohs = 64; a.q0 = S; a.ka0 = 0; a.na = 0; a.kb0 = S; a.nb = CL; a.scale = 0.125f;
                  hipLaunchKernelGGL((nk_attn<64, 64>), dim3(CL / 64, 8), dim3(64), 0, st, a); }
                { AP a; memset(&a, 0, sizeof a); a.Q = Pb; a.ldq = 3072; a.qcol0 = 1536; a.qhs = 64; a.K = Pb; a.ldk = 3072; a.kcol0 = 2048; a.khs = 64; a.kgrp = 1; a.V = Pb; a.ldv = 3072; a.vcol0 = 2560; a.vhs = 128; a.vgrp = 2;
                  a.O = Tb; a.ldo = 1024; a.ocol0 = 0; a.ohs = 128; a.q0 = 0; a.ka0 = 0; a.na = S; a.kb0 = S; a.nb = CL; a.scale = 0.125f;
                  hipLaunchKernelGGL((nk_attn<64, 128>), dim3(S / 64, 8), dim3(64), 0, st, a);
                  a.q0 = S; a.na = 0;
                  hipLaunchKernelGGL((nk_attn<64, 128>), dim3(CL / 64, 8), dim3(64), 0, st, a); }
                hipLaunchKernelGGL(nk_diffcomb, dim3(RB * 4 / 256), dim3(256), 0, st, Tb, I.lq1, I.lk1, I.lq2, I.lk2, I.subln_g, 0.2f, AOb);
                if (ckpt && b == 0) hipMemcpyAsync(ckpt + 0 * CK, AOb, CK * 4, hipMemcpyDeviceToDevice, st);
                { GP p; memset(&p, 0, sizeof p); p.A = AOb; p.lda = D; p.B = I.ev_w_out; p.ldb = D; p.C = Xb; p.ldc = D; p.M = S; p.N = D; p.K = D; p.base = Xb; p.gate = modl + (size_t)b * 6144 + 2 * D; gemm<1>(st, p);
                  p.A = AOb + (size_t)S * D; p.C = XCb; p.base = XCb; p.M = CL; p.gate = modl + (size_t)8 * 6144 + 2 * D; gemm<1>(st, p); }
                if (ckpt && b == 0) { hipMemcpyAsync(ckpt + 1 * CK, Xb, (size_t)S * D * 4, hipMemcpyDeviceToDevice, st); hipMemcpyAsync(ckpt + 1 * CK + (size_t)S * D, XCb, (size_t)CL * D * 4, hipMemcpyDeviceToDevice, st); }
                hipLaunchKernelGGL(nk_normmod, dim3(RB), dim3(256), 0, st, Xb, XCb, I.norm2_g + l * D, modl, b, 3, Hb, S);
                { GP p; memset(&p, 0, sizeof p); p.A = Hb; p.lda = D; p.B = I.ffn_wg; p.B2 = I.ffn_wu; p.ldb = 2816; p.C = MIDb; p.ldc = 2816; p.M = RB; p.N = 2816; p.K = D; gemm<2>(st, p); }
                { GP p; memset(&p, 0, sizeof p); p.A = MIDb; p.lda = 2816; p.B = I.ffn_wd; p.ldb = D; p.C = Xb; p.ldc = D; p.M = S; p.N = D; p.K = 2816; p.base = Xb; p.gate = modl + (size_t)b * 6144 + 5 * D; gemm<1>(st, p);
                  p.A = MIDb + (size_t)S * 2816; p.C = XCb; p.base = XCb; p.M = CL; p.gate = modl + (size_t)8 * 6144 + 5 * D; gemm<1>(st, p); }
                if (ckpt && b == 0) { hipMemcpyAsync(ckpt + 2 * CK, Xb, (size_t)S * D * 4, hipMemcpyDeviceToDevice, st); hipMemcpyAsync(ckpt + 2 * CK + (size_t)S * D, XCb, (size_t)CL * D * 4, hipMemcpyDeviceToDevice, st); }
            } else {
                float* KVb = Tb;
                { GP p; memset(&p, 0, sizeof p); p.A = Hb; p.lda = D; p.B = I.od_w_in; p.ldb = 1184; p.C = Pb; p.ldc = 1184; p.M = RB; p.N = 1184; p.K = D; gemm<0>(st, p); }
                hipLaunchKernelGGL(nk_prep_odd, dim3((RB * 12 + 255) / 256), dim3(256), 0, st, Pb, I.gqa_q_g, I.gqa_k_g, I.cq_g, I.ckv_g);
                { GP p; memset(&p, 0, sizeof p); p.A = Pb + 768; p.lda = 1184; p.B = I.w_uq; p.ldb = 768; p.C = QDb; p.ldc = 768; p.M = RB; p.N = 768; p.K = 256; gemm<0>(st, p); }
                { GP p; memset(&p, 0, sizeof p); p.A = Pb + 1024; p.lda = 1184; p.B = I.w_ukv; p.ldb = 1024; p.C = KVb; p.ldc = 1024; p.M = RB; p.N = 1024; p.K = 128; gemm<0>(st, p); }
                hipLaunchKernelGGL(nk_prep_mla, dim3(RB * 16 / 256), dim3(256), 0, st, QDb, KVb, Pb, KDb, I.mla_q_g, I.mla_k_g);
                { AP a; memset(&a, 0, sizeof a); a.Q = Pb; a.ldq = 1184; a.qcol0 = 0; a.qhs = 64; a.K = Pb; a.ldk = 1184; a.kcol0 = 512; a.khs = 64; a.kgrp = 4; a.V = Pb; a.ldv = 1184; a.vcol0 = 640; a.vhs = 64; a.vgrp = 4;
                  a.O = AOb; a.ldo = 1024; a.ocol0 = 0; a.ohs = 64; a.q0 = 0; a.ka0 = 0; a.na = S; a.kb0 = S; a.nb = CL; a.scale = 0.125f;
                  hipLaunchKernelGGL((nk_attn<64, 64>), dim3(S / 64, 8), dim3(64), 0, st, a); }
                { AP a; memset(&a, 0, sizeof a); a.Q = QDb; a.ldq = 768; a.qcol0 = 0; a.qhs = 96; a.K = KDb; a.ldk = 768; a.kcol0 = 0; a.khs = 96; a.kgrp = 1; a.V = KVb; a.ldv = 1024; a.vcol0 = 64; a.vhs = 128; a.vgrp = 1;
                  a.O = AOb; a.ldo = 1024; a.ocol0 = 512; a.ohs = 64; a.q0 = 0; a.ka0 = 0; a.na = S; a.kb0 = S; a.nb = CL; a.scale = 0.10206207261596575f;
                  hipLaunchKernelGGL((nk_attn<96, 64>), dim3(S / 64, 8), dim3(64), 0, st, a); }
                if (ckpt && b == 0) hipMemcpyAsync(ckpt + 3 * CK, AOb, (size_t)S * D * 4, hipMemcpyDeviceToDevice, st);
                { GP p; memset(&p, 0, sizeof p); p.A = AOb; p.lda = D; p.B = I.od_w_out; p.ldb = D; p.C = Xb; p.ldc = D; p.M = S; p.N = D; p.K = D; p.base = Xb; p.gate = modl + (size_t)b * 6144 + 2 * D; gemm<1>(st, p); }
                if (ckpt && b == 0) hipMemcpyAsync(ckpt + 4 * CK, Xb, (size_t)S * D * 4, hipMemcpyDeviceToDevice, st);
            }
        }
        if (l == 1) {
            bp.off = (size_t)((char*)Hb - ws);
            float* H2 = (float*)bp.get((size_t)ntok * D * 4);
            int* idx = (int*)bp.get((size_t)ntok * 2 * 4);
            float* gt = (float*)bp.get((size_t)ntok * 2 * 4);
            int* slot_tok = (int*)bp.get((size_t)2 * MAXSLOT * 4);
            float* slot_g = (float*)bp.get((size_t)2 * MAXSLOT * 4);
            int* tile_e = (int*)bp.get((size_t)2 * MAXTILE * 4);
            constexpr int CH_TILES = 130, CH_SLOTS = CH_TILES * 64;
            float* MID = (float*)bp.get((size_t)CH_SLOTS * 3584 * 4);
            hipLaunchKernelGGL(nk_normmod, dim3(ntok), dim3(256), 0, st, X, (const float*)nullptr, I.norm2_g + D, modl, -1, 3, H2, ntok);
            hipLaunchKernelGGL(nk_router, dim3(ntok / 256), dim3(256), 0, st, H2, I.router, idx, gt, ntok);
            hipLaunchKernelGGL(nk_sort, dim3(1), dim3(1024), 0, st, idx, gt, ntok, slot_tok, slot_g, tile_e);
            const int max_tiles = (ntok + 8 * 63) / 64 + 1;
            for (int c = 0; c < 2; ++c)
                for (int ch = 0; ch * CH_TILES < max_tiles && ch < 4; ++ch) {
                    const int* st_ = slot_tok + c * MAXSLOT + ch * CH_SLOTS; const int* te = tile_e + c * MAXTILE + ch * CH_TILES;
                    { GP p; memset(&p, 0, sizeof p); p.A = H2; p.lda = D; p.rowidx = st_; p.B = I.w1; p.B2 = I.w3; p.ldb = 3584; p.tile_e = te; p.estride = (size_t)1024 * 3584; p.C = MID; p.ldc = 3584; p.M = CH_SLOTS; p.N = 3584; p.K = D; gemm<2>(st, p); }
                    { GP p; memset(&p, 0, sizeof p); p.A = MID; p.lda = 3584; p.oidx = st_; p.B = I.w2; p.ldb = D; p.tile_e = te; p.estride = (size_t)3584 * 1024; p.C = X; p.ldc = D; p.M = CH_SLOTS; p.N = D; p.K = 3584;
                      p.slot_g = slot_g + c * MAXSLOT + ch * CH_SLOTS; p.modl = modl; p.gchunk = 5; gemm<3>(st, p); }
                }
            if (ckpt) hipMemcpyAsync(ckpt + 5 * CK, X, (size_t)S * D * 4, hipMemcpyDeviceToDevice, st);
        }
    }
}
}
extern "C" void kernel_launch(void* const* d_in, const int* in_sizes, int n_in, void* d_out, int out_size, void* d_ws, size_t ws_size, hipStream_t stream) {
    if (n_in != 37 || out_size != 8 * 4096 * 1024) { fprintf(stderr, "kernel_launch: unexpected shapes\n"); return; }
    nv::In I = nv::make_in(d_in);
    nv::run(stream, I, (float*)d_out, (char*)d_ws, 8, nullptr);
}
```

```cpp
#define MK_MODE 0
#include <hip/hip_runtime.h>
#include <cstdint>
#include <cstdio>
#include <cstring>
#include <cmath>
#define GAS __attribute__((address_space(1)))
#define LAS __attribute__((address_space(3)))
typedef unsigned short bf16_t;
typedef unsigned v4u __attribute__((ext_vector_type(4)));
typedef unsigned v2u __attribute__((ext_vector_type(2)));
typedef float f32x4 __attribute__((ext_vector_type(4)));
typedef float f32x2 __attribute__((ext_vector_type(2)));
typedef float f32x16 __attribute__((ext_vector_type(16)));
typedef short bf16x8 __attribute__((ext_vector_type(8)));
typedef GAS unsigned gu32;
#define RLX_AGENT __ATOMIC_RELAXED, __HIP_MEMORY_SCOPE_AGENT
#define LDS_WAIT() asm volatile("s_waitcnt lgkmcnt(0)" ::: "memory")
#define VM_WAIT() asm volatile("s_waitcnt vmcnt(0)" ::: "memory")

namespace mk {
constexpr int D = 1024, NB = 8, S = 4096, CL = 256, NLAT = NB * S, NCTX = NB * CL, NTOK = NLAT + NCTX;
constexpr int GW = 64;
constexpr float EPS = 1e-6f;
constexpr float LOG2E = 1.4426950408889634f;
constexpr int NWAVES = 8, NTHR = 512;

__device__ __forceinline__ unsigned cvt_pk_bf16(float lo, float hi) { unsigned r; asm volatile("v_cvt_pk_bf16_f32 %0, %1, %2" : "=v"(r) : "v"(lo), "v"(hi)); return r; }
__device__ __forceinline__ float bf2f(unsigned short u) { return __uint_as_float((unsigned)u << 16); }
__device__ __forceinline__ float bflo(unsigned u) { return __uint_as_float(u << 16); }
__device__ __forceinline__ float bfhi(unsigned u) { return __uint_as_float(u & 0xffff0000u); }
__device__ __forceinline__ float silu_f(float x) { return x / (1.f + __expf(-x)); }
__device__ __forceinline__ float wave_sum(float v) {
#pragma unroll
    for (int o = 1; o < 64; o <<= 1) v += __shfl_xor(v, o);
    return v;
}
}
namespace pg8 {
using namespace mk;
constexpr int BM = 256, BK = 64, HALF = 128, HTB = HALF * BK * 2  , STAGE_BYTES = 8 * HTB, NXCD = 8, WGM = 8;

__device__ __forceinline__ int lds_byte(int r, int c) { const int st = (r >> 4) * 2 + (c >> 5), rr = r & 15, cc = c & 31, ob = rr * 64 + cc * 2; return st * 1024 + (ob ^ (((ob >> 9) & 1) << 5)); }
__device__ __forceinline__ void stage_rc(int b, int& R, int& C) { const int st = b / 1024, sb = b % 1024, swz = sb ^ (((sb >> 9) & 1) << 5); R = (st >> 1) * 16 + swz / 64; C = (st & 1) * 32 + (swz % 64) / 2; }
__device__ __forceinline__ int perm32(int rho) { const int n = rho >> 4, i = rho & 15; return 8 * (i >> 2) + 4 * n + (i & 3); }

struct Unit {
    const bf16_t* A; const bf16_t* B;
    const int* ridx;
    int rows;
    int pm, pn, kind, aux;
};

__device__ __forceinline__ int xcd_remap(int L, int nwg) { const int q = nwg / NXCD, r = nwg % NXCD, xcd = L % NXCD, off = L / NXCD; return (xcd < r ? xcd * (q + 1) : r * (q + 1) + (xcd - r) * q) + off; }
__device__ __forceinline__ void grouped(int w, int nM, int nN, int& pm, int& pn) {
    const int nig = WGM * nN, gid = w / nig, fm = gid * WGM, gsz = (nM - fm) < WGM ? (nM - fm) : WGM;
    pm = fm + ((w % nig) % gsz); pn = (w % nig) / gsz;
}

template <class Epi, class Sched, bool GATHER>
__device__ __forceinline__ void gemm_phase(LAS unsigned char* lds, const int K, const Sched& S, const Epi& E) {
    int tid_ = threadIdx.x; asm volatile("" : "+v"(tid_));
    const int tid = tid_, wid = __builtin_amdgcn_readfirstlane(tid >> 6), lane = tid & 63, wr = wid >> 2, wc = wid & 3, fr = lane & 15, fq = lane >> 4;
    const int nt = K / BK;
    int sR[2], sC[2]; unsigned voffB[2];
#pragma unroll
    for (int i = 0; i < 2; ++i) { stage_rc(tid * 16 + i * 8192, sR[i], sC[i]); const int Rb = Epi::PERM ? ((sR[i] & ~31) + perm32(sR[i] & 31)) : sR[i]; voffB[i] = (unsigned)(Rb * K + sC[i]) * 2u; }
    const size_t kstep = (size_t)(BK * 2);
    const size_t hstep = (size_t)HALF * K * 2;
    const unsigned ldsw = (unsigned)wid * 1024u;
    const int aoff = lds_byte(wr * 64 + fr, fq * 8), boff = lds_byte(wc * 32 + fr, fq * 8);
#define PG8_SA(b, h) (((b) * 2 + (h)) * HTB)
#define PG8_SB(b, h) ((4 + (b) * 2 + (h)) * HTB)
#define PG8_STAGE(bufoff, gbase, voff) do { _Pragma("unroll") for (int _i = 0; _i < 2; ++_i) \
        __builtin_amdgcn_global_load_lds((const unsigned*)((const char*)(gbase) + (voff)[_i]), (LAS unsigned*)(lds + (bufoff) + ldsw + _i * 8192), 16, 0, 0); } while (0)
#define PG8_STAGE_A(bufoff, h, kptr, vo) PG8_STAGE(bufoff, (GATHER ? (kptr) : (kptr) + (h) * hstep), (vo)[GATHER ? (h) : 0])
#define PG8_LDA(dst, b, h) do { _Pragma("unroll") for (int m = 0; m < 4; ++m) _Pragma("unroll") for (int k = 0; k < 2; ++k) dst[m][k] = *(const LAS bf16x8*)(lds + PG8_SA(b, h) + aoff + m * 2048 + k * 1024); } while (0)
#define PG8_LDB(dst, b, h) do { _Pragma("unroll") for (int n = 0; n < 2; ++n) _Pragma("unroll") for (int k = 0; k < 2; ++k) dst[n][k] = *(const LAS bf16x8*)(lds + PG8_SB(b, h) + boff + n * 2048 + k * 1024); } while (0)
#define PG8_MMA(ai, bj, At, Bt) do { __builtin_amdgcn_s_setprio(1); _Pragma("unroll") for (int m = 0; m < 4; ++m) _Pragma("unroll") for (int n = 0; n < 2; ++n) _Pragma("unroll") for (int k = 0; k < 2; ++k) \
        acc[ai][bj][m][n] = __builtin_amdgcn_mfma_f32_16x16x32_bf16(Bt[n][k], At[m][k], acc[ai][bj][m][n], 0, 0, 0); __builtin_amdgcn_s_setprio(0); } while (0)
#define PG8_WAIT_V(n) asm volatile("s_waitcnt vmcnt(" #n ")" ::: "memory")
#define PG8_WAIT_L(n) asm volatile("s_waitcnt lgkmcnt(" #n ")" ::: "memory")
#define PG8_BAR __builtin_amdgcn_s_barrier()
#define PG8_SCHED __builtin_amdgcn_sched_barrier(0)
#define PG8_MKVOFF(u, vo) do { _Pragma("unroll") for (int _h = 0; _h < (GATHER ? 2 : 1); ++_h) _Pragma("unroll") for (int _i = 0; _i < 2; ++_i) { \
        const int _row = _h * HALF + sR[_i]; int _g = _row; \
        if (GATHER) { _g = (_row < (u).rows) ? (u).ridx[_row] : 0; } \
        (vo)[_h][_i] = (unsigned)(_g * K + sC[_i]) * 2u; } } while (0)
    Unit cur, nxt; int ui = 0;
    if (!S.next(0, cur)) return;
    f32x4 acc[2][2][4][2];
#pragma unroll
    for (int a = 0; a < 2; ++a)
#pragma unroll
        for (int b = 0; b < 2; ++b)
#pragma unroll
            for (int m = 0; m < 4; ++m)
#pragma unroll
                for (int n = 0; n < 2; ++n) acc[a][b][m][n] = (f32x4){0.f, 0.f, 0.f, 0.f};
    bf16x8 At[4][2], B0[2][2], B1[2][2];
    unsigned vA[2][2], vN[2][2];
    PG8_MKVOFF(cur, vA);
    const char* cA = (const char*)cur.A; const char* cB = (const char*)cur.B;
    PG8_STAGE(PG8_SB(0, 0), cB, voffB); PG8_STAGE(PG8_SB(0, 1), cB + hstep, voffB); PG8_STAGE_A(PG8_SA(0, 0), 0, cA, vA); PG8_STAGE_A(PG8_SA(0, 1), 1, cA, vA);
    if (wr == 1) PG8_BAR;
    PG8_WAIT_V(2); PG8_BAR;
    PG8_STAGE(PG8_SB(1, 0), cB + kstep, voffB); PG8_STAGE_A(PG8_SA(1, 0), 0, cA + kstep, vA); PG8_STAGE(PG8_SB(1, 1), cB + hstep + kstep, voffB);
    PG8_WAIT_V(6); PG8_BAR;
    for (;;) {
        const bool has_next = S.next(ui + 1, nxt);
        const char* nA = has_next ? (const char*)nxt.A : cA; const char* nB = has_next ? (const char*)nxt.B : cB;
        if (GATHER) { if (has_next) { PG8_MKVOFF(nxt, vN); } else {
#pragma unroll
            for (int h = 0; h < 2; ++h)
#pragma unroll
                for (int i = 0; i < 2; ++i) vN[h][i] = vA[h][i]; } }
        for (int t = 0; t < nt; t += 2) {
            const bool last = (t == nt - 2);
            const char* a1 = cA + (size_t)(t + 1) * kstep;
            const char* a2 = last ? nA : cA + (size_t)(t + 2) * kstep; const char* b2 = last ? nB : cB + (size_t)(t + 2) * kstep;
            const char* a3 = a2 + kstep; const char* b3 = b2 + kstep;
            unsigned v2[2][2];
#pragma unroll
            for (int h = 0; h < 2; ++h)
#pragma unroll
                for (int i = 0; i < 2; ++i) v2[h][i] = (GATHER && last) ? vN[h][i] : vA[h][i];
            PG8_LDB(B0, 0, 0); PG8_LDB(B1, 0, 1); PG8_SCHED; PG8_LDA(At, 0, 0); PG8_STAGE_A(PG8_SA(1, 1), 1, a1, vA);
            PG8_WAIT_V(8); PG8_WAIT_L(0); PG8_BAR; PG8_MMA(0, 0, At, B0); PG8_MMA(0, 1, At, B1); PG8_BAR; PG8_SCHED;
            PG8_LDA(At, 0, 1); PG8_STAGE(PG8_SB(0, 0), b2, voffB); PG8_STAGE(PG8_SB(0, 1), b2 + hstep, voffB); PG8_STAGE_A(PG8_SA(0, 0), 0, a2, v2);
            PG8_WAIT_V(8); PG8_WAIT_L(0); PG8_BAR; PG8_MMA(1, 0, At, B0); PG8_MMA(1, 1, At, B1); PG8_BAR; PG8_SCHED;
            PG8_LDB(B0, 1, 0); PG8_LDB(B1, 1, 1); PG8_SCHED; PG8_LDA(At, 1, 0); PG8_STAGE_A(PG8_SA(0, 1), 1, a2, v2);
            PG8_WAIT_V(8); PG8_WAIT_L(0); PG8_BAR; PG8_MMA(0, 0, At, B0); PG8_MMA(0, 1, At, B1); PG8_BAR; PG8_SCHED;
            PG8_LDA(At, 1, 1); PG8_STAGE(PG8_SB(1, 0), b3, voffB); PG8_STAGE(PG8_SB(1, 1), b3 + hstep, voffB); PG8_STAGE_A(PG8_SA(1, 0), 0, a3, v2);
            PG8_WAIT_V(8); PG8_WAIT_L(0); PG8_BAR; PG8_MMA(1, 0, At, B0); PG8_MMA(1, 1, At, B1); PG8_BAR; PG8_SCHED;
        }
        if (wr == 0) PG8_BAR;
        E(acc, cur, wr, wc, fr, fq);
        if (!has_next) break;
#pragma unroll
        for (int a = 0; a < 2; ++a)
#pragma unroll
            for (int b = 0; b < 2; ++b)
#pragma unroll
                for (int m = 0; m < 4; ++m)
#pragma unroll
                    for (int n = 0; n < 2; ++n) acc[a][b][m][n] = (f32x4){0.f, 0.f, 0.f, 0.f};
        cur = nxt; cA = nA; cB = nB; ++ui;
        if (GATHER) {
#pragma unroll
        for (int h = 0; h < 2; ++h)
#pragma unroll
            for (int i = 0; i < 2; ++i) vA[h][i] = vN[h][i]; }
        if (wr == 1) PG8_BAR;
    }
    PG8_WAIT_V(0);
    PG8_BAR;
#undef PG8_SA
#undef PG8_SB
#undef PG8_STAGE
#undef PG8_STAGE_A
#undef PG8_LDA
#undef PG8_LDB
#undef PG8_MMA
#undef PG8_WAIT_V
#undef PG8_WAIT_L
#undef PG8_BAR
#undef PG8_SCHED
#undef PG8_MKVOFF
}

struct MultiSched {
    const bf16_t* A0; const bf16_t* B0; const bf16_t* A1; const bf16_t* B1;
    int nM0, nN0, kind0, nM1, nN1, kind1, n0, total, G, c, K;
    __device__ __forceinline__ void init(int K_, int G_, int c_) { n0 = 0; total = 0; G = G_; c = c_; K = K_; A1 = nullptr; B1 = nullptr; nM1 = 0; nN1 = 1; kind1 = 0; }
    __device__ __forceinline__ void add(const bf16_t* A, const bf16_t* B, int nM, int nN, int kind) {
        if (total == 0) { A0 = A; B0 = B; nM0 = nM; nN0 = nN; kind0 = kind; n0 = nM * nN; } else { A1 = A; B1 = B; nM1 = nM; nN1 = nN; kind1 = kind; }
        total += nM * nN; }
    __device__ __forceinline__ bool next(int i, Unit& u) const {
        const long L = (long)i * G + c; if (L >= total) return false;
        int w = xcd_remap((int)L, total);
        const bool second = w >= n0; if (second) w -= n0;
        const int nM = second ? nM1 : nM0, nN = second ? nN1 : nN0;
        int pm, pn; grouped(w, nM, nN, pm, pn);
        u.A = (second ? A1 : A0) + (size_t)pm * BM * K; u.B = (second ? B1 : B0) + (size_t)pn * BM * K; u.ridx = nullptr; u.rows = BM; u.pm = pm; u.pn = pn; u.kind = second ? kind1 : kind0; u.aux = pm * BM;
        return true;
    }
};
}
namespace pg8 {
struct EpiStore {
    static constexpr bool PERM = true;
    bf16_t* O0; bf16_t* O1; int ldc0, ldc1;
    __device__ __forceinline__ void operator()(const f32x4 (&acc)[2][2][4][2], const Unit& u, int wr, int wc, int fr, int fq) const {
        const int ldc = u.kind ? ldc1 : ldc0;
        bf16_t* base = (u.kind ? O1 : O0) + (size_t)(u.pm * BM + wr * 64 + fr) * ldc + u.pn * BM + wc * 32 + 8 * fq;
#pragma unroll
        for (int ai = 0; ai < 2; ++ai)
#pragma unroll
            for (int m = 0; m < 4; ++m) { bf16_t* rowp = base + (size_t)(ai * HALF + m * 16) * ldc;
#pragma unroll
                for (int bj = 0; bj < 2; ++bj) { const f32x4 v0 = acc[ai][bj][m][0], v1 = acc[ai][bj][m][1];
                    v4u w; w.x = cvt_pk_bf16(v0[0], v0[1]); w.y = cvt_pk_bf16(v0[2], v0[3]); w.z = cvt_pk_bf16(v1[0], v1[1]); w.w = cvt_pk_bf16(v1[2], v1[3]);
                    *(v4u*)(rowp + bj * HALF) = w; } }
    }
};
struct EpiSwiglu {
    static constexpr bool PERM = true;
    bf16_t* O; int ldc;
    __device__ __forceinline__ void operator()(const f32x4 (&acc)[2][2][4][2], const Unit& u, int wr, int wc, int fr, int fq) const {
        bf16_t* base = O + (size_t)(u.aux + wr * 64 + fr) * ldc + u.pn * HALF + wc * 32 + 8 * fq;
#pragma unroll
        for (int ai = 0; ai < 2; ++ai)
#pragma unroll
            for (int m = 0; m < 4; ++m) {
                float o[8];
#pragma unroll
                for (int n = 0; n < 2; ++n)
#pragma unroll
                    for (int j = 0; j < 4; ++j) { const float g = acc[ai][0][m][n][j], up = acc[ai][1][m][n][j]; o[n * 4 + j] = g * __builtin_amdgcn_rcpf(1.f + __builtin_amdgcn_exp2f(-g * LOG2E)) * up; }
                v4u w; w.x = cvt_pk_bf16(o[0], o[1]); w.y = cvt_pk_bf16(o[2], o[3]); w.z = cvt_pk_bf16(o[4], o[5]); w.w = cvt_pk_bf16(o[6], o[7]);
                *(v4u*)(base + (size_t)(ai * HALF + m * 16) * ldc) = w; }
    }
};
struct EpiResid {
    static constexpr bool PERM = false;
    const float* base_lat; float* out_lat; const float* base_ctx; float* out_ctx; const float* modl; int chunk;
    __device__ __forceinline__ void operator()(const f32x4 (&acc)[2][2][4][2], const Unit& u, int wr, int wc, int fr, int fq) const {
        const int row_t = u.pm * BM;
        const bool lat = row_t < NLAT;
        const int v = lat ? row_t / S : 8;
        const float* bp = lat ? base_lat + (size_t)row_t * D : base_ctx + (size_t)(row_t - NLAT) * D;
        float* op = lat ? out_lat + (size_t)row_t * D : out_ctx + (size_t)(row_t - NLAT) * D;
        const int col0 = u.pn * BM + wc * 32 + 4 * fq;
        const float* gp = modl + (size_t)v * 6144 + chunk * D + col0;
        f32x4 gv[2][2];
#pragma unroll
        for (int bj = 0; bj < 2; ++bj)
#pragma unroll
            for (int n = 0; n < 2; ++n) gv[bj][n] = *(const f32x4*)(gp + bj * HALF + n * 16);
#pragma unroll
        for (int ai = 0; ai < 2; ++ai)
#pragma unroll
            for (int m = 0; m < 4; ++m) { const size_t off = (size_t)(ai * HALF + wr * 64 + m * 16 + fr) * D + col0;
#pragma unroll
                for (int bj = 0; bj < 2; ++bj)
#pragma unroll
                    for (int n = 0; n < 2; ++n) { const f32x4 bs = *(const f32x4*)(bp + off + bj * HALF + n * 16);
                        *(f32x4*)(op + off + bj * HALF + n * 16) = bs + gv[bj][n] * acc[ai][bj][m][n]; } }
    }
};
struct EpiMoeDown {
    static constexpr bool PERM = false;
    float* out; const float* modl; const float* slot_g_base; const int* slot_tok_base;
    __device__ __forceinline__ void operator()(const f32x4 (&acc)[2][2][4][2], const Unit& u, int wr, int wc, int fr, int fq) const {
        const int col0 = u.pn * BM + wc * 32 + 4 * fq;
        const float* sg = slot_g_base + (u.ridx - slot_tok_base);
#pragma unroll
        for (int ai = 0; ai < 2; ++ai)
#pragma unroll
            for (int m = 0; m < 4; ++m) { const int r = ai * HALF + wr * 64 + m * 16 + fr;
                if (r < u.rows) { const int tok = u.ridx[r]; const float g = sg[r];
                    const float* gp = modl + (size_t)(tok >> 12) * 6144 + 5 * D + col0; float* op = out + (size_t)tok * D + col0;
#pragma unroll
                    for (int bj = 0; bj < 2; ++bj)
#pragma unroll
                        for (int n = 0; n < 2; ++n) { const f32x4 gv = *(const f32x4*)(gp + bj * HALF + n * 16); const f32x4 bs = *(const f32x4*)(op + bj * HALF + n * 16);
                            *(f32x4*)(op + bj * HALF + n * 16) = bs + (gv * g) * acc[ai][bj][m][n]; } } }
    }
};

struct MoeSched {
    const LAS int* tab;
    int ntile, nN, total, G, cu, K; bool gather;
    const bf16_t* A; const bf16_t* B; size_t bstride; const int* slot_tok;
    __device__ __forceinline__ void init(LAS int* tab_, const int* cnt_g, int K_, int nN_, int G_, int cu_, bool gather_, const bf16_t* A_, const bf16_t* B_, size_t bstride_, const int* slot_tok_) {
        __syncthreads();
        if (threadIdx.x == 0) { int s = 0; for (int e = 0; e < 8; ++e) { const int ce = cnt_g[e]; tab_[16 + e] = ce; tab_[e] = s; s += (ce + BM - 1) / BM; } tab_[8] = s; }
        __syncthreads();
        tab = tab_; ntile = __builtin_amdgcn_readfirstlane(tab_[8]);
        nN = nN_; total = ntile * nN_; G = G_; cu = cu_; K = K_; gather = gather_; A = A_; B = B_; bstride = bstride_; slot_tok = slot_tok_;
    }
    __device__ __forceinline__ bool next(int i, Unit& u) const {
        const long L = (long)i * G + cu; if (L >= total) return false;
        const int w = xcd_remap((int)L, total);
        int rt, pn; grouped(w, ntile, nN, rt, pn);
        int e = 0;
        for (int j = 1; j < 8; ++j) if (rt >= tab[j]) e = j;
        const int t0 = tab[e], ce = tab[16 + e];
        const int lt = rt - t0;
        u.ridx = slot_tok + (size_t)e * NLAT + lt * BM; u.rows = (ce - lt * BM) < BM ? (ce - lt * BM) : BM;
        u.A = gather ? A : A + (size_t)rt * BM * K; u.B = B + (size_t)e * bstride + (size_t)pn * BM * K;
        u.pm = rt; u.pn = pn; u.kind = e; u.aux = rt * BM;
        return true;
    }
};
}
namespace att {
using namespace mk;
constexpr int NSLOT = 3;
constexpr float NEG_BIG = -1e30f;
template <int DK, int DV> struct Cfg {
    static constexpr int KB = 64 * DK * 2, VB = DV * 64 * 2, SLOT = KB + VB, NPK = DK / 8, NPV = DV / 8, NP = NPK + NPV, NPW = (NP + 7) / 8, ND0 = DK / 16, NDB = DV / 32;
};
__device__ __forceinline__ int kvmap(int i) { return (i & 3) | ((i & 4) << 1) | ((i & 8) >> 1) | (i & 16); }

struct Keys { int ka0, na, kb0, nb; };
struct NaInfo { int r_lo; int qr; int qc; const LAS float* bias; };

#define ATT_WAITBAR(N) asm volatile("s_waitcnt vmcnt(" #N ") lgkmcnt(0)\n\ts_barrier" ::: "memory")

template <int DK, int DV, bool MODE_NA>
__device__ __forceinline__ void attn_core(LAS unsigned char* lds, const bf16_t* __restrict__ Qp  ,
                                          const bf16_t* __restrict__ Kh  , int ldk, const bf16_t* __restrict__ VTh  , int ldv,
                                          const Keys ky, const NaInfo na, f32x16 (&oT)[Cfg<DK, DV>::NDB], float& l_out) {
    typedef Cfg<DK, DV> C;
    int tid_ = threadIdx.x; asm volatile("" : "+v"(tid_));
    const int tid = tid_, lane = tid & 63, r32 = lane & 31, hi = lane >> 5; const int wid = __builtin_amdgcn_readfirstlane(tid >> 6);
    const int nt = ky.na + ky.nb;
    bf16x8 qf[C::ND0];
#pragma unroll
    for (int d0 = 0; d0 < C::ND0; ++d0) qf[d0] = *(const bf16x8*)(Qp + d0 * 16 + hi * 8);
    const unsigned voffK = (unsigned)lane * (unsigned)ldk * 2u, voffV = (unsigned)lane * (unsigned)ldv * 2u;
#define ATT_ISSUE(t, slot) do { const int _row0 = (t) < ky.na ? ky.ka0 + 64 * (t) : ky.kb0 + 64 * ((t) - ky.na); \
        _Pragma("unroll") for (int _j = 0; _j < C::NPW; ++_j) { int _pc = wid + 8 * _j; _pc = _pc < C::NP ? _pc : C::NP - 1; \
            if (_pc < C::NPK) { const char* _g = (const char*)(Kh + (size_t)_row0 * ldk + _pc * 8); \
                __builtin_amdgcn_global_load_lds((const unsigned*)(_g + voffK), (LAS unsigned*)(lds + (slot) * C::SLOT + _pc * 1024), 16, 0, 0); } \
            else { const int _pv = _pc - C::NPK; const char* _g = (const char*)(VTh + (size_t)((_pv >> 3) * 64) * ldv + _row0 + (_pv & 7) * 8); \
                __builtin_amdgcn_global_load_lds((const unsigned*)(_g + voffV), (LAS unsigned*)(lds + (slot) * C::SLOT + C::KB + _pv * 1024), 16, 0, 0); } } } while (0)
    ATT_ISSUE(0, 0);
    if (nt > 1) ATT_ISSUE(1, 1);
#pragma unroll
    for (int db = 0; db < C::NDB; ++db)
#pragma unroll
        for (int r = 0; r < 16; ++r) oT[db][r] = 0.f;
    float m = -INFINITY, l = 0.f;
    const int kvm = kvmap(r32);
    int slot = 0;
    for (int t = 0; t < nt; ++t) {
        if (t + 1 < nt) { if (C::NPW == 2) ATT_WAITBAR(2); else ATT_WAITBAR(3); } else ATT_WAITBAR(0);
        int s2 = slot + 2; s2 = s2 >= NSLOT ? s2 - NSLOT : s2;
        if (t + 2 < nt) ATT_ISSUE(t + 2, s2);
        const LAS unsigned char* ks = lds + slot * C::SLOT; const LAS unsigned char* vs = ks + C::KB;
        slot = slot + 1 == NSLOT ? 0 : slot + 1;
        bool active = true; int kr = 0;
        if (MODE_NA) { if (t >= ky.na) { kr = na.r_lo + (t - ky.na); int r0 = na.qr - 4; r0 = r0 < 0 ? 0 : (r0 > 56 ? 56 : r0); active = (kr >= r0) && (kr < r0 + 8); } }
        if (MODE_NA) active = __builtin_amdgcn_readfirstlane(active ? 1 : 0) != 0;
        if (active) {
            f32x16 p[2];
#pragma unroll
            for (int h = 0; h < 2; ++h) {
#pragma unroll
                for (int r = 0; r < 16; ++r) p[h][r] = 0.f;
#pragma unroll
                for (int d0 = 0; d0 < C::ND0; ++d0) { const bf16x8 kf = *(const LAS bf16x8*)(ks + (2 * d0 + hi) * 1024 + (32 * h + kvm) * 16);
                    p[h] = __builtin_amdgcn_mfma_f32_32x32x16_bf16(kf, qf[d0], p[h], 0, 0, 0); }
            }
            if (MODE_NA) { if (t >= ky.na) {
                int c0 = na.qc - 8; c0 = c0 < 0 ? 0 : (c0 > 48 ? 48 : c0);
                const LAS float* brow = na.bias + (kr - na.qr + 7) * 31 + 15 - na.qc;
#pragma unroll
                for (int h = 0; h < 2; ++h)
#pragma unroll
                    for (int r = 0; r < 16; ++r) { const int kc = 32 * h + 16 * (r >> 3) + 8 * hi + (r & 7);
                        const bool ok = (unsigned)(kc - c0) < 16u; const int bi = ok ? kc : na.qc;
                        p[h][r] = ok ? p[h][r] + brow[bi] : NEG_BIG; } } }
            float mt = fmaxf(p[0][0], p[1][0]);
#pragma unroll
            for (int r = 1; r < 16; ++r) mt = fmaxf(mt, fmaxf(p[0][r], p[1][r]));
            mt = fmaxf(mt, __shfl_xor(mt, 32));
            const float mn = fmaxf(m, mt);
            if (__any(mn > m)) { const float al = __builtin_amdgcn_exp2f(m - mn); l *= al;
#pragma unroll
                for (int db = 0; db < C::NDB; ++db)
#pragma unroll
                    for (int r = 0; r < 16; ++r) oT[db][r] *= al;
                m = mn; }
            float sacc = 0.f;
#pragma unroll
            for (int h = 0; h < 2; ++h)
#pragma unroll
                for (int r = 0; r < 16; ++r) { p[h][r] = __builtin_amdgcn_exp2f(p[h][r] - m); sacc += p[h][r]; }
            l += sacc;
#pragma unroll
            for (int kc = 0; kc < 4; ++kc) { const int h = kc >> 1, b = 8 * (kc & 1);
                v4u pw; pw.x = cvt_pk_bf16(p[h][b], p[h][b + 1]); pw.y = cvt_pk_bf16(p[h][b + 2], p[h][b + 3]); pw.z = cvt_pk_bf16(p[h][b + 4], p[h][b + 5]); pw.w = cvt_pk_bf16(p[h][b + 6], p[h][b + 7]);
                const bf16x8 pb = __builtin_bit_cast(bf16x8, pw);
#pragma unroll
                for (int db = 0; db < C::NDB; ++db) { const bf16x8 vf = *(const LAS bf16x8*)(vs + ((db >> 1) * 8 + 2 * kc + hi) * 1024 + ((db & 1) * 32 + r32) * 16);
                    oT[db] = __builtin_amdgcn_mfma_f32_32x32x16_bf16(vf, pb, oT[db], 0, 0, 0); }
                if (C::NDB > 2) __builtin_amdgcn_sched_barrier(0); }
        }
    }
    ATT_WAITBAR(0);
    l_out = l + __shfl_xor(l, 32);
#undef ATT_ISSUE
}
template <int NDB>
__device__ __forceinline__ void store_o(const f32x16 (&oT)[NDB], float scale, bf16_t* Op  , int hi) {
#pragma unroll
    for (int db = 0; db < NDB; ++db)
#pragma unroll
        for (int g = 0; g < 4; ++g) { v2u w; w.x = cvt_pk_bf16(oT[db][4 * g] * scale, oT[db][4 * g + 1] * scale); w.y = cvt_pk_bf16(oT[db][4 * g + 2] * scale, oT[db][4 * g + 3] * scale);
            *(v2u*)(Op + 32 * db + 8 * g + 4 * hi) = w; }
}
}
namespace ew {
using namespace mk;

__device__ __forceinline__ void conv_item(const float* __restrict__ W, int ldw, int k0, int n0, int nvalid, bf16_t* __restrict__ dst, int dK, LAS float* scr, int lane) {
    const int n4 = (lane & 15) * 4, kr = lane >> 4;
#pragma unroll
    for (int i = 0; i < 8; ++i) { const int k = kr + 4 * i;
        f32x4 v = (f32x4){0.f, 0.f, 0.f, 0.f};
        if (n4 < nvalid) v = *(const f32x4*)(W + (size_t)(k0 + k) * ldw + n0 + n4);
        scr[k * 65 + n4] = v.x; scr[k * 65 + n4 + 1] = v.y; scr[k * 65 + n4 + 2] = v.z; scr[k * 65 + n4 + 3] = v.w; }
    LDS_WAIT(); asm volatile("" ::: "memory");
    const int c = lane & 3;
#pragma unroll
    for (int j = 0; j < 4; ++j) { const int n = (lane >> 2) + 16 * j; const LAS float* s = scr + (8 * c) * 65 + n;
        v4u o; o.x = cvt_pk_bf16(s[0], s[65]); o.y = cvt_pk_bf16(s[2 * 65], s[3 * 65]); o.z = cvt_pk_bf16(s[4 * 65], s[5 * 65]); o.w = cvt_pk_bf16(s[6 * 65], s[7 * 65]);
        if (n < nvalid) *(v4u*)(dst + (size_t)n * dK + k0 + 8 * c) = o; }
    LDS_WAIT(); asm volatile("" ::: "memory");
}

__device__ __forceinline__ void normmod_row(const float* __restrict__ xrow, const float* __restrict__ g, const float* __restrict__ sh, const float* __restrict__ sc, bf16_t* __restrict__ orow, int lane) {
    const f32x4* xr = (const f32x4*)xrow + lane;
    f32x4 v[4]; float s = 0.f;
#pragma unroll
    for (int j = 0; j < 4; ++j) { v[j] = xr[64 * j]; s += (v[j].x * v[j].x + v[j].y * v[j].y) + (v[j].z * v[j].z + v[j].w * v[j].w); }
    const float rstd = rsqrtf(wave_sum(s) * (1.f / D) + EPS);
    v2u* o8 = (v2u*)orow + lane;
#pragma unroll
    for (int j = 0; j < 4; ++j) { const f32x4 gg = ((const f32x4*)g)[lane + 64 * j], s1 = ((const f32x4*)sc)[lane + 64 * j], s0 = ((const f32x4*)sh)[lane + 64 * j];
        const f32x4 y = v[j] * rstd * gg * (s1 + 1.f) + s0;
        v2u w; w.x = cvt_pk_bf16(y.x, y.y); w.y = cvt_pk_bf16(y.z, y.w); o8[64 * j] = w; }
}

__device__ __forceinline__ void unpack8(const v4u w, float (&f)[8]) { f[0] = bflo(w.x); f[1] = bfhi(w.x); f[2] = bflo(w.y); f[3] = bfhi(w.y); f[4] = bflo(w.z); f[5] = bfhi(w.z); f[6] = bflo(w.w); f[7] = bfhi(w.w); }
__device__ __forceinline__ v4u pack8(const float (&f)[8]) { v4u w; w.x = cvt_pk_bf16(f[0], f[1]); w.y = cvt_pk_bf16(f[2], f[3]); w.z = cvt_pk_bf16(f[4], f[5]); w.w = cvt_pk_bf16(f[6], f[7]); return w; }

struct Rope { const f32x2* t64; const f32x2* t32; };

__device__ __forceinline__ void seg64(float (&f)[8], int lane, const float* __restrict__ g, bool rope, int gr, int gc, const Rope& R, float scale) {
    const int s = lane & 7;
    float ss = 0.f;
#pragma unroll
    for (int j = 0; j < 8; ++j) ss += f[j] * f[j];
    ss += __shfl_xor(ss, 1); ss += __shfl_xor(ss, 2); ss += __shfl_xor(ss, 4);
    const float rstd = rsqrtf(ss * (1.f / 64.f) + EPS);
#pragma unroll
    for (int j = 0; j < 8; ++j) f[j] = f[j] * rstd * g[8 * s + j];
    float pr[8];
#pragma unroll
    for (int j = 0; j < 8; ++j) pr[j] = __shfl_xor(f[j], 2);
    if (rope) {
        const int pos = (s >> 2) ? gc : gr; const bool x1 = (s & 3) < 2; const int i0 = 8 * (s & 1);
#pragma unroll
        for (int j = 0; j < 8; ++j) { const f32x2 cs = R.t64[pos * 16 + i0 + j]; f[j] = x1 ? (f[j] * cs.x - pr[j] * cs.y) : (pr[j] * cs.y + f[j] * cs.x); }
    }
#pragma unroll
    for (int j = 0; j < 8; ++j) f[j] *= scale;
}
}
namespace mk {
constexpr size_t MiB = (size_t)1 << 20;
constexpr size_t WS_CTL = 0, CTL_ZERO_BYTES = 1 * MiB;
constexpr size_t WS_MODF = 1 * MiB;
constexpr size_t WS_ROPE = 2 * MiB;
constexpr size_t WS_SLOT_TOK = 3 * MiB;
constexpr size_t WS_SLOT_G = 5 * MiB;
constexpr size_t WS_XC = 8 * MiB;
constexpr size_t WS_WQK0 = 16 * MiB, WS_WV0 = 20 * MiB, WS_WO0 = 22 * MiB, WS_WGU0 = 24 * MiB, WS_WD0 = 35 * MiB;
constexpr size_t WS_WODD = 41 * MiB, WS_WVC = 43 * MiB + 512 * 1024, WS_WO1 = 44 * MiB, WS_WUQ = 46 * MiB, WS_WUKN = 46 * MiB + 512 * 1024, WS_WUKV = 46 * MiB + 640 * 1024;
constexpr size_t WS_W13 = 48 * MiB, WS_W2 = 160 * MiB;
constexpr size_t WS_H = 216 * MiB;
constexpr size_t WS_CQN = 216 * MiB, WS_CKVN = 233 * MiB, WS_KN = 242 * MiB;
constexpr size_t WS_BIG = 284 * MiB;
constexpr size_t WS_QK0 = WS_BIG, WS_VT0 = 420 * MiB, WS_DSCR = 488 * MiB, WS_MID0 = WS_BIG;
constexpr size_t WS_P1 = WS_BIG, WS_VT1C = 369 * MiB, WS_QD = 386 * MiB, WS_VT1D = 434 * MiB, WS_KDF = 468 * MiB, WS_MID1 = WS_BIG;
constexpr size_t WS_END = 522 * MiB;
constexpr int CW_TMO = 0, CW_GCNT = 64, CW_BAR = 4096;
constexpr int RING_BYTES = 131072, LDSCTL_OFF = RING_BYTES, MISC_OFF = LDSCTL_OFF + 320, LDS_BYTES = 147456;
constexpr int P1LD = 1280;
constexpr float QSCALE64 = 0.125f * LOG2E, QSCALE96 = 0.10206207261596575f * LOG2E;
constexpr int NPHASE = 22;
}

#define XB_TMO      128
#define XB_XCNT(j)  (256  + 64 * (j))
#define XB_XSUB(j)  (1280 + 64 * (j))
#define XB_XGEN(j)  (2304 + 64 * (j))
#define XB_TOP      3328
#define XB_TOPGEN   3392
#define XCD_BAR_WORDS 3456
#define XB_SPIN_CAP (1u << 18)

__device__ __forceinline__ unsigned xb_ld(unsigned* p)              { return __hip_atomic_load(p, __ATOMIC_RELAXED, __HIP_MEMORY_SCOPE_AGENT); }
__device__ __forceinline__ unsigned xb_add(unsigned* p, unsigned v) { return __hip_atomic_fetch_add(p, v, __ATOMIC_RELAXED, __HIP_MEMORY_SCOPE_AGENT); }
__device__ __forceinline__ unsigned xb_xcc_id() { return (unsigned)__builtin_amdgcn_s_getreg((3 << 11) | 20) & 0xFu; }
#define XB_SPIN(cond, bar) do { unsigned _sp = 0; while (cond) { __builtin_amdgcn_s_sleep(1); \
    if ((++_sp & 255u) == 0u) { if (xb_ld(&(bar)[XB_TMO])) break; if (_sp > XB_SPIN_CAP) { atomicAdd(&(bar)[XB_TMO], 1u); break; } } } } while (0)

struct XcdBarrier {
    unsigned* bar; unsigned x;
    volatile LAS unsigned* st;
};

__device__ __forceinline__ XcdBarrier xcd_barrier_post(unsigned* bar, volatile LAS unsigned* st) {
    XcdBarrier b; b.bar = bar; b.x = xb_xcc_id(); b.st = st;
    if (threadIdx.x == 0) (void)xb_add(&bar[XB_XCNT(b.x)], 1u);
    return b;
}
__device__ __forceinline__ void xcd_barrier_complete(unsigned* bar, unsigned x, unsigned& nloc, unsigned& nx) {
    const unsigned G = gridDim.x * gridDim.y * gridDim.z;
    unsigned sum, cnt, mine, sp = 0u;
    for (;;) {
        sum = 0u; cnt = 0u; mine = 0u;
#pragma unroll
        for (unsigned j = 0; j < 16; ++j) { const unsigned c = xb_ld(&bar[XB_XCNT(j)]); sum += c; cnt += (c > 0u) ? 1u : 0u; mine = (j == x) ? c : mine; }
        if (sum == G) break;
        __builtin_amdgcn_s_sleep(1);
        if ((++sp & 255u) == 0u) { if (xb_ld(&bar[XB_TMO])) break; if (sp > XB_SPIN_CAP) { atomicAdd(&bar[XB_TMO], 1u); break; } }
    }
    nloc = mine > 0u ? mine : 1u; nx = cnt > 0u ? cnt : 1u;
}

__device__ __forceinline__ void xcd_barrier(const XcdBarrier& b) {
    asm volatile("s_waitcnt vmcnt(0)" ::: "memory");
    __syncthreads();
    if (threadIdx.x == 0) {
        unsigned* bar = b.bar;
        __builtin_amdgcn_s_waitcnt(0);
        unsigned nloc = b.st[0], nx = b.st[1];
        if (nloc == 0u) { xcd_barrier_complete(bar, b.x, nloc, nx); b.st[0] = nloc; b.st[1] = nx; }
        const unsigned old = xb_add(&bar[XB_XSUB(b.x)], 1u);
        const unsigned gen = old / nloc;
        if (old + 1u == (gen + 1u) * nloc) {
            __builtin_amdgcn_fence(__ATOMIC_RELEASE, "agent");
            asm volatile("s_waitcnt vmcnt(0)" ::: "memory");
            const unsigned og = xb_add(&bar[XB_TOP], 1u);
            const unsigned tg = og / nx;
            if (og + 1u == (tg + 1u) * nx) xb_add(&bar[XB_TOPGEN], 1u);
            else XB_SPIN(xb_ld(&bar[XB_TOPGEN]) == tg, bar);
            __builtin_amdgcn_fence(__ATOMIC_ACQUIRE, "agent");
            xb_add(&bar[XB_XGEN(b.x)], 1u);
            asm volatile("s_waitcnt vmcnt(0)" ::: "memory");
        } else {
            XB_SPIN(xb_ld(&bar[XB_XGEN(b.x)]) == gen, bar);
            __builtin_amdgcn_fence(__ATOMIC_ACQUIRE, "agent");
            asm volatile("s_waitcnt vmcnt(0)" ::: "memory");
        }
    }
    __syncthreads();
}


namespace mk {
struct Args { const float* in[37]; float* out; unsigned char* ws; int ph_lo, ph_hi; };

struct Frame {
    LAS unsigned char* lds; volatile LAS unsigned* MISC; gu32* ctl;
    int tid, lane, wave, G, vcu, gw, NGW;
};

__device__ __forceinline__ void p0_prologue(Frame& F, const Args& a) {
    unsigned char* ws = a.ws;
    LAS float* sct = (LAS float*)F.lds;
    for (int i = F.tid; i < 9 * D; i += NTHR) { const int v = i >> 10, k = i & 1023; const float x = v < 8 ? a.in[1][v * D + k] : a.in[3][k]; sct[i] = x / (1.f + expf(-x)); }
    __syncthreads();
    if (F.wave == 0) {
        for (int it = blockIdx.x; it < 384; it += F.G) {
            const int l = it / 192, j0 = (it % 192) * 32, col = j0 + (F.lane & 31), kh = F.lane >> 5;
            const float* W = a.in[4] + (size_t)l * D * 6144 + col;
            float acc[9];
#pragma unroll
            for (int v = 0; v < 9; ++v) acc[v] = 0.f;
#pragma unroll 8
            for (int k = kh * 512; k < kh * 512 + 512; ++k) { const float w = W[(size_t)k * 6144];
#pragma unroll
                for (int v = 0; v < 9; ++v) acc[v] += sct[v * D + k] * w; }
#pragma unroll
            for (int v = 0; v < 9; ++v) { acc[v] += __shfl_xor(acc[v], 32); }
            if (F.lane < 32) { float* mo = (float*)(ws + WS_MODF) + (size_t)l * 9 * 6144 + col; const float bb = a.in[5][l * 6144 + col];
#pragma unroll
                for (int v = 0; v < 9; ++v) mo[(size_t)v * 6144] = acc[v] + bb; }
        }
    }
    if (blockIdx.x == 0) {
        f32x2* t64 = (f32x2*)(ws + WS_ROPE); f32x2* t32 = (f32x2*)(ws + WS_ROPE + 16384);
        for (int i = F.tid; i < 64 * 16; i += NTHR) { const int pos = i >> 4, k = i & 15; const float ang = (float)pos * powf(10000.f, -(float)k / 16.f); t64[i] = (f32x2){cosf(ang), sinf(ang)}; }
        for (int i = F.tid; i < 64 * 8; i += NTHR) { const int pos = i >> 3, k = i & 7; const float ang = (float)pos * powf(10000.f, -(float)k / 8.f); t32[i] = (f32x2){cosf(ang), sinf(ang)}; }
    }
    LAS float* scr = (LAS float*)(F.lds + 40960 + F.wave * 8448);
    constexpr int I_EVIN = 32 * 48, I_EVOUT = 32 * 16, I_FG = 32 * 44, I_FU = 32 * 44, I_FD = 88 * 16, I_ODIN = 32 * 19, I_ODOUT = 32 * 16, I_UQ = 8 * 12, I_UKV = 4 * 16;
    constexpr int I_W1 = 32 * 56, I_W2 = 112 * 16;
    constexpr int I_SMALL = I_EVIN + I_EVOUT + I_FG + I_FU + I_FD + I_ODIN + I_ODOUT + I_UQ + I_UKV;
    constexpr int I_TOTAL = I_SMALL + 8 * (2 * I_W1 + I_W2);
    for (int it = F.gw; it < I_TOTAL; it += F.NGW) {
        int r = it;
        if (r < I_EVIN) { const int kb = r / 48, nb = r % 48, n0 = nb * 64;
            bf16_t* dst;
            if (n0 < 1024) dst = (bf16_t*)(ws + WS_WQK0) + (size_t)n0 * D;
            else if (n0 < 1536) dst = (bf16_t*)(ws + WS_WV0) + (size_t)(n0 - 1024) * D;
            else if (n0 < 2560) dst = (bf16_t*)(ws + WS_WQK0) + (size_t)(n0 - 512) * D;
            else dst = (bf16_t*)(ws + WS_WV0) + (size_t)(n0 - 2048) * D;
            ew::conv_item(a.in[8], 3072, kb * 32, n0, 64, dst, D, scr, F.lane); continue; } r -= I_EVIN;
        if (r < I_EVOUT) { const int kb = r / 16, n0 = (r % 16) * 64; ew::conv_item(a.in[9], D, kb * 32, n0, 64, (bf16_t*)(ws + WS_WO0) + (size_t)n0 * D, D, scr, F.lane); continue; } r -= I_EVOUT;
        if (r < I_FG) { const int kb = r / 44, n0 = (r % 44) * 64; ew::conv_item(a.in[20], 2816, kb * 32, n0, 64, (bf16_t*)(ws + WS_WGU0) + (size_t)((n0 >> 7) * 256 + (n0 & 127)) * D, D, scr, F.lane); continue; } r -= I_FG;
        if (r < I_FU) { const int kb = r / 44, n0 = (r % 44) * 64; ew::conv_item(a.in[21], 2816, kb * 32, n0, 64, (bf16_t*)(ws + WS_WGU0) + (size_t)((n0 >> 7) * 256 + 128 + (n0 & 127)) * D, D, scr, F.lane); continue; } r -= I_FU;
        if (r < I_FD) { const int kb = r / 16, n0 = (r % 16) * 64; ew::conv_item(a.in[22], D, kb * 32, n0, 64, (bf16_t*)(ws + WS_WD0) + (size_t)n0 * 2816, 2816, scr, F.lane); continue; } r -= I_FD;
        if (r < I_ODIN) { const int kb = r / 19, nb = r % 19, n0 = nb * 64;
            bf16_t* dst; int nv = 64;
            if (n0 < 512) dst = (bf16_t*)(ws + WS_WODD) + (size_t)n0 * D;
            else if (n0 < 640) dst = (bf16_t*)(ws + WS_WODD) + (size_t)(n0 + 256) * D;
            else if (n0 < 768) dst = (bf16_t*)(ws + WS_WVC) + (size_t)(n0 - 640) * D;
            else if (n0 < 1024) dst = (bf16_t*)(ws + WS_WODD) + (size_t)(n0 - 256) * D;
            else if (n0 < 1152) dst = (bf16_t*)(ws + WS_WODD) + (size_t)(n0 - 128) * D;
            else { dst = (bf16_t*)(ws + WS_WODD) + (size_t)(n0 - 128) * D; nv = 32; }
            ew::conv_item(a.in[23], 1184, kb * 32, n0, nv, dst, D, scr, F.lane); continue; } r -= I_ODIN;
        if (r < I_ODOUT) { const int kb = r / 16, n0 = (r % 16) * 64; ew::conv_item(a.in[24], D, kb * 32, n0, 64, (bf16_t*)(ws + WS_WO1) + (size_t)n0 * D, D, scr, F.lane); continue; } r -= I_ODOUT;
        if (r < I_UQ) { const int kb = r / 12, n0 = (r % 12) * 64; ew::conv_item(a.in[28], 768, kb * 32, n0, 64, (bf16_t*)(ws + WS_WUQ) + (size_t)n0 * 256, 256, scr, F.lane); continue; } r -= I_UQ;
        if (r < I_UKV) { const int kb = r / 16, nb = r % 16, n0 = nb * 64, h = nb >> 1;
            bf16_t* dst = (nb & 1) ? (bf16_t*)(ws + WS_WUKV) + (size_t)(h * 64) * 128 : (bf16_t*)(ws + WS_WUKN) + (size_t)(h * 64) * 128;
            ew::conv_item(a.in[30], 1024, kb * 32, n0, 64, dst, 128, scr, F.lane); continue; } r -= I_UKV;
        { const int e = r / (2 * I_W1 + I_W2); int q = r % (2 * I_W1 + I_W2);
          if (q < 2 * I_W1) { const int up = q >= I_W1; if (up) q -= I_W1; const int kb = q / 56, n0 = (q % 56) * 64;
              ew::conv_item(a.in[up ? 35 : 34] + (size_t)e * D * 3584, 3584, kb * 32, n0, 64, (bf16_t*)(ws + WS_W13) + ((size_t)e * 7168 + (n0 >> 7) * 256 + (up ? 128 : 0) + (n0 & 127)) * D, D, scr, F.lane); }
          else { q -= 2 * I_W1; const int kb = q / 16, n0 = (q % 16) * 64;
              ew::conv_item(a.in[36] + (size_t)e * 3584 * D, D, kb * 32, n0, 64, (bf16_t*)(ws + WS_W2) + ((size_t)e * D + n0) * 3584, 3584, scr, F.lane); } }
    }
}

__device__ __forceinline__ void normmod_phase(Frame& F, const float* xlat, const float* xctx, const float* g, const float* modl, int sh_chunk, bf16_t* H, int nrows) {
    const int per = (nrows + F.NGW - 1) / F.NGW;
    const int r0 = F.gw * per, r1 = (r0 + per) < nrows ? (r0 + per) : nrows;
    for (int row = r0; row < r1; ++row) {
        const bool lat = row < NLAT; const int v = lat ? row / S : 8;
        const float* src = lat ? xlat + (size_t)row * D : xctx + (size_t)(row - NLAT) * D;
        const float* sh = modl + (size_t)v * 6144 + sh_chunk * D;
        ew::normmod_row(src, g, sh, sh + D, H + (size_t)row * D, F.lane);
    }
}

__device__ __forceinline__ void post_even(Frame& F, const Args& a) {
    bf16_t* QK = (bf16_t*)(a.ws + WS_QK0);
    const ew::Rope R{(const f32x2*)(a.ws + WS_ROPE), (const f32x2*)(a.ws + WS_ROPE + 16384)};
    const int per = (NTOK + F.NGW - 1) / F.NGW; const int r0 = F.gw * per, r1 = (r0 + per) < NTOK ? (r0 + per) : NTOK;
    for (int row = r0; row < r1; ++row) {
        const bool lat = row < NLAT; const int pos = row & (S - 1), gr = pos >> 6, gc = pos & 63;
#pragma unroll
        for (int ch = 0; ch < 4; ++ch) {
            v4u* p = (v4u*)(QK + (size_t)row * 2048 + ch * 512) + F.lane;
            float f[8]; ew::unpack8(*p, f);
            const float* g = a.in[ch == 0 ? 10 : ch == 1 ? 11 : ch == 2 ? 13 : 14];
            ew::seg64(f, F.lane, g, ch >= 2 && lat, gr, gc, R, (ch == 0 || ch == 2) ? QSCALE64 : 1.f);
            *p = ew::pack8(f);
        }
    }
}

__device__ __forceinline__ void post_odd(Frame& F, const Args& a) {
    bf16_t* P1 = (bf16_t*)(a.ws + WS_P1); bf16_t* CQN = (bf16_t*)(a.ws + WS_CQN); bf16_t* CKVN = (bf16_t*)(a.ws + WS_CKVN);
    const ew::Rope R{(const f32x2*)(a.ws + WS_ROPE), (const f32x2*)(a.ws + WS_ROPE + 16384)};
    const int per = (NTOK + F.NGW - 1) / F.NGW; const int r0 = F.gw * per, r1 = (r0 + per) < NTOK ? (r0 + per) : NTOK;
    for (int row = r0; row < r1; ++row) {
        const bool lat = row < NLAT; const int pos = row & (S - 1), gr = pos >> 6, gc = pos & 63;
        { v4u* p = (v4u*)(P1 + (size_t)row * P1LD) + F.lane; float f[8]; ew::unpack8(*p, f);
          ew::seg64(f, F.lane, a.in[25], lat, gr, gc, R, QSCALE64); *p = ew::pack8(f); }
        { v4u* p = (v4u*)(P1 + (size_t)row * P1LD + 512) + F.lane; float f[8]; ew::unpack8(*p, f);
          float ss = 0.f;
#pragma unroll
          for (int j = 0; j < 8; ++j) ss += f[j] * f[j];
          ss += __shfl_xor(ss, 1); ss += __shfl_xor(ss, 2); ss += __shfl_xor(ss, 4);
          const float s3 = ss; const float s4 = s3 + __shfl_xor(s3, 8); const float s5 = s4 + __shfl_xor(s4, 16);
          float pr[8];
#pragma unroll
          for (int j = 0; j < 8; ++j) pr[j] = __shfl_xor(f[j], 2);
          if (F.lane < 32) {
              const float rstd = rsqrtf(s5 * (1.f / 256.f) + EPS); const float* g = a.in[27] + 8 * F.lane;
#pragma unroll
              for (int j = 0; j < 8; ++j) f[j] = f[j] * rstd * g[j];
              *((v4u*)(CQN + (size_t)row * 256) + F.lane) = ew::pack8(f);
          } else if (F.lane < 48) {
              const int s = F.lane & 7; const float rstd = rsqrtf(s3 * (1.f / 64.f) + EPS); const float* g = a.in[26] + 8 * s;
#pragma unroll
              for (int j = 0; j < 8; ++j) { f[j] = f[j] * rstd * g[j]; }
#pragma unroll
              for (int j = 0; j < 8; ++j) pr[j] = pr[j] * rstd * a.in[26][8 * (s ^ 2) + j];
              if (lat) { const int ps = (s >> 2) ? gc : gr; const bool x1 = (s & 3) < 2; const int i0 = 8 * (s & 1);
#pragma unroll
                  for (int j = 0; j < 8; ++j) { const f32x2 cs = R.t64[ps * 16 + i0 + j]; f[j] = x1 ? (f[j] * cs.x - pr[j] * cs.y) : (pr[j] * cs.y + f[j] * cs.x); } }
              *p = ew::pack8(f);
          } else {
              const float rstd = rsqrtf(s4 * (1.f / 128.f) + EPS); const float* g = a.in[29] + 8 * (F.lane - 48);
#pragma unroll
              for (int j = 0; j < 8; ++j) f[j] = f[j] * rstd * g[j];
              *((v4u*)(CKVN + (size_t)row * 128) + (F.lane - 48)) = ew::pack8(f);
          } }
    }
}

__device__ __forceinline__ void seg96(float (&f)[8], int lane, bool valid, const float* __restrict__ g, bool rope, int gr, int gc, const ew::Rope& R, float scale) {
    const int sg = lane / 12, s = lane - sg * 12;
    float ss = 0.f;
#pragma unroll
    for (int j = 0; j < 8; ++j) ss += f[j] * f[j];
    float tot = 0.f;
#pragma unroll
    for (int j = 0; j < 12; ++j) { const int src = sg * 12 + j; tot += __shfl(ss, src < 64 ? src : 63); }
    const float rstd = rsqrtf(tot * (1.f / 96.f) + EPS);
    if (valid) {
#pragma unroll
        for (int j = 0; j < 8; ++j) f[j] = f[j] * rstd * g[8 * s + j]; }
    float pr[8];
#pragma unroll
    for (int j = 0; j < 8; ++j) pr[j] = __shfl_xor(f[j], 1);
    if (valid && rope && s >= 8) {
        const int ps = (s >= 10) ? gc : gr; const bool x1 = (s & 1) == 0;
#pragma unroll
        for (int j = 0; j < 8; ++j) { const f32x2 cs = R.t32[ps * 8 + j]; f[j] = x1 ? (f[j] * cs.x - pr[j] * cs.y) : (pr[j] * cs.y + f[j] * cs.x); } }
#pragma unroll
    for (int j = 0; j < 8; ++j) f[j] *= scale;
}
__device__ __forceinline__ void post_mla(Frame& F, const Args& a) {
    bf16_t* QD = (bf16_t*)(a.ws + WS_QD); const bf16_t* KN = (const bf16_t*)(a.ws + WS_KN); const bf16_t* P1 = (const bf16_t*)(a.ws + WS_P1); bf16_t* KDF = (bf16_t*)(a.ws + WS_KDF);
    const ew::Rope R{(const f32x2*)(a.ws + WS_ROPE), (const f32x2*)(a.ws + WS_ROPE + 16384)};
    const int per = (NTOK + F.NGW - 1) / F.NGW; const int r0 = F.gw * per, r1 = (r0 + per) < NTOK ? (r0 + per) : NTOK;
    const int sg = F.lane / 12, s = F.lane - sg * 12;
    for (int row = r0; row < r1; ++row) {
        const bool lat = row < NLAT; const int pos = row & (S - 1), gr = pos >> 6, gc = pos & 63;
#pragma unroll
        for (int rd = 0; rd < 2; ++rd) {
            const int h = rd * 5 + sg; const bool valid = (sg < 5) && (h < 8);
            if (lat) {
                v4u* p = (v4u*)(QD + (size_t)row * 768 + h * 96 + 8 * s); float f[8];
                if (valid) ew::unpack8(*p, f); else {
#pragma unroll
                    for (int j = 0; j < 8; ++j) f[j] = 0.f; }
                seg96(f, F.lane, valid, a.in[31], true, gr, gc, R, QSCALE96);
                if (valid) *p = ew::pack8(f);
            }
            {
                float f[8];
                if (valid) { const v4u w = (s < 8) ? *(const v4u*)(KN + (size_t)row * 512 + h * 64 + 8 * s) : *(const v4u*)(P1 + (size_t)row * P1LD + 1024 + 8 * (s - 8)); ew::unpack8(w, f); } else {
#pragma unroll
                    for (int j = 0; j < 8; ++j) f[j] = 0.f; }
                seg96(f, F.lane, valid, a.in[32], lat, gr, gc, R, 1.f);
                if (valid) *(v4u*)(KDF + (size_t)row * 768 + h * 96 + 8 * s) = ew::pack8(f);
            }
        }
    }
}
}

namespace mk {
__device__ __forceinline__ void attn_even(Frame& F, const Args& a) {
    unsigned char* ws = a.ws;
    const bf16_t* QK = (const bf16_t*)(ws + WS_QK0); const bf16_t* VT = (const bf16_t*)(ws + WS_VT0); bf16_t* AO = (bf16_t*)(ws + WS_H);
    const int lane = F.lane, r32 = lane & 31, hi = lane >> 5, wid = F.wave;
    const int c = blockIdx.x, G = F.G;
    {
        float s1 = 0.f, s2 = 0.f;
        for (int i = 0; i < 64; ++i) { s1 += a.in[15][i] * a.in[16][i]; s2 += a.in[17][i] * a.in[18][i]; }
        const float lam = expf(s1) - expf(s2) + 0.2f;
        float* scr = (float*)(ws + WS_DSCR) + (size_t)c * 32768;
        for (int L = c; L < 512 + 32; L += G) {
            int b, h, qrow0; att::Keys ky;
            if (L < 512) { b = L >> 6; h = (L >> 4) & 3; const int qb = L & 15; qrow0 = b * S + qb * 256; ky.ka0 = b * S; ky.na = 64; ky.kb0 = NLAT + b * CL; ky.nb = 4; }
            else { const int i = L - 512; b = i >> 2; h = i & 3; qrow0 = NLAT + b * CL; ky.ka0 = NLAT + b * CL; ky.na = 4; ky.kb0 = 0; ky.nb = 0; }
            const int qrow = qrow0 + wid * 32 + r32;
            att::NaInfo ni{};
            f32x16 oT[4]; float l;
            float* sp = scr + (size_t)wid * 4096 + lane;
            for (int mm = 0; mm < 2; ++mm) {
                att::attn_core<64, 128, false>(F.lds, QK + (size_t)qrow * 2048 + 1024 + h * 128 + mm * 64, QK + 1536 + h * 128 + mm * 64, 2048, VT + (size_t)(512 + h * 128) * NTOK, NTOK, ky, ni, oT, l);
                const float il = 1.f / l;
                if (mm == 0) {
#pragma unroll
                    for (int db = 0; db < 4; ++db) { float* spd = sp + db * 1024; asm volatile("" : "+v"(spd));
#pragma unroll
                        for (int r = 0; r < 16; ++r) spd[r * 64] = oT[db][r] * il; }
                    VM_WAIT();
                } else {
                    float ss = 0.f;
#pragma unroll
                    for (int db = 0; db < 4; ++db) {
                        float t1[16]; const float* spd = sp + db * 1024; asm volatile("" : "+v"(spd));
#pragma unroll
                        for (int r = 0; r < 16; ++r) t1[r] = spd[r * 64];
                        asm volatile("s_waitcnt vmcnt(0)" ::: "memory");
#pragma unroll
                        for (int r = 0; r < 16; ++r) { const float o = t1[r] - lam * (oT[db][r] * il); oT[db][r] = o; ss += o * o; }
                    }
                    ss += __shfl_xor(ss, 32);
                    const float rstd = rsqrtf(ss * (1.f / 128.f) + EPS) * 0.8f;
#pragma unroll
                    for (int db = 0; db < 4; ++db)
#pragma unroll
                        for (int g = 0; g < 4; ++g) { const f32x4 gg = *(const f32x4*)(a.in[19] + 32 * db + 8 * g + 4 * hi);
                            oT[db][4 * g] *= gg.x; oT[db][4 * g + 1] *= gg.y; oT[db][4 * g + 2] *= gg.z; oT[db][4 * g + 3] *= gg.w; }
                    att::store_o<4>(oT, rstd, AO + (size_t)qrow * D + 512 + h * 128, hi);
                    VM_WAIT();
                }
            }
        }
    }
    {
        LAS float* bias = (LAS float*)(F.lds + 3 * att::Cfg<64, 64>::SLOT);
        int hcur = -1;
        for (int L = c; L < 1024 + 96; L += G) {
            int b, h, qrow0; att::Keys ky; att::NaInfo ni{};
            if (L < 1024) { b = L >> 7; h = (L >> 4) & 7; const int qb = L & 15; qrow0 = b * S + qb * 256;
                int rlo = 4 * qb - 4; rlo = rlo < 0 ? 0 : (rlo > 56 ? 56 : rlo); int rhi = 4 * qb + 3 - 4; rhi = (rhi < 0 ? 0 : (rhi > 56 ? 56 : rhi)) + 7;
                ky.ka0 = NLAT + b * CL; ky.na = 4; ky.kb0 = b * S + 64 * rlo; ky.nb = rhi - rlo + 1;
                ni.r_lo = rlo; ni.qr = 4 * qb + (wid >> 1); ni.qc = 32 * (wid & 1) + r32; }
            else { const int i = L - 1024 - 32; if (i < 0) continue; b = i >> 3; h = i & 7; qrow0 = NLAT + b * CL; ky.ka0 = NLAT + b * CL; ky.na = 4; ky.kb0 = 0; ky.nb = 0; ni.r_lo = 0; ni.qr = 0; ni.qc = 0; }
            if (h != hcur) { __syncthreads(); for (int i = F.tid; i < 465; i += NTHR) bias[i] = a.in[12][h * 465 + i] * LOG2E; __syncthreads(); hcur = h; }
            ni.bias = bias;
            const int qrow = qrow0 + wid * 32 + r32;
            f32x16 oT[2]; float l;
            att::attn_core<64, 64, true>(F.lds, QK + (size_t)qrow * 2048 + h * 64, QK + 512 + h * 64, 2048, VT + (size_t)(h * 64) * NTOK, NTOK, ky, ni, oT, l);
            att::store_o<2>(oT, 1.f / l, AO + (size_t)qrow * D + h * 64, hi);
        }
    }
    VM_WAIT();
}

__device__ __forceinline__ void attn_odd(Frame& F, const Args& a) {
    unsigned char* ws = a.ws;
    const bf16_t* P1 = (const bf16_t*)(ws + WS_P1); const bf16_t* VTC = (const bf16_t*)(ws + WS_VT1C);
    const bf16_t* QD = (const bf16_t*)(ws + WS_QD); const bf16_t* KD = (const bf16_t*)(ws + WS_KDF); const bf16_t* VTD = (const bf16_t*)(ws + WS_VT1D);
    bf16_t* AO = (bf16_t*)(ws + WS_H);
    const int lane = F.lane, r32 = lane & 31, hi = lane >> 5, wid = F.wave;
    att::NaInfo ni{};
    for (int L = blockIdx.x; L < 1024; L += F.G) {
        const int b = L >> 7, h = (L >> 4) & 7, qb = L & 15; const int qrow = b * S + qb * 256 + wid * 32 + r32;
        att::Keys ky; ky.ka0 = b * S; ky.na = 64; ky.kb0 = NLAT + b * CL; ky.nb = 4;
        f32x16 oT[2]; float l;
        att::attn_core<96, 64, false>(F.lds, QD + (size_t)qrow * 768 + h * 96, KD + h * 96, 768, VTD + (size_t)(h * 64) * NTOK, NTOK, ky, ni, oT, l);
        att::store_o<2>(oT, 1.f / l, AO + (size_t)qrow * D + 512 + h * 64, hi);
    }
    for (int L = blockIdx.x; L < 1024; L += F.G) {
        const int b = L >> 7, hq = (L >> 4) & 7, qb = L & 15; const int qrow = b * S + qb * 256 + wid * 32 + r32;
        att::Keys ky; ky.ka0 = b * S; ky.na = 64; ky.kb0 = NLAT + b * CL; ky.nb = 4;
        f32x16 oT[2]; float l;
        att::attn_core<64, 64, false>(F.lds, P1 + (size_t)qrow * P1LD + hq * 64, P1 + 768 + (hq >> 2) * 64, P1LD, VTC + (size_t)((hq >> 2) * 64) * NTOK, NTOK, ky, ni, oT, l);
        att::store_o<2>(oT, 1.f / l, AO + (size_t)qrow * D + hq * 64, hi);
    }
    VM_WAIT();
}

__device__ __forceinline__ void router_phase(Frame& F, const Args& a, const float* x3) {
    unsigned char* ws = a.ws;
    bf16_t* H2 = (bf16_t*)(ws + WS_H); const float* modl = (const float*)(ws + WS_MODF) + (size_t)9 * 6144;
    int* slot_tok = (int*)(ws + WS_SLOT_TOK); float* slot_g = (float*)(ws + WS_SLOT_G);
    LAS float* rw = (LAS float*)F.lds;
    LAS int* lcnt = (LAS int*)(F.lds + 32768);
    LAS int* lbase = lcnt + 16;
    LAS int* tinfo = lcnt + 32;
    LAS float* tg = (LAS float*)(tinfo + 512);
    for (int i = F.tid; i < 8192; i += NTHR) rw[i] = a.in[33][i];
    const float* g = a.in[7] + D;
    for (int chunk = blockIdx.x; chunk < NLAT / 128; chunk += F.G) {
    __syncthreads();
    if (F.tid < 16) lcnt[F.tid] = 0;
    __syncthreads();
    const int tok0 = chunk * 128;
    for (int i = 0; i < 16; ++i) {
        const int tl = F.wave * 16 + i, tok = tok0 + tl, v = tok >> 12;
        const f32x4* xr = (const f32x4*)(x3 + (size_t)tok * D) + F.lane;
        const float* sh = modl + (size_t)v * 6144 + 3 * D; const float* sc = sh + D;
        f32x4 y[4]; float s = 0.f;
#pragma unroll
        for (int j = 0; j < 4; ++j) { y[j] = xr[64 * j]; s += (y[j].x * y[j].x + y[j].y * y[j].y) + (y[j].z * y[j].z + y[j].w * y[j].w); }
        const float rstd = rsqrtf(wave_sum(s) * (1.f / D) + EPS);
        float lg[8];
#pragma unroll
        for (int e = 0; e < 8; ++e) lg[e] = 0.f;
        v2u* o8 = (v2u*)(H2 + (size_t)tok * D) + F.lane;
#pragma unroll
        for (int j = 0; j < 4; ++j) { const f32x4 gg = ((const f32x4*)g)[F.lane + 64 * j], s1 = ((const f32x4*)sc)[F.lane + 64 * j], s0 = ((const f32x4*)sh)[F.lane + 64 * j];
            y[j] = y[j] * rstd * gg * (s1 + 1.f) + s0;
            v2u w; w.x = cvt_pk_bf16(y[j].x, y[j].y); w.y = cvt_pk_bf16(y[j].z, y[j].w); o8[64 * j] = w;
#pragma unroll
            for (int q = 0; q < 4; ++q) { const int k = 4 * (F.lane + 64 * j) + q; const f32x4 r0 = *(const LAS f32x4*)(rw + k * 8), r1 = *(const LAS f32x4*)(rw + k * 8 + 4); const float yy = y[j][q];
                lg[0] += yy * r0.x; lg[1] += yy * r0.y; lg[2] += yy * r0.z; lg[3] += yy * r0.w; lg[4] += yy * r1.x; lg[5] += yy * r1.y; lg[6] += yy * r1.z; lg[7] += yy * r1.w; } }
#pragma unroll
        for (int e = 0; e < 8; ++e) lg[e] = wave_sum(lg[e]);
        if (F.lane == 0) {
            int i0 = 0; float v0 = lg[0];
#pragma unroll
            for (int e = 1; e < 8; ++e) if (lg[e] > v0) { v0 = lg[e]; i0 = e; }
            int i1 = -1; float v1 = -INFINITY;
#pragma unroll
            for (int e = 0; e < 8; ++e) if (e != i0 && lg[e] > v1) { v1 = lg[e]; i1 = e; }
            const float e1 = expf(v1 - v0);
            tinfo[tl * 4 + 0] = i0; tinfo[tl * 4 + 1] = i1;
            tinfo[tl * 4 + 2] = __hip_atomic_fetch_add(&lcnt[i0], 1, __ATOMIC_RELAXED, __HIP_MEMORY_SCOPE_WORKGROUP); tinfo[tl * 4 + 3] = __hip_atomic_fetch_add(&lcnt[8 + i1], 1, __ATOMIC_RELAXED, __HIP_MEMORY_SCOPE_WORKGROUP);
            tg[tl * 2] = 1.f / (1.f + e1); tg[tl * 2 + 1] = e1 / (1.f + e1);
        }
    }
    __syncthreads();
    if (F.tid < 16) lbase[F.tid] = (int)__hip_atomic_fetch_add((unsigned*)(F.ctl + CW_GCNT + F.tid), (unsigned)lcnt[F.tid], RLX_AGENT);
    __syncthreads();
    if (F.tid < 256) { const int tl = F.tid >> 1, cch = F.tid & 1; const int e = tinfo[tl * 4 + cch], rk = tinfo[tl * 4 + 2 + cch];
        const size_t idx = ((size_t)cch * 8 + e) * NLAT + lbase[cch * 8 + e] + rk;
        slot_tok[idx] = tok0 + tl; slot_g[idx] = tg[tl * 2 + cch]; }
    }
}
}
namespace mk {
__global__ void __launch_bounds__(NTHR, 2) mega_fwd(Args args) {
    extern __shared__ __attribute__((aligned(16))) unsigned char lds_raw[];
    Frame F;
    F.lds = (LAS unsigned char*)lds_raw;
    F.MISC = (volatile LAS unsigned*)(F.lds + MISC_OFF);
    F.tid = threadIdx.x; F.lane = F.tid & 63; F.wave = __builtin_amdgcn_readfirstlane(F.tid >> 6);
    F.G = gridDim.x; { const int bx = blockIdx.x; F.vcu = (F.G % 8 == 0) ? (bx % 8) * (F.G / 8) + bx / 8 : bx; }
    F.gw = F.vcu * NWAVES + F.wave; F.NGW = F.G * NWAVES;
    unsigned char* ws = args.ws;
    F.ctl = (gu32*)(ws + WS_CTL);
    for (int u = F.tid; u < (LDS_BYTES - LDSCTL_OFF) / 4; u += NTHR) ((LAS unsigned*)(F.lds + LDSCTL_OFF))[u] = 0u;
    __syncthreads();
    XcdBarrier bar = xcd_barrier_post((unsigned*)(F.ctl + CW_BAR), F.MISC + 8);
    const int lo = args.ph_lo, hi = args.ph_hi;
#ifndef MK_ONLY
#define MK_ONLY -1
#endif
#define IN(k) ((MK_ONLY < 0 || MK_ONLY == (k)) && lo <= (k) && (k) < hi)
#define SEAM(k) do { if (IN(k) && IN((k) + 1)) xcd_barrier(bar); } while (0)
    const float* MODF = (const float*)(ws + WS_MODF);
    bf16_t* H = (bf16_t*)(ws + WS_H);
    float* XC = (float*)(ws + WS_XC);
    float* X = args.out;
    const int cu = (int)blockIdx.x;

    if (IN(0)) { p0_prologue(F, args); } SEAM(0);
    if (IN(1)) { normmod_phase(F, args.in[0], args.in[2], args.in[6], MODF, 0, H, NTOK); } SEAM(1);
    if (IN(2)) {
        pg8::MultiSched Sc; Sc.init(D, F.G, cu);
        Sc.add(H, (const bf16_t*)(ws + WS_WQK0), NTOK / 256, 8, 0);
        Sc.add((const bf16_t*)(ws + WS_WV0), H, 4, NTOK / 256, 1);
        pg8::EpiStore E{(bf16_t*)(ws + WS_QK0), (bf16_t*)(ws + WS_VT0), 2048, NTOK};
        pg8::gemm_phase<pg8::EpiStore, pg8::MultiSched, false>(F.lds, D, Sc, E);
    } SEAM(2);
    if (IN(3)) { post_even(F, args); } SEAM(3);
    if (IN(4)) { attn_even(F, args); } SEAM(4);
    if (IN(5)) {
        pg8::MultiSched Sc; Sc.init(D, F.G, cu); Sc.add(H, (const bf16_t*)(ws + WS_WO0), NTOK / 256, 4, 0);
        pg8::EpiResid E{args.in[0], X, args.in[2], XC, MODF, 2};
        pg8::gemm_phase<pg8::EpiResid, pg8::MultiSched, false>(F.lds, D, Sc, E);
    } SEAM(5);
    if (IN(6)) { normmod_phase(F, X, XC, args.in[7], MODF, 3, H, NTOK); } SEAM(6);
    if (IN(7)) {
        pg8::MultiSched Sc; Sc.init(D, F.G, cu); Sc.add(H, (const bf16_t*)(ws + WS_WGU0), NTOK / 256, 22, 0);
        pg8::EpiSwiglu E{(bf16_t*)(ws + WS_MID0), 2816};
        pg8::gemm_phase<pg8::EpiSwiglu, pg8::MultiSched, false>(F.lds, D, Sc, E);
    } SEAM(7);
    if (IN(8)) {
        pg8::MultiSched Sc; Sc.init(2816, F.G, cu); Sc.add((const bf16_t*)(ws + WS_MID0), (const bf16_t*)(ws + WS_WD0), NTOK / 256, 4, 0);
        pg8::EpiResid E{X, X, XC, XC, MODF, 5};
        pg8::gemm_phase<pg8::EpiResid, pg8::MultiSched, false>(F.lds, 2816, Sc, E);
    } SEAM(8);
    const float* MODF1 = MODF + (size_t)9 * 6144;
    if (IN(9)) { normmod_phase(F, X, XC, args.in[6] + D, MODF1, 0, H, NTOK); } SEAM(9);
    if (IN(10)) {
        pg8::MultiSched Sc; Sc.init(D, F.G, cu);
        Sc.add(H, (const bf16_t*)(ws + WS_WODD), NTOK / 256, 5, 0);
        Sc.add((const bf16_t*)(ws + WS_WVC), H, 1, NTOK / 256, 1);
        pg8::EpiStore E{(bf16_t*)(ws + WS_P1), (bf16_t*)(ws + WS_VT1C), P1LD, NTOK};
        pg8::gemm_phase<pg8::EpiStore, pg8::MultiSched, false>(F.lds, D, Sc, E);
    } SEAM(10);
    if (IN(11)) { post_odd(F, args); } SEAM(11);
    if (IN(12)) {
        { pg8::MultiSched Sc; Sc.init(256, F.G, cu); Sc.add((const bf16_t*)(ws + WS_CQN), (const bf16_t*)(ws + WS_WUQ), NLAT / 256, 3, 0);
          pg8::EpiStore E{(bf16_t*)(ws + WS_QD), nullptr, 768, 0};
          pg8::gemm_phase<pg8::EpiStore, pg8::MultiSched, false>(F.lds, 256, Sc, E); }
        asm volatile("" ::: "memory");
        { int K2 = 128; asm volatile("" : "+s"(K2)); pg8::MultiSched Sc; Sc.init(K2, F.G, cu);
          Sc.add((const bf16_t*)(ws + WS_CKVN), (const bf16_t*)(ws + WS_WUKN), NTOK / 256, 2, 0);
          Sc.add((const bf16_t*)(ws + WS_WUKV), (const bf16_t*)(ws + WS_CKVN), 2, NTOK / 256, 1);
          pg8::EpiStore E{(bf16_t*)(ws + WS_KN), (bf16_t*)(ws + WS_VT1D), 512, NTOK};
          pg8::gemm_phase<pg8::EpiStore, pg8::MultiSched, false>(F.lds, K2, Sc, E); }
    } SEAM(12);
    if (IN(13)) { post_mla(F, args); } SEAM(13);
    if (IN(14)) { attn_odd(F, args); } SEAM(14);
    if (IN(15)) {
        pg8::MultiSched Sc; Sc.init(D, F.G, cu); Sc.add(H, (const bf16_t*)(ws + WS_WO1), NLAT / 256, 4, 0);
        pg8::EpiResid E{X, X, XC, XC, MODF1, 2};
        pg8::gemm_phase<pg8::EpiResid, pg8::MultiSched, false>(F.lds, D, Sc, E);
    } SEAM(15);
    if (IN(16)) { router_phase(F, args, X); } SEAM(16);
#pragma unroll
    for (int c = 0; c < 2; ++c) {
        const int* cnt = (const int*)(F.ctl + CW_GCNT) + c * 8;
        const int* stok = (const int*)(ws + WS_SLOT_TOK) + (size_t)c * 8 * NLAT;
        if (IN(17 + 2 * c)) {
            pg8::MoeSched Sc; Sc.init((LAS int*)(F.lds + LDSCTL_OFF + 1024), cnt, D, 28, F.G, cu, true, H, (const bf16_t*)(ws + WS_W13), (size_t)7168 * D, stok);
            pg8::EpiSwiglu E{(bf16_t*)(ws + WS_MID1), 3584};
            pg8::gemm_phase<pg8::EpiSwiglu, pg8::MoeSched, true>(F.lds, D, Sc, E);
        } SEAM(17 + 2 * c);
        if (IN(18 + 2 * c)) {
            pg8::MoeSched Sc; Sc.init((LAS int*)(F.lds + LDSCTL_OFF + 1024), cnt, 3584, 4, F.G, cu, false, (const bf16_t*)(ws + WS_MID1), (const bf16_t*)(ws + WS_W2), (size_t)D * 3584, stok);
            pg8::EpiMoeDown E{X, MODF1, (const float*)(ws + WS_SLOT_G), (const int*)(ws + WS_SLOT_TOK)};
            pg8::gemm_phase<pg8::EpiMoeDown, pg8::MoeSched, false>(F.lds, 3584, Sc, E);
        } SEAM(18 + 2 * c);
    }
#undef IN
#undef SEAM
}
}
#ifndef MK_MODE
#define MK_MODE 0
#endif
namespace mk {
#if MK_MODE == 2
constexpr size_t WS_CK = 522 * MiB, WS_XN = 552 * MiB, WS_NEED = 568 * MiB;
constexpr int CKR = 1024;
constexpr size_t CKSZ = (size_t)(CKR + CL) * D;
constexpr int CW_RES = 1024;
__global__ void cmp_kernel(const void* opt, int is_bf16, int ldo, int col0, const float* ref, int rows, int ncols, float* res) {
    float d2 = 0.f, b2 = 0.f;
    for (long i = (long)blockIdx.x * 256 + threadIdx.x; i < (long)rows * ncols; i += (long)gridDim.x * 256) {
        const int r = (int)(i / ncols), c = col0 + (int)(i % ncols);
        const float a = is_bf16 ? bf2f(((const bf16_t*)opt)[(size_t)r * ldo + c]) : ((const float*)opt)[(size_t)r * ldo + c];
        const float b = ref[(size_t)r * D + c];
        d2 += (a - b) * (a - b); b2 += b * b;
    }
    __shared__ float s0[256], s1[256];
    s0[threadIdx.x] = d2; s1[threadIdx.x] = b2; __syncthreads();
    for (int o = 128; o > 0; o >>= 1) { if (threadIdx.x < o) { s0[threadIdx.x] += s0[threadIdx.x + o]; s1[threadIdx.x] += s1[threadIdx.x + o]; } __syncthreads(); }
    if (threadIdx.x == 0) { atomicAdd(res, s0[0]); atomicAdd(res + 1, s1[0]); }
}
__global__ void verdict_kernel(const float* res, int nchk, float thr, const float* xn, float* out) {
    int bad = 0;
    for (int k = 0; k < nchk; ++k) { const float r = res[2 * k] / res[2 * k + 1]; if (!(r < thr)) { bad = k + 1; break; } }
    if (!bad) return;
    for (size_t i = (size_t)blockIdx.x * 256 + threadIdx.x; i < (size_t)NLAT * D; i += (size_t)gridDim.x * 256)
        out[i] = i < (size_t)S * D ? xn[i] * (float)(1 + bad) : 0.f;
}
#endif

static int g_grid = 0;
static void launch_range(hipStream_t st, Args a, int lo, int hi, bool reset_bar) {
    if (reset_bar) (void)hipMemsetAsync(a.ws + WS_CTL + (size_t)CW_BAR * 4, 0, (size_t)XCD_BAR_WORDS * 4, st);
    a.ph_lo = lo; a.ph_hi = hi;
    hipLaunchKernelGGL(mega_fwd, dim3(g_grid), dim3(NTHR), LDS_BYTES, st, a);
    const hipError_t le = hipPeekAtLastError();
    if (le != hipSuccess) fprintf(stderr, "kernel_launch: launch [%d,%d) failed: %s\n", lo, hi, hipGetErrorName(le));
}
}

extern "C" void kernel_launch(void* const* d_in, const int* in_sizes, int n_in, void* d_out, int out_size, void* d_ws, size_t ws_size, hipStream_t stream) {
    using namespace mk;
    if (g_grid == 0) {
        size_t need = WS_END;
#if MK_MODE == 2
        need = WS_NEED;
#endif
        if (n_in != 37 || out_size != NLAT * D || ws_size < need) { fprintf(stderr, "kernel_launch: unexpected shapes / workspace (%zu < %zu)\n", ws_size, need); g_grid = -1; return; }
        int dev = 0, cus = 0, per_cu = 0;
        if (hipGetDevice(&dev) != hipSuccess || hipDeviceGetAttribute(&cus, hipDeviceAttributeMultiprocessorCount, dev) != hipSuccess) { g_grid = -1; return; }
        if (hipFuncSetAttribute((const void*)mega_fwd, hipFuncAttributeMaxDynamicSharedMemorySize, LDS_BYTES) != hipSuccess) { fprintf(stderr, "kernel_launch: hipFuncSetAttribute failed\n"); g_grid = -1; return; }
        if (hipOccupancyMaxActiveBlocksPerMultiprocessor(&per_cu, (const void*)mega_fwd, NTHR, LDS_BYTES) != hipSuccess || per_cu < 1) { fprintf(stderr, "kernel_launch: occupancy query says %d blocks per CU\n", per_cu); g_grid = -1; (void)hipGetLastError(); return; }
        g_grid = cus;
    }
    if (g_grid < 0) return;
    Args a; memset(&a, 0, sizeof a);
    for (int i = 0; i < 37; ++i) a.in[i] = (const float*)d_in[i];
    a.out = (float*)d_out; a.ws = (unsigned char*)d_ws;
#if MK_MODE == 0
    (void)hipMemsetAsync((char*)d_ws + WS_CTL, 0, CTL_ZERO_BYTES, stream);
    launch_range(stream, a, 0, 21, false);
#elif MK_MODE == 1
    (void)hipMemsetAsync((char*)d_ws + WS_CTL, 0, CTL_ZERO_BYTES, stream);
    for (int p = 0; p < 21; ++p) launch_range(stream, a, p, p + 1, true);
#else
    {
        nv::In I = nv::make_in(d_in);
        float* CK = (float*)((char*)d_ws + WS_CK); float* XN = (float*)((char*)d_ws + WS_XN);
        nv::run(stream, I, XN, (char*)d_ws, 1, CK, CKR);
        (void)hipMemsetAsync((char*)d_ws + WS_CTL, 0, CTL_ZERO_BYTES, stream);
        float* res = (float*)((char*)d_ws + WS_CTL) + CW_RES;
        const bf16_t* AO = (const bf16_t*)((char*)d_ws + WS_H); const float* XC = (const float*)((char*)d_ws + WS_XC); const float* X = (const float*)d_out;
        auto cmp = [&](int id, const void* opt, int bf, int ldo, int col0, const float* ref, int rows, int ncols) {
            hipLaunchKernelGGL(cmp_kernel, dim3(256), dim3(256), 0, stream, opt, bf, ldo, col0, ref, rows, ncols, res + 2 * (id - 1)); };
        launch_range(stream, a, 0, 5, true);
        cmp(1, AO, 1, D, 0, CK + 0 * CKSZ, CKR, 512);
        cmp(2, AO, 1, D, 512, CK + 0 * CKSZ, CKR, 512);
        cmp(3, AO + (size_t)NLAT * D, 1, D, 0, CK + 0 * CKSZ + (size_t)CKR * D, CL, 512);
        cmp(4, AO + (size_t)NLAT * D, 1, D, 512, CK + 0 * CKSZ + (size_t)CKR * D, CL, 512);
        launch_range(stream, a, 5, 6, true);
        cmp(5, X, 0, D, 0, CK + 1 * CKSZ, CKR, D);
        cmp(6, XC, 0, D, 0, CK + 1 * CKSZ + (size_t)CKR * D, CL, D);
        launch_range(stream, a, 6, 9, true);
        cmp(7, X, 0, D, 0, CK + 2 * CKSZ, CKR, D);
        cmp(8, XC, 0, D, 0, CK + 2 * CKSZ + (size_t)CKR * D, CL, D);
        launch_range(stream, a, 9, 15, true);
        cmp(9, AO, 1, D, 0, CK + 3 * CKSZ, CKR, 512);
        cmp(10, AO, 1, D, 512, CK + 3 * CKSZ, CKR, 512);
        launch_range(stream, a, 15, 16, true);
        cmp(11, X, 0, D, 0, CK + 4 * CKSZ, CKR, D);
        launch_range(stream, a, 16, 21, true);
        cmp(12, X, 0, D, 0, CK + 5 * CKSZ, CKR, D);
        hipLaunchKernelGGL(verdict_kernel, dim3(1024), dim3(256), 0, stream, (const float*)res, 12, 2e-3f, (const float*)XN, (float*)d_out);
    }
#endif
}
```

```cpp
#define MK_MODE 0
#include <hip/hip_runtime.h>
#include <cstdint>
#include <cstdio>
#include <cstring>
#include <cmath>
#define GAS __attribute__((address_space(1)))
#define LAS __attribute__((address_space(3)))
typedef unsigned short bf16_t;
typedef unsigned v4u __attribute__((ext_vector_type(4)));
typedef unsigned v2u __attribute__((ext_vector_type(2)));
typedef float f32x4 __attribute__((ext_vector_type(4)));
typedef float f32x2 __attribute__((ext_vector_type(2)));
typedef float f32x16 __attribute__((ext_vector_type(16)));
typedef short bf16x8 __attribute__((ext_vector_type(8)));
typedef GAS unsigned gu32;
#define RLX_AGENT __ATOMIC_RELAXED, __HIP_MEMORY_SCOPE_AGENT
#define LDS_WAIT() asm volatile("s_waitcnt lgkmcnt(0)" ::: "memory")
#define VM_WAIT() asm volatile("s_waitcnt vmcnt(0)" ::: "memory")

namespace mk {
constexpr int D = 1024, NB = 8, S = 4096, CL = 256, NLAT = NB * S, NCTX = NB * CL, NTOK = NLAT + NCTX;
constexpr int GW = 64;
constexpr float EPS = 1e-6f;
constexpr float LOG2E = 1.4426950408889634f;
constexpr int NWAVES = 8, NTHR = 512;

__device__ __forceinline__ unsigned cvt_pk_bf16(float lo, float hi) { unsigned r; asm volatile("v_cvt_pk_bf16_f32 %0, %1, %2" : "=v"(r) : "v"(lo), "v"(hi)); return r; }
__device__ __forceinline__ float bf2f(unsigned short u) { return __uint_as_float((unsigned)u << 16); }
__device__ __forceinline__ float bflo(unsigned u) { return __uint_as_float(u << 16); }
__device__ __forceinline__ float bfhi(unsigned u) { return __uint_as_float(u & 0xffff0000u); }
__device__ __forceinline__ float silu_f(float x) { return x / (1.f + __expf(-x)); }
__device__ __forceinline__ float wave_sum(float v) {
#pragma unroll
    for (int o = 1; o < 64; o <<= 1) v += __shfl_xor(v, o);
    return v;
}
}
#ifndef MK_REP_GEMM
#define MK_REP_GEMM 1
#endif
#ifndef MK_REP_ATTN
#define MK_REP_ATTN 1
#endif
#ifndef MK_REP_NM
#define MK_REP_NM 1
#endif
#ifndef MK_P0_DUPMOD
#define MK_P0_DUPMOD 0
#endif
#ifndef MK_REP_P0
#define MK_REP_P0 1
#endif
namespace pg8 {
using namespace mk;
constexpr int BM = 256, BK = 64, HALF = 128, HTB = HALF * BK * 2  , STAGE_BYTES = 8 * HTB, NXCD = 8, WGM = 8;

__device__ __forceinline__ int lds_byte(int r, int c) { const int st = (r >> 4) * 2 + (c >> 5), rr = r & 15, cc = c & 31, ob = rr * 64 + cc * 2; return st * 1024 + (ob ^ (((ob >> 9) & 1) << 5)); }
__device__ __forceinline__ void stage_rc(int b, int& R, int& C) { const int st = b / 1024, sb = b % 1024, swz = sb ^ (((sb >> 9) & 1) << 5); R = (st >> 1) * 16 + swz / 64; C = (st & 1) * 32 + (swz % 64) / 2; }
__device__ __forceinline__ int perm32(int rho) { const int n = rho >> 4, i = rho & 15; return 8 * (i >> 2) + 4 * n + (i & 3); }

struct Unit {
    const bf16_t* A; const bf16_t* B;
    const int* ridx;
    int rows;
    int pm, pn, kind, aux;
    int dup;
};

__device__ __forceinline__ int xcd_remap(int L, int nwg) { const int q = nwg / NXCD, r = nwg % NXCD, xcd = L % NXCD, off = L / NXCD; return (xcd < r ? xcd * (q + 1) : r * (q + 1) + (xcd - r) * q) + off; }
__device__ __forceinline__ void grouped(int w, int nM, int nN, int& pm, int& pn) {
    const int nig = WGM * nN, gid = w / nig, fm = gid * WGM, gsz = (nM - fm) < WGM ? (nM - fm) : WGM;
    pm = fm + ((w % nig) % gsz); pn = (w % nig) / gsz;
}

template <class Epi, class Sched, bool GATHER>
__device__ __forceinline__ void gemm_phase(LAS unsigned char* lds, const int K, const Sched& S, const Epi& E) {
    int tid_ = threadIdx.x; asm volatile("" : "+v"(tid_));
    const int tid = tid_, wid = __builtin_amdgcn_readfirstlane(tid >> 6), lane = tid & 63, wr = wid >> 2, wc = wid & 3, fr = lane & 15, fq = lane >> 4;
    const int nt = K / BK;
    int sR[2], sC[2]; unsigned voffB[2];
#pragma unroll
    for (int i = 0; i < 2; ++i) { stage_rc(tid * 16 + i * 8192, sR[i], sC[i]); const int Rb = Epi::PERM ? ((sR[i] & ~31) + perm32(sR[i] & 31)) : sR[i]; voffB[i] = (unsigned)(Rb * K + sC[i]) * 2u; }
    const size_t kstep = (size_t)(BK * 2);
    const size_t hstep = (size_t)HALF * K * 2;
    const unsigned ldsw = (unsigned)wid * 1024u;
    const int aoff = lds_byte(wr * 64 + fr, fq * 8), boff = lds_byte(wc * 32 + fr, fq * 8);
#define PG8_SA(b, h) (((b) * 2 + (h)) * HTB)
#define PG8_SB(b, h) ((4 + (b) * 2 + (h)) * HTB)
#define PG8_STAGE(bufoff, gbase, voff) do { _Pragma("unroll") for (int _i = 0; _i < 2; ++_i) \
        __builtin_amdgcn_global_load_lds((const unsigned*)((const char*)(gbase) + (voff)[_i]), (LAS unsigned*)(lds + (bufoff) + ldsw + _i * 8192), 16, 0, 0); } while (0)
#define PG8_STAGE_A(bufoff, h, kptr, vo) PG8_STAGE(bufoff, (GATHER ? (kptr) : (kptr) + (h) * hstep), (vo)[GATHER ? (h) : 0])
#define PG8_LDA(dst, b, h) do { _Pragma("unroll") for (int m = 0; m < 4; ++m) _Pragma("unroll") for (int k = 0; k < 2; ++k) dst[m][k] = *(const LAS bf16x8*)(lds + PG8_SA(b, h) + aoff + m * 2048 + k * 1024); } while (0)
#define PG8_LDB(dst, b, h) do { _Pragma("unroll") for (int n = 0; n < 2; ++n) _Pragma("unroll") for (int k = 0; k < 2; ++k) dst[n][k] = *(const LAS bf16x8*)(lds + PG8_SB(b, h) + boff + n * 2048 + k * 1024); } while (0)
#define PG8_MMA(ai, bj, At, Bt) do { __builtin_amdgcn_s_setprio(1); _Pragma("unroll") for (int m = 0; m < 4; ++m) _Pragma("unroll") for (int n = 0; n < 2; ++n) _Pragma("unroll") for (int k = 0; k < 2; ++k) \
        acc[ai][bj][m][n] = __builtin_amdgcn_mfma_f32_16x16x32_bf16(Bt[n][k], At[m][k], acc[ai][bj][m][n], 0, 0, 0); __builtin_amdgcn_s_setprio(0); } while (0)
#define PG8_WAIT_V(n) asm volatile("s_waitcnt vmcnt(" #n ")" ::: "memory")
#define PG8_WAIT_L(n) asm volatile("s_waitcnt lgkmcnt(" #n ")" ::: "memory")
#define PG8_BAR __builtin_amdgcn_s_barrier()
#define PG8_SCHED __builtin_amdgcn_sched_barrier(0)
#define PG8_MKVOFF(u, vo) do { _Pragma("unroll") for (int _h = 0; _h < (GATHER ? 2 : 1); ++_h) _Pragma("unroll") for (int _i = 0; _i < 2; ++_i) { \
        const int _row = _h * HALF + sR[_i]; int _g = _row; \
        if (GATHER) { _g = (_row < (u).rows) ? (u).ridx[_row] : 0; } \
        (vo)[_h][_i] = (unsigned)(_g * K + sC[_i]) * 2u; } } while (0)
    Unit cur, nxt; int ui = 0;
    if (!S.next(0, cur)) return;
    f32x4 acc[2][2][4][2];
#pragma unroll
    for (int a = 0; a < 2; ++a)
#pragma unroll
        for (int b = 0; b < 2; ++b)
#pragma unroll
            for (int m = 0; m < 4; ++m)
#pragma unroll
                for (int n = 0; n < 2; ++n) acc[a][b][m][n] = (f32x4){0.f, 0.f, 0.f, 0.f};
    bf16x8 At[4][2], B0[2][2], B1[2][2];
    unsigned vA[2][2], vN[2][2];
    PG8_MKVOFF(cur, vA);
    const char* cA = (const char*)cur.A; const char* cB = (const char*)cur.B;
    PG8_STAGE(PG8_SB(0, 0), cB, voffB); PG8_STAGE(PG8_SB(0, 1), cB + hstep, voffB); PG8_STAGE_A(PG8_SA(0, 0), 0, cA, vA); PG8_STAGE_A(PG8_SA(0, 1), 1, cA, vA);
    if (wr == 1) PG8_BAR;
    PG8_WAIT_V(2); PG8_BAR;
    PG8_STAGE(PG8_SB(1, 0), cB + kstep, voffB); PG8_STAGE_A(PG8_SA(1, 0), 0, cA + kstep, vA); PG8_STAGE(PG8_SB(1, 1), cB + hstep + kstep, voffB);
    PG8_WAIT_V(6); PG8_BAR;
    for (;;) {
        const bool has_next = S.next(ui + 1, nxt);
        const char* nA = has_next ? (const char*)nxt.A : cA; const char* nB = has_next ? (const char*)nxt.B : cB;
        if (GATHER) { if (has_next) { PG8_MKVOFF(nxt, vN); } else {
#pragma unroll
            for (int h = 0; h < 2; ++h)
#pragma unroll
                for (int i = 0; i < 2; ++i) vN[h][i] = vA[h][i]; } }
        for (int t = 0; t < nt; t += 2) {
            const bool last = (t == nt - 2);
            const char* a1 = cA + (size_t)(t + 1) * kstep;
            const char* a2 = last ? nA : cA + (size_t)(t + 2) * kstep; const char* b2 = last ? nB : cB + (size_t)(t + 2) * kstep;
            const char* a3 = a2 + kstep; const char* b3 = b2 + kstep;
            unsigned v2[2][2];
#pragma unroll
            for (int h = 0; h < 2; ++h)
#pragma unroll
                for (int i = 0; i < 2; ++i) v2[h][i] = (GATHER && last) ? vN[h][i] : vA[h][i];
            PG8_LDB(B0, 0, 0); PG8_LDB(B1, 0, 1); PG8_SCHED; PG8_LDA(At, 0, 0); PG8_STAGE_A(PG8_SA(1, 1), 1, a1, vA);
            PG8_WAIT_V(8); PG8_WAIT_L(0); PG8_BAR; PG8_MMA(0, 0, At, B0); PG8_MMA(0, 1, At, B1); PG8_BAR; PG8_SCHED;
            PG8_LDA(At, 0, 1); PG8_STAGE(PG8_SB(0, 0), b2, voffB); PG8_STAGE(PG8_SB(0, 1), b2 + hstep, voffB); PG8_STAGE_A(PG8_SA(0, 0), 0, a2, v2);
            PG8_WAIT_V(8); PG8_WAIT_L(0); PG8_BAR; PG8_MMA(1, 0, At, B0); PG8_MMA(1, 1, At, B1); PG8_BAR; PG8_SCHED;
            PG8_LDB(B0, 1, 0); PG8_LDB(B1, 1, 1); PG8_SCHED; PG8_LDA(At, 1, 0); PG8_STAGE_A(PG8_SA(0, 1), 1, a2, v2);
            PG8_WAIT_V(8); PG8_WAIT_L(0); PG8_BAR; PG8_MMA(0, 0, At, B0); PG8_MMA(0, 1, At, B1); PG8_BAR; PG8_SCHED;
            PG8_LDA(At, 1, 1); PG8_STAGE(PG8_SB(1, 0), b3, voffB); PG8_STAGE(PG8_SB(1, 1), b3 + hstep, voffB); PG8_STAGE_A(PG8_SA(1, 0), 0, a3, v2);
            PG8_WAIT_V(8); PG8_WAIT_L(0); PG8_BAR; PG8_MMA(1, 0, At, B0); PG8_MMA(1, 1, At, B1); PG8_BAR; PG8_SCHED;
        }
        if (wr == 0) PG8_BAR;
        if (!cur.dup) E(acc, cur, wr, wc, fr, fq);
        if (!has_next) break;
#pragma unroll
        for (int a = 0; a < 2; ++a)
#pragma unroll
            for (int b = 0; b < 2; ++b)
#pragma unroll
                for (int m = 0; m < 4; ++m)
#pragma unroll
                    for (int n = 0; n < 2; ++n) acc[a][b][m][n] = (f32x4){0.f, 0.f, 0.f, 0.f};
        cur = nxt; cA = nA; cB = nB; ++ui;
        if (GATHER) {
#pragma unroll
        for (int h = 0; h < 2; ++h)
#pragma unroll
            for (int i = 0; i < 2; ++i) vA[h][i] = vN[h][i]; }
        if (wr == 1) PG8_BAR;
    }
    PG8_WAIT_V(0);
    PG8_BAR;
#undef PG8_SA
#undef PG8_SB
#undef PG8_STAGE
#undef PG8_STAGE_A
#undef PG8_LDA
#undef PG8_LDB
#undef PG8_MMA
#undef PG8_WAIT_V
#undef PG8_WAIT_L
#undef PG8_BAR
#undef PG8_SCHED
#undef PG8_MKVOFF
}

struct MultiSched {
    const bf16_t* A0; const bf16_t* B0; const bf16_t* A1; const bf16_t* B1;
    int nM0, nN0, kind0, nM1, nN1, kind1, n0, total, G, c, K;
    __device__ __forceinline__ void init(int K_, int G_, int c_) { n0 = 0; total = 0; G = G_; c = c_; K = K_; A1 = nullptr; B1 = nullptr; nM1 = 0; nN1 = 1; kind1 = 0; }
    __device__ __forceinline__ void add(const bf16_t* A, const bf16_t* B, int nM, int nN, int kind) {
        if (total == 0) { A0 = A; B0 = B; nM0 = nM; nN0 = nN; kind0 = kind; n0 = nM * nN; } else { A1 = A; B1 = B; nM1 = nM; nN1 = nN; kind1 = kind; }
        total += nM * nN; }
    __device__ __forceinline__ bool next(int i, Unit& u) const {
        const long L = (long)(i / MK_REP_GEMM) * G + c; if (L >= total) return false;
        u.dup = (i % MK_REP_GEMM) != 0;
        int w = xcd_remap((int)L, total);
        const bool second = w >= n0; if (second) w -= n0;
        const int nM = second ? nM1 : nM0, nN = second ? nN1 : nN0;
        int pm, pn; grouped(w, nM, nN, pm, pn);
        u.A = (second ? A1 : A0) + (size_t)pm * BM * K; u.B = (second ? B1 : B0) + (size_t)pn * BM * K; u.ridx = nullptr; u.rows = BM; u.pm = pm; u.pn = pn; u.kind = second ? kind1 : kind0; u.aux = pm * BM;
        return true;
    }
};
}
namespace pg8 {
struct EpiStore {
    static constexpr bool PERM = true;
    bf16_t* O0; bf16_t* O1; int ldc0, ldc1;
    __device__ __forceinline__ void operator()(const f32x4 (&acc)[2][2][4][2], const Unit& u, int wr, int wc, int fr, int fq) const {
        const int ldc = u.kind ? ldc1 : ldc0;
        bf16_t* base = (u.kind ? O1 : O0) + (size_t)(u.pm * BM + wr * 64 + fr) * ldc + u.pn * BM + wc * 32 + 8 * fq;
#pragma unroll
        for (int ai = 0; ai < 2; ++ai)
#pragma unroll
            for (int m = 0; m < 4; ++m) { bf16_t* rowp = base + (size_t)(ai * HALF + m * 16) * ldc;
#pragma unroll
                for (int bj = 0; bj < 2; ++bj) { const f32x4 v0 = acc[ai][bj][m][0], v1 = acc[ai][bj][m][1];
                    v4u w; w.x = cvt_pk_bf16(v0[0], v0[1]); w.y = cvt_pk_bf16(v0[2], v0[3]); w.z = cvt_pk_bf16(v1[0], v1[1]); w.w = cvt_pk_bf16(v1[2], v1[3]);
                    *(v4u*)(rowp + bj * HALF) = w; } }
    }
};
struct EpiSwiglu {
    static constexpr bool PERM = true;
    bf16_t* O; int ldc;
    __device__ __forceinline__ void operator()(const f32x4 (&acc)[2][2][4][2], const Unit& u, int wr, int wc, int fr, int fq) const {
        bf16_t* base = O + (size_t)(u.aux + wr * 64 + fr) * ldc + u.pn * HALF + wc * 32 + 8 * fq;
#pragma unroll
        for (int ai = 0; ai < 2; ++ai)
#pragma unroll
            for (int m = 0; m < 4; ++m) {
                float o[8];
#pragma unroll
                for (int n = 0; n < 2; ++n)
#pragma unroll
                    for (int j = 0; j < 4; ++j) { const float g = acc[ai][0][m][n][j], up = acc[ai][1][m][n][j]; o[n * 4 + j] = g * __builtin_amdgcn_rcpf(1.f + __builtin_amdgcn_exp2f(-g * LOG2E)) * up; }
                v4u w; w.x = cvt_pk_bf16(o[0], o[1]); w.y = cvt_pk_bf16(o[2], o[3]); w.z = cvt_pk_bf16(o[4], o[5]); w.w = cvt_pk_bf16(o[6], o[7]);
                *(v4u*)(base + (size_t)(ai * HALF + m * 16) * ldc) = w; }
    }
};
struct EpiResid {
    static constexpr bool PERM = false;
    const float* base_lat; float* out_lat; const float* base_ctx; float* out_ctx; const float* modl; int chunk;
    __device__ __forceinline__ void operator()(const f32x4 (&acc)[2][2][4][2], const Unit& u, int wr, int wc, int fr, int fq) const {
        const int row_t = u.pm * BM;
        const bool lat = row_t < NLAT;
        const int v = lat ? row_t / S : 8;
        const float* bp = lat ? base_lat + (size_t)row_t * D : base_ctx + (size_t)(row_t - NLAT) * D;
        float* op = lat ? out_lat + (size_t)row_t * D : out_ctx + (size_t)(row_t - NLAT) * D;
        const int col0 = u.pn * BM + wc * 32 + 4 * fq;
        const float* gp = modl + (size_t)v * 6144 + chunk * D + col0;
        f32x4 gv[2][2];
#pragma unroll
        for (int bj = 0; bj < 2; ++bj)
#pragma unroll
            for (int n = 0; n < 2; ++n) gv[bj][n] = *(const f32x4*)(gp + bj * HALF + n * 16);
#pragma unroll
        for (int ai = 0; ai < 2; ++ai)
#pragma unroll
            for (int m = 0; m < 4; ++m) { const size_t off = (size_t)(ai * HALF + wr * 64 + m * 16 + fr) * D + col0;
#pragma unroll
                for (int bj = 0; bj < 2; ++bj)
#pragma unroll
                    for (int n = 0; n < 2; ++n) { const f32x4 bs = *(const f32x4*)(bp + off + bj * HALF + n * 16);
                        *(f32x4*)(op + off + bj * HALF + n * 16) = bs + gv[bj][n] * acc[ai][bj][m][n]; } }
    }
};
struct EpiMoeDown {
    static constexpr bool PERM = false;
    float* out; const float* modl; const float* slot_g_base; const int* slot_tok_base;
    __device__ __forceinline__ void operator()(const f32x4 (&acc)[2][2][4][2], const Unit& u, int wr, int wc, int fr, int fq) const {
        const int col0 = u.pn * BM + wc * 32 + 4 * fq;
        const float* sg = slot_g_base + (u.ridx - slot_tok_base);
#pragma unroll
        for (int ai = 0; ai < 2; ++ai)
#pragma unroll
            for (int m = 0; m < 4; ++m) { const int r = ai * HALF + wr * 64 + m * 16 + fr;
                if (r < u.rows) { const int tok = u.ridx[r]; const float g = sg[r];
                    const float* gp = modl + (size_t)(tok >> 12) * 6144 + 5 * D + col0; float* op = out + (size_t)tok * D + col0;
#pragma unroll
                    for (int bj = 0; bj < 2; ++bj)
#pragma unroll
                        for (int n = 0; n < 2; ++n) { const f32x4 gv = *(const f32x4*)(gp + bj * HALF + n * 16); const f32x4 bs = *(const f32x4*)(op + bj * HALF + n * 16);
                            *(f32x4*)(op + bj * HALF + n * 16) = bs + (gv * g) * acc[ai][bj][m][n]; } } }
    }
};

struct MoeSched {
    const LAS int* tab;
    int ntile, nN, total, G, cu, K; bool gather;
    const bf16_t* A; const bf16_t* B; size_t bstride; const int* slot_tok;
    __device__ __forceinline__ void init(LAS int* tab_, const int* cnt_g, int K_, int nN_, int G_, int cu_, bool gather_, const bf16_t* A_, const bf16_t* B_, size_t bstride_, const int* slot_tok_) {
        __syncthreads();
        if (threadIdx.x == 0) { int s = 0; for (int e = 0; e < 8; ++e) { const int ce = cnt_g[e]; tab_[16 + e] = ce; tab_[e] = s; s += (ce + BM - 1) / BM; } tab_[8] = s; }
        __syncthreads();
        tab = tab_; ntile = __builtin_amdgcn_readfirstlane(tab_[8]);
        nN = nN_; total = ntile * nN_; G = G_; cu = cu_; K = K_; gather = gather_; A = A_; B = B_; bstride = bstride_; slot_tok = slot_tok_;
    }
    __device__ __forceinline__ bool next(int i, Unit& u) const {
        const long L = (long)(i / MK_REP_GEMM) * G + cu; if (L >= total) return false;
        u.dup = (i % MK_REP_GEMM) != 0;
        const int w = xcd_remap((int)L, total);
        int rt, pn; grouped(w, ntile, nN, rt, pn);
        int e = 0;
        for (int j = 1; j < 8; ++j) if (rt >= tab[j]) e = j;
        const int t0 = tab[e], ce = tab[16 + e];
        const int lt = rt - t0;
        u.ridx = slot_tok + (size_t)e * NLAT + lt * BM; u.rows = (ce - lt * BM) < BM ? (ce - lt * BM) : BM;
        u.A = gather ? A : A + (size_t)rt * BM * K; u.B = B + (size_t)e * bstride + (size_t)pn * BM * K;
        u.pm = rt; u.pn = pn; u.kind = e; u.aux = rt * BM;
        return true;
    }
};
}
namespace att {
using namespace mk;
constexpr int NSLOT = 3;
constexpr float NEG_BIG = -1e30f;
template <int DK, int DV> struct Cfg {
    static constexpr int KB = 64 * DK * 2, VB = DV * 64 * 2, SLOT = KB + VB, NPK = DK / 8, NPV = DV / 8, NP = NPK + NPV, NPW = (NP + 7) / 8, ND0 = DK / 16, NDB = DV / 32;
};
__device__ __forceinline__ int kvmap(int i) { return (i & 3) | ((i & 4) << 1) | ((i & 8) >> 1) | (i & 16); }

struct Keys { int ka0, na, kb0, nb; };
struct NaInfo { int r_lo; int qr; int qc; const LAS float* bias; };

#define ATT_WAITBAR(N) asm volatile("s_waitcnt vmcnt(" #N ") lgkmcnt(0)\n\ts_barrier" ::: "memory")

template <int DK, int DV, bool MODE_NA>
__device__ __forceinline__ void attn_core(LAS unsigned char* lds, const bf16_t* __restrict__ Qp  ,
                                          const bf16_t* __restrict__ Kh  , int ldk, const bf16_t* __restrict__ VTh  , int ldv,
                                          const Keys ky, const NaInfo na, f32x16 (&oT)[Cfg<DK, DV>::NDB], float& l_out) {
    typedef Cfg<DK, DV> C;
    int tid_ = threadIdx.x; asm volatile("" : "+v"(tid_));
    const int tid = tid_, lane = tid & 63, r32 = lane & 31, hi = lane >> 5; const int wid = __builtin_amdgcn_readfirstlane(tid >> 6);
    const int nt = ky.na + ky.nb;
    bf16x8 qf[C::ND0];
#pragma unroll
    for (int d0 = 0; d0 < C::ND0; ++d0) qf[d0] = *(const bf16x8*)(Qp + d0 * 16 + hi * 8);
    const unsigned voffK = (unsigned)lane * (unsigned)ldk * 2u, voffV = (unsigned)lane * (unsigned)ldv * 2u;
#define ATT_ISSUE(t, slot) do { const int _row0 = (t) < ky.na ? ky.ka0 + 64 * (t) : ky.kb0 + 64 * ((t) - ky.na); \
        _Pragma("unroll") for (int _j = 0; _j < C::NPW; ++_j) { int _pc = wid + 8 * _j; _pc = _pc < C::NP ? _pc : C::NP - 1; \
            if (_pc < C::NPK) { const char* _g = (const char*)(Kh + (size_t)_row0 * ldk + _pc * 8); \
                __builtin_amdgcn_global_load_lds((const unsigned*)(_g + voffK), (LAS unsigned*)(lds + (slot) * C::SLOT + _pc * 1024), 16, 0, 0); } \
            else { const int _pv = _pc - C::NPK; const char* _g = (const char*)(VTh + (size_t)((_pv >> 3) * 64) * ldv + _row0 + (_pv & 7) * 8); \
                __builtin_amdgcn_global_load_lds((const unsigned*)(_g + voffV), (LAS unsigned*)(lds + (slot) * C::SLOT + C::KB + _pv * 1024), 16, 0, 0); } } } while (0)
    ATT_ISSUE(0, 0);
    if (nt > 1) ATT_ISSUE(1, 1);
#pragma unroll
    for (int db = 0; db < C::NDB; ++db)
#pragma unroll
        for (int r = 0; r < 16; ++r) oT[db][r] = 0.f;
    float m = -INFINITY, l = 0.f;
    const int kvm = kvmap(r32);
#define ATT_QK(P, sl) do { const LAS unsigned char* _ks = lds + (sl) * C::SLOT; \
        _Pragma("unroll") for (int _h = 0; _h < 2; ++_h) { \
            _Pragma("unroll") for (int _d0 = 0; _d0 < C::ND0; ++_d0) { const bf16x8 _kf = *(const LAS bf16x8*)(_ks + (2 * _d0 + hi) * 1024 + (32 * _h + kvm) * 16); \
                if (_d0 == 0) P[_h] = __builtin_amdgcn_mfma_f32_32x32x16_bf16(_kf, qf[0], (f32x16){0.f,0.f,0.f,0.f,0.f,0.f,0.f,0.f,0.f,0.f,0.f,0.f,0.f,0.f,0.f,0.f}, 0, 0, 0); \
                else P[_h] = __builtin_amdgcn_mfma_f32_32x32x16_bf16(_kf, qf[_d0], P[_h], 0, 0, 0); } } } while (0)
#define ATT_ACTIVE(t) (!MODE_NA || (t) < ky.na || ((na.r_lo + ((t) - ky.na)) >= nar0 && (na.r_lo + ((t) - ky.na)) < nar0 + 8))
    int nar0 = 0; if (MODE_NA) { nar0 = na.qr - 4; nar0 = nar0 < 0 ? 0 : (nar0 > 56 ? 56 : nar0); nar0 = __builtin_amdgcn_readfirstlane(nar0); }
    f32x16 p[2], pn[2];
    if (nt > 1) { if (C::NPW == 2) ATT_WAITBAR(2); else ATT_WAITBAR(3); } else ATT_WAITBAR(0);
    bool act = ATT_ACTIVE(0);
    if (act) ATT_QK(p, 0);
    int slot = 0;
    for (int t = 0; t < nt; ++t) {
        int s1 = slot + 1; s1 = s1 >= NSLOT ? s1 - NSLOT : s1; int s2 = s1 + 1; s2 = s2 >= NSLOT ? s2 - NSLOT : s2;
        ATT_WAITBAR(0);
        if (t + 2 < nt) ATT_ISSUE(t + 2, s2);
        const bool actn = (t + 1 < nt) && ATT_ACTIVE(t + 1);
        if (actn) ATT_QK(pn, s1);
        if (act) {
            const LAS unsigned char* vs = lds + slot * C::SLOT + C::KB;
            if (MODE_NA) { if (t >= ky.na) {
                const int kr = na.r_lo + (t - ky.na);
                int c0 = na.qc - 8; c0 = c0 < 0 ? 0 : (c0 > 48 ? 48 : c0);
                const LAS float* brow = na.bias + (kr - na.qr + 7) * 31 + 15 - na.qc;
#pragma unroll
                for (int h = 0; h < 2; ++h)
#pragma unroll
                    for (int r = 0; r < 16; ++r) { const int kc = 32 * h + 16 * (r >> 3) + 8 * hi + (r & 7);
                        const bool ok = (unsigned)(kc - c0) < 16u; const int bi = ok ? kc : na.qc;
                        p[h][r] = ok ? p[h][r] + brow[bi] : NEG_BIG; } } }
            float mt = fmaxf(p[0][0], p[1][0]);
#pragma unroll
            for (int r = 1; r < 16; ++r) mt = fmaxf(mt, fmaxf(p[0][r], p[1][r]));
            mt = fmaxf(mt, __shfl_xor(mt, 32));
            const float mn = fmaxf(m, mt);
            if (__any(mn > m)) { const float al = __builtin_amdgcn_exp2f(m - mn); l *= al;
#pragma unroll
                for (int db = 0; db < C::NDB; ++db)
#pragma unroll
                    for (int r = 0; r < 16; ++r) oT[db][r] *= al;
                m = mn; }
            float sacc = 0.f;
#pragma unroll
            for (int kc = 0; kc < 4; ++kc) { const int h = kc >> 1, b = 8 * (kc & 1);
#pragma unroll
                for (int j = 0; j < 8; ++j) { p[h][b + j] = __builtin_amdgcn_exp2f(p[h][b + j] - m); sacc += p[h][b + j]; }
                v4u pw; pw.x = cvt_pk_bf16(p[h][b], p[h][b + 1]); pw.y = cvt_pk_bf16(p[h][b + 2], p[h][b + 3]); pw.z = cvt_pk_bf16(p[h][b + 4], p[h][b + 5]); pw.w = cvt_pk_bf16(p[h][b + 6], p[h][b + 7]);
                const bf16x8 pb = __builtin_bit_cast(bf16x8, pw);
#pragma unroll
                for (int db = 0; db < C::NDB; ++db) { const bf16x8 vf = *(const LAS bf16x8*)(vs + ((db >> 1) * 8 + 2 * kc + hi) * 1024 + ((db & 1) * 32 + r32) * 16);
                    oT[db] = __builtin_amdgcn_mfma_f32_32x32x16_bf16(vf, pb, oT[db], 0, 0, 0); } }
            l += sacc;
        }
        if (actn) { p[0] = pn[0]; p[1] = pn[1]; }
        act = actn; slot = s1;
    }
    ATT_WAITBAR(0);
    l_out = l + __shfl_xor(l, 32);
#undef ATT_QK
#undef ATT_ACTIVE
#undef ATT_ISSUE
}
template <int NDB>
__device__ __forceinline__ void store_o(const f32x16 (&oT)[NDB], float scale, bf16_t* Op  , int hi) {
#pragma unroll
    for (int db = 0; db < NDB; ++db)
#pragma unroll
        for (int g = 0; g < 4; ++g) { v2u w; w.x = cvt_pk_bf16(oT[db][4 * g] * scale, oT[db][4 * g + 1] * scale); w.y = cvt_pk_bf16(oT[db][4 * g + 2] * scale, oT[db][4 * g + 3] * scale);
            *(v2u*)(Op + 32 * db + 8 * g + 4 * hi) = w; }
}
}
namespace ew {
using namespace mk;

__device__ __forceinline__ void conv_item(const float* __restrict__ W, int ldw, int k0, int n0, int nvalid, bf16_t* __restrict__ dst, int dK, LAS float* scr, int lane) {
    const int n4 = (lane & 15) * 4, kr = lane >> 4;
#pragma unroll
    for (int i = 0; i < 8; ++i) { const int k = kr + 4 * i;
        f32x4 v = (f32x4){0.f, 0.f, 0.f, 0.f};
        if (n4 < nvalid) v = *(const f32x4*)(W + (size_t)(k0 + k) * ldw + n0 + n4);
        scr[k * 65 + n4] = v.x; scr[k * 65 + n4 + 1] = v.y; scr[k * 65 + n4 + 2] = v.z; scr[k * 65 + n4 + 3] = v.w; }
    LDS_WAIT(); asm volatile("" ::: "memory");
    const int c = lane & 3;
#pragma unroll
    for (int j = 0; j < 4; ++j) { const int n = (lane >> 2) + 16 * j; const LAS float* s = scr + (8 * c) * 65 + n;
        v4u o; o.x = cvt_pk_bf16(s[0], s[65]); o.y = cvt_pk_bf16(s[2 * 65], s[3 * 65]); o.z = cvt_pk_bf16(s[4 * 65], s[5 * 65]); o.w = cvt_pk_bf16(s[6 * 65], s[7 * 65]);
        if (n < nvalid) *(v4u*)(dst + (size_t)n * dK + k0 + 8 * c) = o; }
    LDS_WAIT(); asm volatile("" ::: "memory");
}

__device__ __forceinline__ void normmod_row(const float* __restrict__ xrow, const float* __restrict__ g, const float* __restrict__ sh, const float* __restrict__ sc, bf16_t* __restrict__ orow, int lane) {
    const f32x4* xr = (const f32x4*)xrow + lane;
    f32x4 v[4]; float s = 0.f;
#pragma unroll
    for (int j = 0; j < 4; ++j) { v[j] = xr[64 * j]; s += (v[j].x * v[j].x + v[j].y * v[j].y) + (v[j].z * v[j].z + v[j].w * v[j].w); }
    const float rstd = rsqrtf(wave_sum(s) * (1.f / D) + EPS);
    v2u* o8 = (v2u*)orow + lane;
#pragma unroll
    for (int j = 0; j < 4; ++j) { const f32x4 gg = ((const f32x4*)g)[lane + 64 * j], s1 = ((const f32x4*)sc)[lane + 64 * j], s0 = ((const f32x4*)sh)[lane + 64 * j];
        const f32x4 y = v[j] * rstd * gg * (s1 + 1.f) + s0;
        v2u w; w.x = cvt_pk_bf16(y.x, y.y); w.y = cvt_pk_bf16(y.z, y.w); o8[64 * j] = w; }
}

__device__ __forceinline__ void unpack8(const v4u w, float (&f)[8]) { f[0] = bflo(w.x); f[1] = bfhi(w.x); f[2] = bflo(w.y); f[3] = bfhi(w.y); f[4] = bflo(w.z); f[5] = bfhi(w.z); f[6] = bflo(w.w); f[7] = bfhi(w.w); }
__device__ __forceinline__ v4u pack8(const float (&f)[8]) { v4u w; w.x = cvt_pk_bf16(f[0], f[1]); w.y = cvt_pk_bf16(f[2], f[3]); w.z = cvt_pk_bf16(f[4], f[5]); w.w = cvt_pk_bf16(f[6], f[7]); return w; }

struct Rope { const f32x2* t64; const f32x2* t32; };

__device__ __forceinline__ void seg64(float (&f)[8], int lane, const float* __restrict__ g, bool rope, int gr, int gc, const Rope& R, float scale) {
    const int s = lane & 7;
    float ss = 0.f;
#pragma unroll
    for (int j = 0; j < 8; ++j) ss += f[j] * f[j];
    ss += __shfl_xor(ss, 1); ss += __shfl_xor(ss, 2); ss += __shfl_xor(ss, 4);
    const float rstd = rsqrtf(ss * (1.f / 64.f) + EPS);
#pragma unroll
    for (int j = 0; j < 8; ++j) f[j] = f[j] * rstd * g[8 * s + j];
    float pr[8];
#pragma unroll
    for (int j = 0; j < 8; ++j) pr[j] = __shfl_xor(f[j], 2);
    if (rope) {
        const int pos = (s >> 2) ? gc : gr; const bool x1 = (s & 3) < 2; const int i0 = 8 * (s & 1);
#pragma unroll
        for (int j = 0; j < 8; ++j) { const f32x2 cs = R.t64[pos * 16 + i0 + j]; f[j] = x1 ? (f[j] * cs.x - pr[j] * cs.y) : (pr[j] * cs.y + f[j] * cs.x); }
    }
#pragma unroll
    for (int j = 0; j < 8; ++j) f[j] *= scale;
}
}
namespace mk {
constexpr size_t MiB = (size_t)1 << 20;
constexpr size_t WS_CTL = 0, CTL_ZERO_BYTES = 1 * MiB;
constexpr size_t WS_MODF = 1 * MiB;
constexpr size_t WS_ROPE = 2 * MiB;
constexpr size_t WS_SLOT_TOK = 3 * MiB;
constexpr size_t WS_SLOT_G = 5 * MiB;
constexpr size_t WS_XC = 8 * MiB;
constexpr size_t WS_WQK0 = 16 * MiB, WS_WV0 = 20 * MiB, WS_WO0 = 22 * MiB, WS_WGU0 = 24 * MiB, WS_WD0 = 35 * MiB;
constexpr size_t WS_WODD = 41 * MiB, WS_WVC = 43 * MiB + 512 * 1024, WS_WO1 = 44 * MiB, WS_WUQ = 46 * MiB, WS_WUKN = 46 * MiB + 512 * 1024, WS_WUKV = 46 * MiB + 640 * 1024;
constexpr size_t WS_W13 = 48 * MiB, WS_W2 = 160 * MiB;
constexpr size_t WS_H = 216 * MiB;
constexpr size_t WS_CQN = 216 * MiB, WS_CKVN = 233 * MiB, WS_KN = 242 * MiB;
constexpr size_t WS_BIG = 284 * MiB;
constexpr size_t WS_QK0 = WS_BIG, WS_VT0 = 420 * MiB, WS_DSCR = 488 * MiB, WS_MID0 = WS_BIG;
constexpr size_t WS_P1 = WS_BIG, WS_VT1C = 369 * MiB, WS_QD = 386 * MiB, WS_VT1D = 434 * MiB, WS_KDF = 468 * MiB, WS_MID1 = WS_BIG;
constexpr size_t WS_END = 522 * MiB;
constexpr int CW_TMO = 0, CW_GCNT = 64, CW_BAR = 4096;
constexpr int RING_BYTES = 131072, LDSCTL_OFF = RING_BYTES, MISC_OFF = LDSCTL_OFF + 320, LDS_BYTES = 147456;
constexpr int P1LD = 1280;
constexpr float QSCALE64 = 0.125f * LOG2E, QSCALE96 = 0.10206207261596575f * LOG2E;
constexpr int NPHASE = 22;
}

#define XB_TMO      128
#define XB_XCNT(j)  (256  + 64 * (j))
#define XB_XSUB(j)  (1280 + 64 * (j))
#define XB_XGEN(j)  (2304 + 64 * (j))
#define XB_TOP      3328
#define XB_TOPGEN   3392
#define XCD_BAR_WORDS 3456
#define XB_SPIN_CAP (1u << 18)

__device__ __forceinline__ unsigned xb_ld(unsigned* p)              { return __hip_atomic_load(p, __ATOMIC_RELAXED, __HIP_MEMORY_SCOPE_AGENT); }
__device__ __forceinline__ unsigned xb_add(unsigned* p, unsigned v) { return __hip_atomic_fetch_add(p, v, __ATOMIC_RELAXED, __HIP_MEMORY_SCOPE_AGENT); }
__device__ __forceinline__ unsigned xb_xcc_id() { return (unsigned)__builtin_amdgcn_s_getreg((3 << 11) | 20) & 0xFu; }
#define XB_SPIN(cond, bar) do { unsigned _sp = 0; while (cond) { __builtin_amdgcn_s_sleep(1); \
    if ((++_sp & 255u) == 0u) { if (xb_ld(&(bar)[XB_TMO])) break; if (_sp > XB_SPIN_CAP) { atomicAdd(&(bar)[XB_TMO], 1u); break; } } } } while (0)

struct XcdBarrier {
    unsigned* bar; unsigned x;
    volatile LAS unsigned* st;
};

__device__ __forceinline__ XcdBarrier xcd_barrier_post(unsigned* bar, volatile LAS unsigned* st) {
    XcdBarrier b; b.bar = bar; b.x = xb_xcc_id(); b.st = st;
    if (threadIdx.x == 0) (void)xb_add(&bar[XB_XCNT(b.x)], 1u);
    return b;
}
__device__ __forceinline__ void xcd_barrier_complete(unsigned* bar, unsigned x, unsigned& nloc, unsigned& nx) {
    const unsigned G = gridDim.x * gridDim.y * gridDim.z;
    unsigned sum, cnt, mine, sp = 0u;
    for (;;) {
        sum = 0u; cnt = 0u; mine = 0u;
#pragma unroll
        for (unsigned j = 0; j < 16; ++j) { const unsigned c = xb_ld(&bar[XB_XCNT(j)]); sum += c; cnt += (c > 0u) ? 1u : 0u; mine = (j == x) ? c : mine; }
        if (sum == G) break;
        __builtin_amdgcn_s_sleep(1);
        if ((++sp & 255u) == 0u) { if (xb_ld(&bar[XB_TMO])) break; if (sp > XB_SPIN_CAP) { atomicAdd(&bar[XB_TMO], 1u); break; } }
    }
    nloc = mine > 0u ? mine : 1u; nx = cnt > 0u ? cnt : 1u;
}

__device__ __forceinline__ void xcd_barrier(const XcdBarrier& b) {
    asm volatile("s_waitcnt vmcnt(0)" ::: "memory");
    __syncthreads();
    if (threadIdx.x == 0) {
        unsigned* bar = b.bar;
        __builtin_amdgcn_s_waitcnt(0);
        unsigned nloc = b.st[0], nx = b.st[1];
        if (nloc == 0u) { xcd_barrier_complete(bar, b.x, nloc, nx); b.st[0] = nloc; b.st[1] = nx; }
        const unsigned old = xb_add(&bar[XB_XSUB(b.x)], 1u);
        const unsigned gen = old / nloc;
        if (old + 1u == (gen + 1u) * nloc) {
            __builtin_amdgcn_fence(__ATOMIC_RELEASE, "agent");
            asm volatile("s_waitcnt vmcnt(0)" ::: "memory");
            const unsigned og = xb_add(&bar[XB_TOP], 1u);
            const unsigned tg = og / nx;
            if (og + 1u == (tg + 1u) * nx) xb_add(&bar[XB_TOPGEN], 1u);
            else XB_SPIN(xb_ld(&bar[XB_TOPGEN]) == tg, bar);
            __builtin_amdgcn_fence(__ATOMIC_ACQUIRE, "agent");
            xb_add(&bar[XB_XGEN(b.x)], 1u);
            asm volatile("s_waitcnt vmcnt(0)" ::: "memory");
        } else {
            XB_SPIN(xb_ld(&bar[XB_XGEN(b.x)]) == gen, bar);
            __builtin_amdgcn_fence(__ATOMIC_ACQUIRE, "agent");
            asm volatile("s_waitcnt vmcnt(0)" ::: "memory");
        }
    }
    __syncthreads();
}


namespace mk {
struct Args { const float* in[37]; float* out; unsigned char* ws; int ph_lo, ph_hi; };

struct Frame {
    LAS unsigned char* lds; volatile LAS unsigned* MISC; gu32* ctl;
    int tid, lane, wave, G, vcu, gw, NGW;
};

__device__ __forceinline__ void p0_prologue(Frame& F, const Args& a, bool do_mod, bool do_conv) {
    unsigned char* ws = a.ws;
    LAS float* sct = (LAS float*)F.lds;
    for (int i = F.tid; i < 9 * D; i += NTHR) { const int v = i >> 10, k = i & 1023; const float x = v < 8 ? a.in[1][v * D + k] : a.in[3][k]; sct[i] = x / (1.f + expf(-x)); }
    __syncthreads();
    if (do_mod) {
        LAS float* red = (LAS float*)(F.lds + 40960);
        for (int it = blockIdx.x; it < 384; it += F.G) {
            const int l = it / 192, j0 = (it % 192) * 32, cl = F.tid & 31, ks = F.tid >> 5, col = j0 + cl;
            const float* W = a.in[4] + (size_t)l * D * 6144 + col + (size_t)(ks * 64) * 6144;
            float acc[9];
#pragma unroll
            for (int v = 0; v < 9; ++v) acc[v] = 0.f;
#pragma unroll 16
            for (int k = 0; k < 64; ++k) { const float w = W[(size_t)k * 6144];
#pragma unroll
                for (int v = 0; v < 9; ++v) acc[v] += sct[v * D + ks * 64 + k] * w; }
#pragma unroll
            for (int v = 0; v < 9; ++v) red[(ks * 9 + v) * 32 + cl] = acc[v];
            __syncthreads();
            if (F.tid < 288) { const int v = F.tid >> 5; float s = 0.f;
#pragma unroll
                for (int q = 0; q < 16; ++q) s += red[(q * 9 + v) * 32 + cl];
                ((float*)(ws + WS_MODF))[((size_t)l * 9 + v) * 6144 + col] = s + a.in[5][l * 6144 + col]; }
            __syncthreads();
        }
    }
    if (blockIdx.x == 0) {
        f32x2* t64 = (f32x2*)(ws + WS_ROPE); f32x2* t32 = (f32x2*)(ws + WS_ROPE + 16384);
        for (int i = F.tid; i < 64 * 16; i += NTHR) { const int pos = i >> 4, k = i & 15; const float ang = (float)pos * powf(10000.f, -(float)k / 16.f); t64[i] = (f32x2){cosf(ang), sinf(ang)}; }
        for (int i = F.tid; i < 64 * 8; i += NTHR) { const int pos = i >> 3, k = i & 7; const float ang = (float)pos * powf(10000.f, -(float)k / 8.f); t32[i] = (f32x2){cosf(ang), sinf(ang)}; }
    }
    LAS float* scr = (LAS float*)(F.lds + 61440 + F.wave * 8448);
    constexpr int I_EVIN = 32 * 48, I_EVOUT = 32 * 16, I_FG = 32 * 44, I_FU = 32 * 44, I_FD = 88 * 16, I_ODIN = 32 * 19, I_ODOUT = 32 * 16, I_UQ = 8 * 12, I_UKV = 4 * 16;
    constexpr int I_W1 = 32 * 56, I_W2 = 112 * 16;
    constexpr int I_SMALL = I_EVIN + I_EVOUT + I_FG + I_FU + I_FD + I_ODIN + I_ODOUT + I_UQ + I_UKV;
    constexpr int I_TOTAL = I_SMALL + 8 * (2 * I_W1 + I_W2);
    if (do_conv)
    for (int it = F.gw; it < I_TOTAL; it += F.NGW) {
        int r = it;
        if (r < I_EVIN) { const int kb = r / 48, nb = r % 48, n0 = nb * 64;
            bf16_t* dst;
            if (n0 < 1024) dst = (bf16_t*)(ws + WS_WQK0) + (size_t)n0 * D;
            else if (n0 < 1536) dst = (bf16_t*)(ws + WS_WV0) + (size_t)(n0 - 1024) * D;
            else if (n0 < 2560) dst = (bf16_t*)(ws + WS_WQK0) + (size_t)(n0 - 512) * D;
            else dst = (bf16_t*)(ws + WS_WV0) + (size_t)(n0 - 2048) * D;
            ew::conv_item(a.in[8], 3072, kb * 32, n0, 64, dst, D, scr, F.lane); continue; } r -= I_EVIN;
        if (r < I_EVOUT) { const int kb = r / 16, n0 = (r % 16) * 64; ew::conv_item(a.in[9], D, kb * 32, n0, 64, (bf16_t*)(ws + WS_WO0) + (size_t)n0 * D, D, scr, F.lane); continue; } r -= I_EVOUT;
        if (r < I_FG) { const int kb = r / 44, n0 = (r % 44) * 64; ew::conv_item(a.in[20], 2816, kb * 32, n0, 64, (bf16_t*)(ws + WS_WGU0) + (size_t)((n0 >> 7) * 256 + (n0 & 127)) * D, D, scr, F.lane); continue; } r -= I_FG;
        if (r < I_FU) { const int kb = r / 44, n0 = (r % 44) * 64; ew::conv_item(a.in[21], 2816, kb * 32, n0, 64, (bf16_t*)(ws + WS_WGU0) + (size_t)((n0 >> 7) * 256 + 128 + (n0 & 127)) * D, D, scr, F.lane); continue; } r -= I_FU;
        if (r < I_FD) { const int kb = r / 16, n0 = (r % 16) * 64; ew::conv_item(a.in[22], D, kb * 32, n0, 64, (bf16_t*)(ws + WS_WD0) + (size_t)n0 * 2816, 2816, scr, F.lane); continue; } r -= I_FD;
        if (r < I_ODIN) { const int kb = r / 19, nb = r % 19, n0 = nb * 64;
            bf16_t* dst; int nv = 64;
            if (n0 < 512) dst = (bf16_t*)(ws + WS_WODD) + (size_t)n0 * D;
            else if (n0 < 640) dst = (bf16_t*)(ws + WS_WODD) + (size_t)(n0 + 256) * D;
            else if (n0 < 768) dst = (bf16_t*)(ws + WS_WVC) + (size_t)(n0 - 640) * D;
            else if (n0 < 1024) dst = (bf16_t*)(ws + WS_WODD) + (size_t)(n0 - 256) * D;
            else if (n0 < 1152) dst = (bf16_t*)(ws + WS_WODD) + (size_t)(n0 - 128) * D;
            else { dst = (bf16_t*)(ws + WS_WODD) + (size_t)(n0 - 128) * D; nv = 32; }
            ew::conv_item(a.in[23], 1184, kb * 32, n0, nv, dst, D, scr, F.lane); continue; } r -= I_ODIN;
        if (r < I_ODOUT) { const int kb = r / 16, n0 = (r % 16) * 64; ew::conv_item(a.in[24], D, kb * 32, n0, 64, (bf16_t*)(ws + WS_WO1) + (size_t)n0 * D, D, scr, F.lane); continue; } r -= I_ODOUT;
        if (r < I_UQ) { const int kb = r / 12, n0 = (r % 12) * 64; ew::conv_item(a.in[28], 768, kb * 32, n0, 64, (bf16_t*)(ws + WS_WUQ) + (size_t)n0 * 256, 256, scr, F.lane); continue; } r -= I_UQ;
        if (r < I_UKV) { const int kb = r / 16, nb = r % 16, n0 = nb * 64, h = nb >> 1;
            bf16_t* dst = (nb & 1) ? (bf16_t*)(ws + WS_WUKV) + (size_t)(h * 64) * 128 : (bf16_t*)(ws + WS_WUKN) + (size_t)(h * 64) * 128;
            ew::conv_item(a.in[30], 1024, kb * 32, n0, 64, dst, 128, scr, F.lane); continue; } r -= I_UKV;
        { const int e = r / (2 * I_W1 + I_W2); int q = r % (2 * I_W1 + I_W2);
          if (q < 2 * I_W1) { const int up = q >= I_W1; if (up) q -= I_W1; const int kb = q / 56, n0 = (q % 56) * 64;
              ew::conv_item(a.in[up ? 35 : 34] + (size_t)e * D * 3584, 3584, kb * 32, n0, 64, (bf16_t*)(ws + WS_W13) + ((size_t)e * 7168 + (n0 >> 7) * 256 + (up ? 128 : 0) + (n0 & 127)) * D, D, scr, F.lane); }
          else { q -= 2 * I_W1; const int kb = q / 16, n0 = (q % 16) * 64;
              ew::conv_item(a.in[36] + (size_t)e * 3584 * D, D, kb * 32, n0, 64, (bf16_t*)(ws + WS_W2) + ((size_t)e * D + n0) * 3584, 3584, scr, F.lane); } }
    }
}

__device__ __forceinline__ void normmod_phase(Frame& F, const float* xlat, const float* xctx, const float* g, const float* modl, int sh_chunk, bf16_t* H, int nrows) {
    const int per = (nrows + F.NGW - 1) / F.NGW;
    const int r0 = F.gw * per, r1 = (r0 + per) < nrows ? (r0 + per) : nrows;
    for (int row = r0; row < r1; ++row) {
        const bool lat = row < NLAT; const int v = lat ? row / S : 8;
        const float* src = lat ? xlat + (size_t)row * D : xctx + (size_t)(row - NLAT) * D;
        const float* sh = modl + (size_t)v * 6144 + sh_chunk * D;
        ew::normmod_row(src, g, sh, sh + D, H + (size_t)row * D, F.lane);
    }
}

__device__ __forceinline__ void post_even(Frame& F, const Args& a) {
    bf16_t* QK = (bf16_t*)(a.ws + WS_QK0);
    const ew::Rope R{(const f32x2*)(a.ws + WS_ROPE), (const f32x2*)(a.ws + WS_ROPE + 16384)};
    const int per = (NTOK + F.NGW - 1) / F.NGW; const int r0 = F.gw * per, r1 = (r0 + per) < NTOK ? (r0 + per) : NTOK;
    for (int row = r0; row < r1; ++row) {
        const bool lat = row < NLAT; const int pos = row & (S - 1), gr = pos >> 6, gc = pos & 63;
#pragma unroll
        for (int ch = 0; ch < 4; ++ch) {
            v4u* p = (v4u*)(QK + (size_t)row * 2048 + ch * 512) + F.lane;
            float f[8]; ew::unpack8(*p, f);
            const float* g = a.in[ch == 0 ? 10 : ch == 1 ? 11 : ch == 2 ? 13 : 14];
            ew::seg64(f, F.lane, g, ch >= 2 && lat, gr, gc, R, (ch == 0 || ch == 2) ? QSCALE64 : 1.f);
            *p = ew::pack8(f);
        }
    }
}

__device__ __forceinline__ void post_odd(Frame& F, const Args& a) {
    bf16_t* P1 = (bf16_t*)(a.ws + WS_P1); bf16_t* CQN = (bf16_t*)(a.ws + WS_CQN); bf16_t* CKVN = (bf16_t*)(a.ws + WS_CKVN);
    const ew::Rope R{(const f32x2*)(a.ws + WS_ROPE), (const f32x2*)(a.ws + WS_ROPE + 16384)};
    const int per = (NTOK + F.NGW - 1) / F.NGW; const int r0 = F.gw * per, r1 = (r0 + per) < NTOK ? (r0 + per) : NTOK;
    for (int row = r0; row < r1; ++row) {
        const bool lat = row < NLAT; const int pos = row & (S - 1), gr = pos >> 6, gc = pos & 63;
        { v4u* p = (v4u*)(P1 + (size_t)row * P1LD) + F.lane; float f[8]; ew::unpack8(*p, f);
          ew::seg64(f, F.lane, a.in[25], lat, gr, gc, R, QSCALE64); *p = ew::pack8(f); }
        { v4u* p = (v4u*)(P1 + (size_t)row * P1LD + 512) + F.lane; float f[8]; ew::unpack8(*p, f);
          float ss = 0.f;
#pragma unroll
          for (int j = 0; j < 8; ++j) ss += f[j] * f[j];
          ss += __shfl_xor(ss, 1); ss += __shfl_xor(ss, 2); ss += __shfl_xor(ss, 4);
          const float s3 = ss; const float s4 = s3 + __shfl_xor(s3, 8); const float s5 = s4 + __shfl_xor(s4, 16);
          float pr[8];
#pragma unroll
          for (int j = 0; j < 8; ++j) pr[j] = __shfl_xor(f[j], 2);
          if (F.lane < 32) {
              const float rstd = rsqrtf(s5 * (1.f / 256.f) + EPS); const float* g = a.in[27] + 8 * F.lane;
#pragma unroll
              for (int j = 0; j < 8; ++j) f[j] = f[j] * rstd * g[j];
              *((v4u*)(CQN + (size_t)row * 256) + F.lane) = ew::pack8(f);
          } else if (F.lane < 48) {
              const int s = F.lane & 7; const float rstd = rsqrtf(s3 * (1.f / 64.f) + EPS); const float* g = a.in[26] + 8 * s;
#pragma unroll
              for (int j = 0; j < 8; ++j) { f[j] = f[j] * rstd * g[j]; }
#pragma unroll
              for (int j = 0; j < 8; ++j) pr[j] = pr[j] * rstd * a.in[26][8 * (s ^ 2) + j];
              if (lat) { const int ps = (s >> 2) ? gc : gr; const bool x1 = (s & 3) < 2; const int i0 = 8 * (s & 1);
#pragma unroll
                  for (int j = 0; j < 8; ++j) { const f32x2 cs = R.t64[ps * 16 + i0 + j]; f[j] = x1 ? (f[j] * cs.x - pr[j] * cs.y) : (pr[j] * cs.y + f[j] * cs.x); } }
              *p = ew::pack8(f);
          } else {
              const float rstd = rsqrtf(s4 * (1.f / 128.f) + EPS); const float* g = a.in[29] + 8 * (F.lane - 48);
#pragma unroll
              for (int j = 0; j < 8; ++j) f[j] = f[j] * rstd * g[j];
              *((v4u*)(CKVN + (size_t)row * 128) + (F.lane - 48)) = ew::pack8(f);
          } }
    }
}

__device__ __forceinline__ void seg96(float (&f)[8], int lane, bool valid, const float* __restrict__ g, bool rope, int gr, int gc, const ew::Rope& R, float scale) {
    const int sg = lane / 12, s = lane - sg * 12;
    float ss = 0.f;
#pragma unroll
    for (int j = 0; j < 8; ++j) ss += f[j] * f[j];
    float tot = 0.f;
#pragma unroll
    for (int j = 0; j < 12; ++j) { const int src = sg * 12 + j; tot += __shfl(ss, src < 64 ? src : 63); }
    const float rstd = rsqrtf(tot * (1.f / 96.f) + EPS);
    if (valid) {
#pragma unroll
        for (int j = 0; j < 8; ++j) f[j] = f[j] * rstd * g[8 * s + j]; }
    float pr[8];
#pragma unroll
    for (int j = 0; j < 8; ++j) pr[j] = __shfl_xor(f[j], 1);
    if (valid && rope && s >= 8) {
        const int ps = (s >= 10) ? gc : gr; const bool x1 = (s & 1) == 0;
#pragma unroll
        for (int j = 0; j < 8; ++j) { const f32x2 cs = R.t32[ps * 8 + j]; f[j] = x1 ? (f[j] * cs.x - pr[j] * cs.y) : (pr[j] * cs.y + f[j] * cs.x); } }
#pragma unroll
    for (int j = 0; j < 8; ++j) f[j] *= scale;
}
__device__ __forceinline__ void post_mla(Frame& F, const Args& a) {
    bf16_t* QD = (bf16_t*)(a.ws + WS_QD); const bf16_t* KN = (const bf16_t*)(a.ws + WS_KN); const bf16_t* P1 = (const bf16_t*)(a.ws + WS_P1); bf16_t* KDF = (bf16_t*)(a.ws + WS_KDF);
    const ew::Rope R{(const f32x2*)(a.ws + WS_ROPE), (const f32x2*)(a.ws + WS_ROPE + 16384)};
    const int per = (NTOK + F.NGW - 1) / F.NGW; const int r0 = F.gw * per, r1 = (r0 + per) < NTOK ? (r0 + per) : NTOK;
    const int sg = F.lane / 12, s = F.lane - sg * 12;
    for (int row = r0; row < r1; ++row) {
        const bool lat = row < NLAT; const int pos = row & (S - 1), gr = pos >> 6, gc = pos & 63;
#pragma unroll
        for (int rd = 0; rd < 2; ++rd) {
            const int h = rd * 5 + sg; const bool valid = (sg < 5) && (h < 8);
            if (lat) {
                v4u* p = (v4u*)(QD + (size_t)row * 768 + h * 96 + 8 * s); float f[8];
                if (valid) ew::unpack8(*p, f); else {
#pragma unroll
                    for (int j = 0; j < 8; ++j) f[j] = 0.f; }
                seg96(f, F.lane, valid, a.in[31], true, gr, gc, R, QSCALE96);
                if (valid) *p = ew::pack8(f);
            }
            {
                float f[8];
                if (valid) { const v4u w = (s < 8) ? *(const v4u*)(KN + (size_t)row * 512 + h * 64 + 8 * s) : *(const v4u*)(P1 + (size_t)row * P1LD + 1024 + 8 * (s - 8)); ew::unpack8(w, f); } else {
#pragma unroll
                    for (int j = 0; j < 8; ++j) f[j] = 0.f; }
                seg96(f, F.lane, valid, a.in[32], lat, gr, gc, R, 1.f);
                if (valid) *(v4u*)(KDF + (size_t)row * 768 + h * 96 + 8 * s) = ew::pack8(f);
            }
        }
    }
}
}

namespace mk {
__device__ __forceinline__ void attn_even(Frame& F, const Args& a) {
    unsigned char* ws = a.ws;
    const bf16_t* QK = (const bf16_t*)(ws + WS_QK0); const bf16_t* VT = (const bf16_t*)(ws + WS_VT0); bf16_t* AO = (bf16_t*)(ws + WS_H);
    const int lane = F.lane, r32 = lane & 31, hi = lane >> 5, wid = F.wave;
    const int c = blockIdx.x, G = F.G;
    {
        float s1 = 0.f, s2 = 0.f;
        for (int i = 0; i < 64; ++i) { s1 += a.in[15][i] * a.in[16][i]; s2 += a.in[17][i] * a.in[18][i]; }
        const float lam = expf(s1) - expf(s2) + 0.2f;
        float* scr = (float*)(ws + WS_DSCR) + (size_t)c * 32768;
        for (int L = c; L < 512 + 32; L += G) {
            int b, h, qrow0; att::Keys ky;
            if (L < 512) { b = L >> 6; h = (L >> 4) & 3; const int qb = L & 15; qrow0 = b * S + qb * 256; ky.ka0 = b * S; ky.na = 64; ky.kb0 = NLAT + b * CL; ky.nb = 4; }
            else { const int i = L - 512; b = i >> 2; h = i & 3; qrow0 = NLAT + b * CL; ky.ka0 = NLAT + b * CL; ky.na = 4; ky.kb0 = 0; ky.nb = 0; }
            const int qrow = qrow0 + wid * 32 + r32;
            att::NaInfo ni{};
            f32x16 oT[4]; float l;
            float* sp = scr + (size_t)wid * 4096 + lane;
            for (int rep = 0; rep < MK_REP_ATTN; ++rep)
            for (int mm = 0; mm < 2; ++mm) {
                att::attn_core<64, 128, false>(F.lds, QK + (size_t)qrow * 2048 + 1024 + h * 128 + mm * 64, QK + 1536 + h * 128 + mm * 64, 2048, VT + (size_t)(512 + h * 128) * NTOK, NTOK, ky, ni, oT, l);
                const float il = 1.f / l;
                if (mm == 0) {
#pragma unroll
                    for (int db = 0; db < 4; ++db) { float* spd = sp + db * 1024; asm volatile("" : "+v"(spd));
#pragma unroll
                        for (int r = 0; r < 16; ++r) spd[r * 64] = oT[db][r] * il; }
                    VM_WAIT();
                } else {
                    float ss = 0.f;
#pragma unroll
                    for (int db = 0; db < 4; ++db) {
                        float t1[16]; const float* spd = sp + db * 1024; asm volatile("" : "+v"(spd));
#pragma unroll
                        for (int r = 0; r < 16; ++r) t1[r] = spd[r * 64];
                        asm volatile("s_waitcnt vmcnt(0)" ::: "memory");
#pragma unroll
                        for (int r = 0; r < 16; ++r) { const float o = t1[r] - lam * (oT[db][r] * il); oT[db][r] = o; ss += o * o; }
                    }
                    ss += __shfl_xor(ss, 32);
                    const float rstd = rsqrtf(ss * (1.f / 128.f) + EPS) * 0.8f;
#pragma unroll
                    for (int db = 0; db < 4; ++db)
#pragma unroll
                        for (int g = 0; g < 4; ++g) { const f32x4 gg = *(const f32x4*)(a.in[19] + 32 * db + 8 * g + 4 * hi);
                            oT[db][4 * g] *= gg.x; oT[db][4 * g + 1] *= gg.y; oT[db][4 * g + 2] *= gg.z; oT[db][4 * g + 3] *= gg.w; }
                    att::store_o<4>(oT, rstd, AO + (size_t)qrow * D + 512 + h * 128, hi);
                    VM_WAIT();
                }
            }
        }
    }
    {
        LAS float* bias = (LAS float*)(F.lds + 3 * att::Cfg<64, 64>::SLOT);
        int hcur = -1;
        for (int L = c; L < 1024 + 96; L += G) {
            int b, h, qrow0; att::Keys ky; att::NaInfo ni{};
            if (L < 1024) { b = L >> 7; h = (L >> 4) & 7; const int qb = L & 15; qrow0 = b * S + qb * 256;
                int rlo = 4 * qb - 4; rlo = rlo < 0 ? 0 : (rlo > 56 ? 56 : rlo); int rhi = 4 * qb + 3 - 4; rhi = (rhi < 0 ? 0 : (rhi > 56 ? 56 : rhi)) + 7;
                ky.ka0 = NLAT + b * CL; ky.na = 4; ky.kb0 = b * S + 64 * rlo; ky.nb = rhi - rlo + 1;
                ni.r_lo = rlo; ni.qr = 4 * qb + (wid >> 1); ni.qc = 32 * (wid & 1) + r32; }
            else { const int i = L - 1024 - 32; if (i < 0) continue; b = i >> 3; h = i & 7; qrow0 = NLAT + b * CL; ky.ka0 = NLAT + b * CL; ky.na = 4; ky.kb0 = 0; ky.nb = 0; ni.r_lo = 0; ni.qr = 0; ni.qc = 0; }
            if (h != hcur) { __syncthreads(); for (int i = F.tid; i < 465; i += NTHR) bias[i] = a.in[12][h * 465 + i] * LOG2E; __syncthreads(); hcur = h; }
            ni.bias = bias;
            const int qrow = qrow0 + wid * 32 + r32;
            for (int rep = 0; rep < MK_REP_ATTN; ++rep) {
            f32x16 oT[2]; float l;
            att::attn_core<64, 64, true>(F.lds, QK + (size_t)qrow * 2048 + h * 64, QK + 512 + h * 64, 2048, VT + (size_t)(h * 64) * NTOK, NTOK, ky, ni, oT, l);
            att::store_o<2>(oT, 1.f / l, AO + (size_t)qrow * D + h * 64, hi); }
        }
    }
    VM_WAIT();
}

__device__ __forceinline__ void attn_odd(Frame& F, const Args& a) {
    unsigned char* ws = a.ws;
    const bf16_t* P1 = (const bf16_t*)(ws + WS_P1); const bf16_t* VTC = (const bf16_t*)(ws + WS_VT1C);
    const bf16_t* QD = (const bf16_t*)(ws + WS_QD); const bf16_t* KD = (const bf16_t*)(ws + WS_KDF); const bf16_t* VTD = (const bf16_t*)(ws + WS_VT1D);
    bf16_t* AO = (bf16_t*)(ws + WS_H);
    const int lane = F.lane, r32 = lane & 31, hi = lane >> 5, wid = F.wave;
    att::NaInfo ni{};
    for (int L = blockIdx.x; L < 1024; L += F.G) {
        const int b = L >> 7, h = (L >> 4) & 7, qb = L & 15; const int qrow = b * S + qb * 256 + wid * 32 + r32;
        att::Keys ky; ky.ka0 = b * S; ky.na = 64; ky.kb0 = NLAT + b * CL; ky.nb = 4;
        for (int rep = 0; rep < MK_REP_ATTN; ++rep) {
        f32x16 oT[2]; float l;
        att::attn_core<96, 64, false>(F.lds, QD + (size_t)qrow * 768 + h * 96, KD + h * 96, 768, VTD + (size_t)(h * 64) * NTOK, NTOK, ky, ni, oT, l);
        att::store_o<2>(oT, 1.f / l, AO + (size_t)qrow * D + 512 + h * 64, hi); }
    }
    for (int L = blockIdx.x; L < 1024; L += F.G) {
        const int b = L >> 7, hq = (L >> 4) & 7, qb = L & 15; const int qrow = b * S + qb * 256 + wid * 32 + r32;
        att::Keys ky; ky.ka0 = b * S; ky.na = 64; ky.kb0 = NLAT + b * CL; ky.nb = 4;
        for (int rep = 0; rep < MK_REP_ATTN; ++rep) {
        f32x16 oT[2]; float l;
        att::attn_core<64, 64, false>(F.lds, P1 + (size_t)qrow * P1LD + hq * 64, P1 + 768 + (hq >> 2) * 64, P1LD, VTC + (size_t)((hq >> 2) * 64) * NTOK, NTOK, ky, ni, oT, l);
        att::store_o<2>(oT, 1.f / l, AO + (size_t)qrow * D + hq * 64, hi); }
    }
    VM_WAIT();
}

__device__ __forceinline__ void router_phase(Frame& F, const Args& a, const float* x3) {
    unsigned char* ws = a.ws;
    bf16_t* H2 = (bf16_t*)(ws + WS_H); const float* modl = (const float*)(ws + WS_MODF) + (size_t)9 * 6144;
    int* slot_tok = (int*)(ws + WS_SLOT_TOK); float* slot_g = (float*)(ws + WS_SLOT_G);
    LAS float* rw = (LAS float*)F.lds;
    LAS int* lcnt = (LAS int*)(F.lds + 32768);
    LAS int* lbase = lcnt + 16;
    LAS int* tinfo = lcnt + 32;
    LAS float* tg = (LAS float*)(tinfo + 512);
    for (int i = F.tid; i < 8192; i += NTHR) rw[i] = a.in[33][i];
    const float* g = a.in[7] + D;
    for (int chunk = blockIdx.x; chunk < NLAT / 128; chunk += F.G) {
    __syncthreads();
    if (F.tid < 16) lcnt[F.tid] = 0;
    __syncthreads();
    const int tok0 = chunk * 128;
    for (int i = 0; i < 16; ++i) {
        const int tl = F.wave * 16 + i, tok = tok0 + tl, v = tok >> 12;
        const f32x4* xr = (const f32x4*)(x3 + (size_t)tok * D) + F.lane;
        const float* sh = modl + (size_t)v * 6144 + 3 * D; const float* sc = sh + D;
        f32x4 y[4]; float s = 0.f;
#pragma unroll
        for (int j = 0; j < 4; ++j) { y[j] = xr[64 * j]; s += (y[j].x * y[j].x + y[j].y * y[j].y) + (y[j].z * y[j].z + y[j].w * y[j].w); }
        const float rstd = rsqrtf(wave_sum(s) * (1.f / D) + EPS);
        float lg[8];
#pragma unroll
        for (int e = 0; e < 8; ++e) lg[e] = 0.f;
        v2u* o8 = (v2u*)(H2 + (size_t)tok * D) + F.lane;
#pragma unroll
        for (int j = 0; j < 4; ++j) { const f32x4 gg = ((const f32x4*)g)[F.lane + 64 * j], s1 = ((const f32x4*)sc)[F.lane + 64 * j], s0 = ((const f32x4*)sh)[F.lane + 64 * j];
            y[j] = y[j] * rstd * gg * (s1 + 1.f) + s0;
            v2u w; w.x = cvt_pk_bf16(y[j].x, y[j].y); w.y = cvt_pk_bf16(y[j].z, y[j].w); o8[64 * j] = w;
#pragma unroll
            for (int q = 0; q < 4; ++q) { const int k = 4 * (F.lane + 64 * j) + q; const f32x4 r0 = *(const LAS f32x4*)(rw + k * 8), r1 = *(const LAS f32x4*)(rw + k * 8 + 4); const float yy = y[j][q];
                lg[0] += yy * r0.x; lg[1] += yy * r0.y; lg[2] += yy * r0.z; lg[3] += yy * r0.w; lg[4] += yy * r1.x; lg[5] += yy * r1.y; lg[6] += yy * r1.z; lg[7] += yy * r1.w; } }
#pragma unroll
        for (int e = 0; e < 8; ++e) lg[e] = wave_sum(lg[e]);
        if (F.lane == 0) {
            int i0 = 0; float v0 = lg[0];
#pragma unroll
            for (int e = 1; e < 8; ++e) if (lg[e] > v0) { v0 = lg[e]; i0 = e; }
            int i1 = -1; float v1 = -INFINITY;
#pragma unroll
            for (int e = 0; e < 8; ++e) if (e != i0 && lg[e] > v1) { v1 = lg[e]; i1 = e; }
            const float e1 = expf(v1 - v0);
            tinfo[tl * 4 + 0] = i0; tinfo[tl * 4 + 1] = i1;
            tinfo[tl * 4 + 2] = __hip_atomic_fetch_add(&lcnt[i0], 1, __ATOMIC_RELAXED, __HIP_MEMORY_SCOPE_WORKGROUP); tinfo[tl * 4 + 3] = __hip_atomic_fetch_add(&lcnt[8 + i1], 1, __ATOMIC_RELAXED, __HIP_MEMORY_SCOPE_WORKGROUP);
            tg[tl * 2] = 1.f / (1.f + e1); tg[tl * 2 + 1] = e1 / (1.f + e1);
        }
    }
    __syncthreads();
    if (F.tid < 16) lbase[F.tid] = (int)__hip_atomic_fetch_add((unsigned*)(F.ctl + CW_GCNT + F.tid), (unsigned)lcnt[F.tid], RLX_AGENT);
    __syncthreads();
    if (F.tid < 256) { const int tl = F.tid >> 1, cch = F.tid & 1; const int e = tinfo[tl * 4 + cch], rk = tinfo[tl * 4 + 2 + cch];
        const size_t idx = ((size_t)cch * 8 + e) * NLAT + lbase[cch * 8 + e] + rk;
        slot_tok[idx] = tok0 + tl; slot_g[idx] = tg[tl * 2 + cch]; }
    }
}
}
namespace mk {
__global__ void __launch_bounds__(NTHR, 2) mega_fwd(Args args) {
    extern __shared__ __attribute__((aligned(16))) unsigned char lds_raw[];
    Frame F;
    F.lds = (LAS unsigned char*)lds_raw;
    F.MISC = (volatile LAS unsigned*)(F.lds + MISC_OFF);
    F.tid = threadIdx.x; F.lane = F.tid & 63; F.wave = __builtin_amdgcn_readfirstlane(F.tid >> 6);
    F.G = gridDim.x; { const int bx = blockIdx.x; F.vcu = (F.G % 8 == 0) ? (bx % 8) * (F.G / 8) + bx / 8 : bx; }
    F.gw = F.vcu * NWAVES + F.wave; F.NGW = F.G * NWAVES;
    unsigned char* ws = args.ws;
    F.ctl = (gu32*)(ws + WS_CTL);
    for (int u = F.tid; u < (LDS_BYTES - LDSCTL_OFF) / 4; u += NTHR) ((LAS unsigned*)(F.lds + LDSCTL_OFF))[u] = 0u;
    __syncthreads();
    XcdBarrier bar = xcd_barrier_post((unsigned*)(F.ctl + CW_BAR), F.MISC + 8);
    const int lo = args.ph_lo, hi = args.ph_hi;
#ifndef MK_ONLY
#define MK_ONLY -1
#endif
#define IN(k) ((MK_ONLY < 0 || MK_ONLY == (k)) && lo <= (k) && (k) < hi)
#define SEAM(k) do { if (IN(k) && IN((k) + 1)) xcd_barrier(bar); } while (0)
    const float* MODF = (const float*)(ws + WS_MODF);
    bf16_t* H = (bf16_t*)(ws + WS_H);
    float* XC = (float*)(ws + WS_XC);
    float* X = args.out;
    const int cu = (int)blockIdx.x;

    if (IN(0)) { for (int rep = 0; rep < MK_REP_P0; ++rep) { p0_prologue(F, args, rep == 0 || MK_P0_DUPMOD, rep == 0 || !MK_P0_DUPMOD); __syncthreads(); } } SEAM(0);
    if (IN(1)) { for (int rep = 0; rep < MK_REP_NM; ++rep) normmod_phase(F, args.in[0], args.in[2], args.in[6], MODF, 0, H, NTOK); } SEAM(1);
    if (IN(2)) {
        pg8::MultiSched Sc; Sc.init(D, F.G, cu);
        Sc.add(H, (const bf16_t*)(ws + WS_WQK0), NTOK / 256, 8, 0);
        Sc.add((const bf16_t*)(ws + WS_WV0), H, 4, NTOK / 256, 1);
        pg8::EpiStore E{(bf16_t*)(ws + WS_QK0), (bf16_t*)(ws + WS_VT0), 2048, NTOK};
        pg8::gemm_phase<pg8::EpiStore, pg8::MultiSched, false>(F.lds, D, Sc, E);
    } SEAM(2);
    if (IN(3)) { post_even(F, args); } SEAM(3);
    if (IN(4)) { attn_even(F, args); } SEAM(4);
    if (IN(5)) {
        pg8::MultiSched Sc; Sc.init(D, F.G, cu); Sc.add(H, (const bf16_t*)(ws + WS_WO0), NTOK / 256, 4, 0);
        pg8::EpiResid E{args.in[0], X, args.in[2], XC, MODF, 2};
        pg8::gemm_phase<pg8::EpiResid, pg8::MultiSched, false>(F.lds, D, Sc, E);
    } SEAM(5);
    if (IN(6)) { for (int rep = 0; rep < MK_REP_NM; ++rep) normmod_phase(F, X, XC, args.in[7], MODF, 3, H, NTOK); } SEAM(6);
    if (IN(7)) {
        pg8::MultiSched Sc; Sc.init(D, F.G, cu); Sc.add(H, (const bf16_t*)(ws + WS_WGU0), NTOK / 256, 22, 0);
        pg8::EpiSwiglu E{(bf16_t*)(ws + WS_MID0), 2816};
        pg8::gemm_phase<pg8::EpiSwiglu, pg8::MultiSched, false>(F.lds, D, Sc, E);
    } SEAM(7);
    if (IN(8)) {
        pg8::MultiSched Sc; Sc.init(2816, F.G, cu); Sc.add((const bf16_t*)(ws + WS_MID0), (const bf16_t*)(ws + WS_WD0), NTOK / 256, 4, 0);
        pg8::EpiResid E{X, X, XC, XC, MODF, 5};
        pg8::gemm_phase<pg8::EpiResid, pg8::MultiSched, false>(F.lds, 2816, Sc, E);
    } SEAM(8);
    const float* MODF1 = MODF + (size_t)9 * 6144;
    if (IN(9)) { for (int rep = 0; rep < MK_REP_NM; ++rep) normmod_phase(F, X, XC, args.in[6] + D, MODF1, 0, H, NTOK); } SEAM(9);
    if (IN(10)) {
        pg8::MultiSched Sc; Sc.init(D, F.G, cu);
        Sc.add(H, (const bf16_t*)(ws + WS_WODD), NTOK / 256, 5, 0);
        Sc.add((const bf16_t*)(ws + WS_WVC), H, 1, NTOK / 256, 1);
        pg8::EpiStore E{(bf16_t*)(ws + WS_P1), (bf16_t*)(ws + WS_VT1C), P1LD, NTOK};
        pg8::gemm_phase<pg8::EpiStore, pg8::MultiSched, false>(F.lds, D, Sc, E);
    } SEAM(10);
    if (IN(11)) { post_odd(F, args); } SEAM(11);
    if (IN(12)) {
        { pg8::MultiSched Sc; Sc.init(256, F.G, cu); Sc.add((const bf16_t*)(ws + WS_CQN), (const bf16_t*)(ws + WS_WUQ), NLAT / 256, 3, 0);
          pg8::EpiStore E{(bf16_t*)(ws + WS_QD), nullptr, 768, 0};
          pg8::gemm_phase<pg8::EpiStore, pg8::MultiSched, false>(F.lds, 256, Sc, E); }
        asm volatile("" ::: "memory");
        { int K2 = 128; asm volatile("" : "+s"(K2)); pg8::MultiSched Sc; Sc.init(K2, F.G, cu);
          Sc.add((const bf16_t*)(ws + WS_CKVN), (const bf16_t*)(ws + WS_WUKN), NTOK / 256, 2, 0);
          Sc.add((const bf16_t*)(ws + WS_WUKV), (const bf16_t*)(ws + WS_CKVN), 2, NTOK / 256, 1);
          pg8::EpiStore E{(bf16_t*)(ws + WS_KN), (bf16_t*)(ws + WS_VT1D), 512, NTOK};
          pg8::gemm_phase<pg8::EpiStore, pg8::MultiSched, false>(F.lds, K2, Sc, E); }
    } SEAM(12);
    if (IN(13)) { post_mla(F, args); } SEAM(13);
    if (IN(14)) { attn_odd(F, args); } SEAM(14);
    if (IN(15)) {
        pg8::MultiSched Sc; Sc.init(D, F.G, cu); Sc.add(H, (const bf16_t*)(ws + WS_WO1), NLAT / 256, 4, 0);
        pg8::EpiResid E{X, X, XC, XC, MODF1, 2};
        pg8::gemm_phase<pg8::EpiResid, pg8::MultiSched, false>(F.lds, D, Sc, E);
    } SEAM(15);
    if (IN(16)) { router_phase(F, args, X); } SEAM(16);
#pragma unroll
    for (int c = 0; c < 2; ++c) {
        const int* cnt = (const int*)(F.ctl + CW_GCNT) + c * 8;
        const int* stok = (const int*)(ws + WS_SLOT_TOK) + (size_t)c * 8 * NLAT;
        if (IN(17 + 2 * c)) {
            pg8::MoeSched Sc; Sc.init((LAS int*)(F.lds + LDSCTL_OFF + 1024), cnt, D, 28, F.G, cu, true, H, (const bf16_t*)(ws + WS_W13), (size_t)7168 * D, stok);
            pg8::EpiSwiglu E{(bf16_t*)(ws + WS_MID1), 3584};
            pg8::gemm_phase<pg8::EpiSwiglu, pg8::MoeSched, true>(F.lds, D, Sc, E);
        } SEAM(17 + 2 * c);
        if (IN(18 + 2 * c)) {
            pg8::MoeSched Sc; Sc.init((LAS int*)(F.lds + LDSCTL_OFF + 1024), cnt, 3584, 4, F.G, cu, false, (const bf16_t*)(ws + WS_MID1), (const bf16_t*)(ws + WS_W2), (size_t)D * 3584, stok);
            pg8::EpiMoeDown E{X, MODF1, (const float*)(ws + WS_SLOT_G), (const int*)(ws + WS_SLOT_TOK)};
            pg8::gemm_phase<pg8::EpiMoeDown, pg8::MoeSched, false>(F.lds, 3584, Sc, E);
        } SEAM(18 + 2 * c);
    }
#undef IN
#undef SEAM
}
}
#ifndef MK_MODE
#define MK_MODE 0
#endif
namespace mk {
#if MK_MODE == 2
constexpr size_t WS_CK = 522 * MiB, WS_XN = 552 * MiB, WS_NEED = 568 * MiB;
constexpr int CKR = 1024;
constexpr size_t CKSZ = (size_t)(CKR + CL) * D;
constexpr int CW_RES = 1024;
__global__ void cmp_kernel(const void* opt, int is_bf16, int ldo, int col0, const float* ref, int rows, int ncols, float* res) {
    float d2 = 0.f, b2 = 0.f;
    for (long i = (long)blockIdx.x * 256 + threadIdx.x; i < (long)rows * ncols; i += (long)gridDim.x * 256) {
        const int r = (int)(i / ncols), c = col0 + (int)(i % ncols);
        const float a = is_bf16 ? bf2f(((const bf16_t*)opt)[(size_t)r * ldo + c]) : ((const float*)opt)[(size_t)r * ldo + c];
        const float b = ref[(size_t)r * D + c];
        d2 += (a - b) * (a - b); b2 += b * b;
    }
    __shared__ float s0[256], s1[256];
    s0[threadIdx.x] = d2; s1[threadIdx.x] = b2; __syncthreads();
    for (int o = 128; o > 0; o >>= 1) { if (threadIdx.x < o) { s0[threadIdx.x] += s0[threadIdx.x + o]; s1[threadIdx.x] += s1[threadIdx.x + o]; } __syncthreads(); }
    if (threadIdx.x == 0) { atomicAdd(res, s0[0]); atomicAdd(res + 1, s1[0]); }
}
__global__ void verdict_kernel(const float* res, int nchk, float thr, const float* xn, float* out) {
    int bad = 0;
    for (int k = 0; k < nchk; ++k) { const float r = res[2 * k] / res[2 * k + 1]; if (!(r < thr)) { bad = k + 1; break; } }
    if (!bad) return;
    for (size_t i = (size_t)blockIdx.x * 256 + threadIdx.x; i < (size_t)NLAT * D; i += (size_t)gridDim.x * 256)
        out[i] = i < (size_t)S * D ? xn[i] * (float)(1 + bad) : 0.f;
}
#endif

static int g_grid = 0;
static void launch_range(hipStream_t st, Args a, int lo, int hi, bool reset_bar) {
    if (reset_bar) (void)hipMemsetAsync(a.ws + WS_CTL + (size_t)CW_BAR * 4, 0, (size_t)XCD_BAR_WORDS * 4, st);
    a.ph_lo = lo; a.ph_hi = hi;
    hipLaunchKernelGGL(mega_fwd, dim3(g_grid), dim3(NTHR), LDS_BYTES, st, a);
    const hipError_t le = hipPeekAtLastError();
    if (le != hipSuccess) fprintf(stderr, "kernel_launch: launch [%d,%d) failed: %s\n", lo, hi, hipGetErrorName(le));
}
}

extern "C" void kernel_launch(void* const* d_in, const int* in_sizes, int n_in, void* d_out, int out_size, void* d_ws, size_t ws_size, hipStream_t stream) {
    using namespace mk;
    if (g_grid == 0) {
        size_t need = WS_END;
#if MK_MODE == 2
        need = WS_NEED;
#endif
        if (n_in != 37 || out_size != NLAT * D || ws_size < need) { fprintf(stderr, "kernel_launch: unexpected shapes / workspace (%zu < %zu)\n", ws_size, need); g_grid = -1; return; }
        int dev = 0, cus = 0, per_cu = 0;
        if (hipGetDevice(&dev) != hipSuccess || hipDeviceGetAttribute(&cus, hipDeviceAttributeMultiprocessorCount, dev) != hipSuccess) { g_grid = -1; return; }
        if (hipFuncSetAttribute((const void*)mega_fwd, hipFuncAttributeMaxDynamicSharedMemorySize, LDS_BYTES) != hipSuccess) { fprintf(stderr, "kernel_launch: hipFuncSetAttribute failed\n"); g_grid = -1; return; }
        if (hipOccupancyMaxActiveBlocksPerMultiprocessor(&per_cu, (const void*)mega_fwd, NTHR, LDS_BYTES) != hipSuccess || per_cu < 1) { fprintf(stderr, "kernel_launch: occupancy query says %d blocks per CU\n", per_cu); g_grid = -1; (void)hipGetLastError(); return; }
        g_grid = cus;
    }
    if (g_grid < 0) return;
    Args a; memset(&a, 0, sizeof a);
    for (int i = 0; i < 37; ++i) a.in[i] = (const float*)d_in[i];
    a.out = (float*)d_out; a.ws = (unsigned char*)d_ws;
#if MK_MODE == 0
    (void)hipMemsetAsync((char*)d_ws + WS_CTL, 0, CTL_ZERO_BYTES, stream);
    launch_range(stream, a, 0, 21, false);
#elif MK_MODE == 1
    (void)hipMemsetAsync((char*)d_ws + WS_CTL, 0, CTL_ZERO_BYTES, stream);
    for (int p = 0; p < 21; ++p) launch_range(stream, a, p, p + 1, true);
#else
    {
        nv::In I = nv::make_in(d_in);
        float* CK = (float*)((char*)d_ws + WS_CK); float* XN = (float*)((char*)d_ws + WS_XN);
        nv::run(stream, I, XN, (char*)d_ws, 1, CK, CKR);
        (void)hipMemsetAsync((char*)d_ws + WS_CTL, 0, CTL_ZERO_BYTES, stream);
        float* res = (float*)((char*)d_ws + WS_CTL) + CW_RES;
        const bf16_t* AO = (const bf16_t*)((char*)d_ws + WS_H); const float* XC = (const float*)((char*)d_ws + WS_XC); const float* X = (const float*)d_out;
        auto cmp = [&](int id, const void* opt, int bf, int ldo, int col0, const float* ref, int rows, int ncols) {
            hipLaunchKernelGGL(cmp_kernel, dim3(256), dim3(256), 0, stream, opt, bf, ldo, col0, ref, rows, ncols, res + 2 * (id - 1)); };
        launch_range(stream, a, 0, 5, true);
        cmp(1, AO, 1, D, 0, CK + 0 * CKSZ, CKR, 512);
        cmp(2, AO, 1, D, 512, CK + 0 * CKSZ, CKR, 512);
        cmp(3, AO + (size_t)NLAT * D, 1, D, 0, CK + 0 * CKSZ + (size_t)CKR * D, CL, 512);
        cmp(4, AO + (size_t)NLAT * D, 1, D, 512, CK + 0 * CKSZ + (size_t)CKR * D, CL, 512);
        launch_range(stream, a, 5, 6, true);
        cmp(5, X, 0, D, 0, CK + 1 * CKSZ, CKR, D);
        cmp(6, XC, 0, D, 0, CK + 1 * CKSZ + (size_t)CKR * D, CL, D);
        launch_range(stream, a, 6, 9, true);
        cmp(7, X, 0, D, 0, CK + 2 * CKSZ, CKR, D);
        cmp(8, XC, 0, D, 0, CK + 2 * CKSZ + (size_t)CKR * D, CL, D);
        launch_range(stream, a, 9, 15, true);
        cmp(9, AO, 1, D, 0, CK + 3 * CKSZ, CKR, 512);
        cmp(10, AO, 1, D, 512, CK + 3 * CKSZ, CKR, 512);
        launch_range(stream, a, 15, 16, true);
        cmp(11, X, 0, D, 0, CK + 4 * CKSZ, CKR, D);
        launch_range(stream, a, 16, 21, true);
        cmp(12, X, 0, D, 0, CK + 5 * CKSZ, CKR, D);
        hipLaunchKernelGGL(verdict_kernel, dim3(1024), dim3(256), 0, stream, (const float*)res, 12, 2e-3f, (const float*)XN, (float*)d_out);
    }
#endif
}
```

```cpp
#define MK_MODE 0
#include <hip/hip_runtime.h>
#include <cstdint>
#include <cstdio>
#include <cstring>
#include <cmath>
#define GAS __attribute__((address_space(1)))
#define LAS __attribute__((address_space(3)))
typedef unsigned short bf16_t;
typedef unsigned v4u __attribute__((ext_vector_type(4)));
typedef unsigned v2u __attribute__((ext_vector_type(2)));
typedef float f32x4 __attribute__((ext_vector_type(4)));
typedef float f32x2 __attribute__((ext_vector_type(2)));
typedef float f32x16 __attribute__((ext_vector_type(16)));
typedef short bf16x8 __attribute__((ext_vector_type(8)));
typedef int v4i __attribute__((ext_vector_type(4)));
typedef int v8i __attribute__((ext_vector_type(8)));
typedef GAS unsigned gu32;
#define RLX_AGENT __ATOMIC_RELAXED, __HIP_MEMORY_SCOPE_AGENT
#define LDS_WAIT() asm volatile("s_waitcnt lgkmcnt(0)" ::: "memory")
#define VM_WAIT() asm volatile("s_waitcnt vmcnt(0)" ::: "memory")

namespace mk {
constexpr int D = 1024, NB = 8, S = 4096, CL = 256, NLAT = NB * S, NCTX = NB * CL, NTOK = NLAT + NCTX;
constexpr int GW = 64;
constexpr float EPS = 1e-6f;
constexpr float LOG2E = 1.4426950408889634f;
constexpr int NWAVES = 8, NTHR = 512;

typedef __bf16 bf16x2_nt __attribute__((ext_vector_type(2)));
__device__ __forceinline__ unsigned cvt_pk_bf16(float lo, float hi) { const f32x2 v = {lo, hi}; return __builtin_bit_cast(unsigned, __builtin_convertvector(v, bf16x2_nt)); }
__device__ __forceinline__ float bf2f(unsigned short u) { return __uint_as_float((unsigned)u << 16); }
__device__ __forceinline__ float bflo(unsigned u) { return __uint_as_float(u << 16); }
__device__ __forceinline__ float bfhi(unsigned u) { return __uint_as_float(u & 0xffff0000u); }
__device__ __forceinline__ unsigned cvt4_fp8(float a, float b, float c, float d) {
    a = __builtin_amdgcn_fmed3f(a, -448.f, 448.f); b = __builtin_amdgcn_fmed3f(b, -448.f, 448.f); c = __builtin_amdgcn_fmed3f(c, -448.f, 448.f); d = __builtin_amdgcn_fmed3f(d, -448.f, 448.f);
    int r = __builtin_amdgcn_cvt_pk_fp8_f32(a, b, 0, false); r = __builtin_amdgcn_cvt_pk_fp8_f32(c, d, r, true); return (unsigned)r; }
__device__ __forceinline__ float silu_f(float x) { return x / (1.f + __expf(-x)); }
template <int CTRL> __device__ __forceinline__ float dpp_f(float v) { return __builtin_bit_cast(float, __builtin_amdgcn_update_dpp(0, __builtin_bit_cast(int, v), CTRL, 0xf, 0xf, true)); }
__device__ __forceinline__ float xor1_f(float v) { return dpp_f<0xB1>(v); }
__device__ __forceinline__ float xor2_f(float v) { return dpp_f<0x4E>(v); }
__device__ __forceinline__ float xor8_f(float v) { return dpp_f<0x128>(v); }
__device__ __forceinline__ float sum4_f(float v) { v += xor1_f(v); return v + xor2_f(v); }
__device__ __forceinline__ float sum8_f(float v) { v = sum4_f(v); return v + dpp_f<0x141>(v); }
__device__ __forceinline__ float sum16_f(float v) { v = sum8_f(v); return v + dpp_f<0x140>(v); }
__device__ __forceinline__ float sum32_f(float v) { v = sum16_f(v); const auto r = __builtin_amdgcn_permlane16_swap(__float_as_uint(v), __float_as_uint(v), false, false); return __uint_as_float(r[0]) + __uint_as_float(r[1]); }
__device__ __forceinline__ float wave_sum(float v) { v = sum32_f(v); const auto r = __builtin_amdgcn_permlane32_swap(__float_as_uint(v), __float_as_uint(v), false, false); return __uint_as_float(r[0]) + __uint_as_float(r[1]); }
}
#ifndef MK_REP_GEMM
#define MK_REP_GEMM 1
#endif
#ifndef MK_REP_ATTN
#define MK_REP_ATTN 1
#endif
#ifndef MK_PROBE_Q
#define MK_PROBE_Q 0
#endif
#ifndef MK_PROBE
#define MK_PROBE 0
#endif
#ifndef MK_REP_NM
#define MK_REP_NM 1
#endif
#ifndef MK_P0_DUPMOD
#define MK_P0_DUPMOD 0
#endif
#ifndef MK_REP_P0
#define MK_REP_P0 1
#endif
namespace pg8 {
using namespace mk;
constexpr int BM = 256, BK = 64, HALF = 128, HTB = HALF * BK * 2  , STAGE_BYTES = 8 * HTB, NXCD = 8, WGM = 8;

__device__ __forceinline__ int lds_byte(int r, int c) { const int st = (r >> 4) * 2 + (c >> 5), rr = r & 15, cc = c & 31, ob = rr * 64 + cc * 2; return st * 1024 + (ob ^ (((ob >> 9) & 1) << 5)); }
__device__ __forceinline__ void stage_rc(int b, int& R, int& C) { const int st = b / 1024, sb = b % 1024, swz = sb ^ (((sb >> 9) & 1) << 5); R = (st >> 1) * 16 + swz / 64; C = (st & 1) * 32 + (swz % 64) / 2; }
__device__ __forceinline__ int perm32(int rho) { const int n = rho >> 4, i = rho & 15; return 8 * (i >> 2) + 4 * n + (i & 3); }

struct Unit {
    const bf16_t* A; const bf16_t* B;
    const int* ridx;
    int rows;
    int pm, pn, kind, aux;
    int dup;
    int K, gath;
};

__device__ __forceinline__ int xcd_remap(int L, int nwg) { const int q = nwg / NXCD, r = nwg % NXCD, xcd = L % NXCD, off = L / NXCD; return (xcd < r ? xcd * (q + 1) : r * (q + 1) + (xcd - r) * q) + off; }
__device__ __forceinline__ void grouped(int w, int nM, int nN, int& pm, int& pn) {
    const int nig = WGM * nN, gid = w / nig, fm = gid * WGM, gsz = (nM - fm) < WGM ? (nM - fm) : WGM;
    pm = fm + ((w % nig) % gsz); pn = (w % nig) / gsz;
}

template <class Epi, class Sched, bool GATHER, bool FP8 = false, bool VARK = false>
__device__ __forceinline__ void gemm_phase(LAS unsigned char* lds, const int K, const Sched& S, const Epi& E) {
    int tid_ = threadIdx.x; asm volatile("" : "+v"(tid_));
    const int tid = tid_, wid = __builtin_amdgcn_readfirstlane(tid >> 6), lane = tid & 63, wr = wid >> 2, wc = wid & 3, fr = lane & 15, fq = lane >> 4;
    unsigned voffB[2], voffBn[2];
#pragma unroll
    for (int i = 0; i < 2; ++i) { int sR_, sC_; stage_rc(tid * 16 + i * 8192, sR_, sC_); const int sRb_ = Epi::PERM ? ((sR_ & ~31) + perm32(sR_ & 31)) : sR_; voffB[i] = (unsigned)(sRb_ * K + sC_) * 2u; voffBn[i] = voffB[i]; }
    const size_t kstep = (size_t)(BK * 2);
    size_t hstep = (size_t)HALF * K * 2, hstepN = hstep;
    int nt = K / BK;
    const unsigned ldsw = (unsigned)wid * 1024u;
    const int aoff = lds_byte(wr * 64 + fr, fq * 8), boff = lds_byte(wc * 32 + fr, fq * 8);
#define PG8_SA(b, h) (((b) * 2 + (h)) * HTB)
#define PG8_SB(b, h) ((4 + (b) * 2 + (h)) * HTB)
#define PG8_STAGE(bufoff, gbase, voff) do { _Pragma("unroll") for (int _i = 0; _i < 2; ++_i) \
        __builtin_amdgcn_global_load_lds((const unsigned*)((const char*)(gbase) + (voff)[_i]), (LAS unsigned*)(lds + (bufoff) + ldsw + _i * 8192), 16, 0, 0); } while (0)
#define PG8_STAGE_A(bufoff, h, kptr, vo) PG8_STAGE(bufoff, (GATHER ? (kptr) : (kptr) + (h) * hstep), (vo)[GATHER ? (h) : 0])
#define PG8_LDA(dst, b, h) do { _Pragma("unroll") for (int m = 0; m < 4; ++m) { if (FP8) dst##8[m] = __builtin_shufflevector(*(const LAS v4i*)(lds + PG8_SA(b, h) + aoff + m * 2048), *(const LAS v4i*)(lds + PG8_SA(b, h) + aoff + m * 2048 + 1024), 0, 1, 2, 3, 4, 5, 6, 7); \
        else { _Pragma("unroll") for (int k = 0; k < 2; ++k) dst[m][k] = *(const LAS bf16x8*)(lds + PG8_SA(b, h) + aoff + m * 2048 + k * 1024); } } } while (0)
#define PG8_LDB(dst, b, h) do { _Pragma("unroll") for (int n = 0; n < 2; ++n) { if (FP8) dst##8[n] = __builtin_shufflevector(*(const LAS v4i*)(lds + PG8_SB(b, h) + boff + n * 2048), *(const LAS v4i*)(lds + PG8_SB(b, h) + boff + n * 2048 + 1024), 0, 1, 2, 3, 4, 5, 6, 7); \
        else { _Pragma("unroll") for (int k = 0; k < 2; ++k) dst[n][k] = *(const LAS bf16x8*)(lds + PG8_SB(b, h) + boff + n * 2048 + k * 1024); } } } while (0)
#define PG8_MMA(ai, bj, At, Bt) do { __builtin_amdgcn_s_setprio(1); _Pragma("unroll") for (int m = 0; m < 4; ++m) _Pragma("unroll") for (int n = 0; n < 2; ++n) { \
        if (FP8) { asm volatile("v_mfma_f32_16x16x128_f8f6f4 %0, %1, %2, %0" : "+v"(acc[ai][bj][m][n]) : "v"(Bt##8[n]), "v"(At##8[m])); } \
        else { _Pragma("unroll") for (int k = 0; k < 2; ++k) acc[ai][bj][m][n] = __builtin_amdgcn_mfma_f32_16x16x32_bf16(Bt[n][k], At[m][k], acc[ai][bj][m][n], 0, 0, 0); } } \
        __builtin_amdgcn_s_setprio(0); } while (0)
#define PG8_WAIT_V(n) asm volatile("s_waitcnt vmcnt(" #n ")" ::: "memory")
#define PG8_WAIT_L(n) asm volatile("s_waitcnt lgkmcnt(" #n ")" ::: "memory")
#define PG8_BAR __builtin_amdgcn_s_barrier()
#define PG8_SCHED __builtin_amdgcn_sched_barrier(0)
#define PG8_MKVOFF(u, vo) do { _Pragma("unroll") for (int _h = 0; _h < (GATHER ? 2 : 1); ++_h) _Pragma("unroll") for (int _i = 0; _i < 2; ++_i) { \
        int _sR, _sC; stage_rc(tid * 16 + _i * 8192, _sR, _sC); const int _row = _h * HALF + _sR; int _g = _row; \
        if (GATHER) { if (!VARK || (u).gath) _g = (_row < (u).rows) ? (u).ridx[_row] : 0; } \
        (vo)[_h][_i] = (unsigned)(_g * (VARK ? (u).K : K) + _sC) * 2u; } } while (0)
#define PG8_MKVOFFB(u, vb, hs) do { if (VARK) { _Pragma("unroll") for (int _i = 0; _i < 2; ++_i) { int _sR, _sC; stage_rc(tid * 16 + _i * 8192, _sR, _sC); const int _sRb = Epi::PERM ? ((_sR & ~31) + perm32(_sR & 31)) : _sR; (vb)[_i] = (unsigned)(_sRb * (u).K + _sC) * 2u; } hs = (size_t)HALF * (u).K * 2; } } while (0)
    Unit cur, nxt; int ui = 0;
    if (!S.next(0, cur)) return;
    f32x4 acc[2][2][4][2];
#pragma unroll
    for (int a = 0; a < 2; ++a)
#pragma unroll
        for (int b = 0; b < 2; ++b)
#pragma unroll
            for (int m = 0; m < 4; ++m)
#pragma unroll
                for (int n = 0; n < 2; ++n) acc[a][b][m][n] = (f32x4){0.f, 0.f, 0.f, 0.f};
    bf16x8 At[4][2], B0[2][2], B1[2][2];
    v8i At8[4], B08[2], B18[2];
    unsigned vA[2][2], vN[2][2];
    PG8_MKVOFF(cur, vA); PG8_MKVOFFB(cur, voffB, hstep); if (VARK) nt = cur.K / BK;
    const char* cA = (const char*)cur.A; const char* cB = (const char*)cur.B;
    PG8_STAGE(PG8_SB(0, 0), cB, voffB); PG8_STAGE(PG8_SB(0, 1), cB + hstep, voffB); PG8_STAGE_A(PG8_SA(0, 0), 0, cA, vA); PG8_STAGE_A(PG8_SA(0, 1), 1, cA, vA);
    if (wr == 1) PG8_BAR;
    PG8_WAIT_V(2); PG8_BAR;
    PG8_STAGE(PG8_SB(1, 0), cB + kstep, voffB); PG8_STAGE_A(PG8_SA(1, 0), 0, cA + kstep, vA); PG8_STAGE(PG8_SB(1, 1), cB + hstep + kstep, voffB);
    PG8_WAIT_V(6); PG8_BAR;
    for (;;) {
        const bool has_next = S.next(ui + 1, nxt);
        const char* nA = has_next ? (const char*)nxt.A : cA; const char* nB = has_next ? (const char*)nxt.B : cB;
        if (VARK) { if (has_next) { PG8_MKVOFFB(nxt, voffBn, hstepN); } else { voffBn[0] = voffB[0]; voffBn[1] = voffB[1]; hstepN = hstep; } }
        if (GATHER) { if (has_next) { PG8_MKVOFF(nxt, vN); } else {
#pragma unroll
            for (int h = 0; h < 2; ++h)
#pragma unroll
                for (int i = 0; i < 2; ++i) vN[h][i] = vA[h][i]; } }
        LAS v4u* const parkA = (LAS v4u*)(lds + STAGE_BYTES + 4096) + tid; LAS v2u* const parkB = (LAS v2u*)(lds + STAGE_BYTES + 4096 + 8192) + tid;
        if (VARK) { *parkA = (v4u){vN[0][0], vN[0][1], vN[1][0], vN[1][1]}; *parkB = (v2u){voffBn[0], voffBn[1]}; }
        for (int t = 0; t < nt; t += 2) {
            const bool last = (t == nt - 2);
            const char* a1 = cA + (size_t)(t + 1) * kstep;
            const char* a2 = last ? nA : cA + (size_t)(t + 2) * kstep; const char* b2 = last ? nB : cB + (size_t)(t + 2) * kstep;
            const char* a3 = a2 + kstep; const char* b3 = b2 + kstep;
            unsigned v2[2][2];
#pragma unroll
            for (int h = 0; h < 2; ++h)
#pragma unroll
                for (int i = 0; i < 2; ++i) v2[h][i] = (GATHER && !VARK && last) ? vN[h][i] : vA[h][i];
            unsigned vb2[2]; vb2[0] = voffB[0]; vb2[1] = voffB[1];
            if (VARK) { if (last) { const v4u pa = *parkA; const v2u pb = *parkB; v2[0][0] = pa.x; v2[0][1] = pa.y; v2[1][0] = pa.z; v2[1][1] = pa.w; vb2[0] = pb.x; vb2[1] = pb.y; } }
            const size_t hs2 = (VARK && last) ? hstepN : hstep;
            PG8_LDB(B0, 0, 0); PG8_LDB(B1, 0, 1); PG8_SCHED; PG8_LDA(At, 0, 0); PG8_STAGE_A(PG8_SA(1, 1), 1, a1, vA);
            PG8_WAIT_V(8); PG8_WAIT_L(0); PG8_BAR; PG8_MMA(0, 0, At, B0); PG8_MMA(0, 1, At, B1); PG8_BAR; PG8_SCHED;
            PG8_LDA(At, 0, 1); PG8_STAGE(PG8_SB(0, 0), b2, vb2); PG8_STAGE(PG8_SB(0, 1), b2 + hs2, vb2); PG8_STAGE_A(PG8_SA(0, 0), 0, a2, v2);
            PG8_WAIT_V(8); PG8_WAIT_L(0); PG8_BAR; PG8_MMA(1, 0, At, B0); PG8_MMA(1, 1, At, B1); PG8_BAR; PG8_SCHED;
            PG8_LDB(B0, 1, 0); PG8_LDB(B1, 1, 1); PG8_SCHED; PG8_LDA(At, 1, 0); PG8_STAGE_A(PG8_SA(0, 1), 1, a2, v2);
            PG8_WAIT_V(8); PG8_WAIT_L(0); PG8_BAR; PG8_MMA(0, 0, At, B0); PG8_MMA(0, 1, At, B1); PG8_BAR; PG8_SCHED;
            PG8_LDA(At, 1, 1); PG8_STAGE(PG8_SB(1, 0), b3, vb2); PG8_STAGE(PG8_SB(1, 1), b3 + hs2, vb2); PG8_STAGE_A(PG8_SA(1, 0), 0, a3, v2);
            PG8_WAIT_V(8); PG8_WAIT_L(0); PG8_BAR; PG8_MMA(1, 0, At, B0); PG8_MMA(1, 1, At, B1); PG8_BAR; PG8_SCHED;
        }
        if (wr == 0) PG8_BAR;
        if (FP8) asm volatile("s_nop 15\n\ts_nop 15\n\ts_nop 15\n\ts_nop 15" ::: "memory");
        { int t2_ = threadIdx.x; asm volatile("" : "+v"(t2_));
          if (!cur.dup) E(acc, cur, wr, wc, t2_ & 15, (t2_ & 63) >> 4); }
        if (!has_next) break;
#pragma unroll
        for (int a = 0; a < 2; ++a)
#pragma unroll
            for (int b = 0; b < 2; ++b)
#pragma unroll
                for (int m = 0; m < 4; ++m)
#pragma unroll
                    for (int n = 0; n < 2; ++n) acc[a][b][m][n] = (f32x4){0.f, 0.f, 0.f, 0.f};
        cur = nxt; cA = nA; cB = nB; ++ui;
        if (VARK) { const v4u pa = *parkA; const v2u pb = *parkB; vA[0][0] = pa.x; vA[0][1] = pa.y; vA[1][0] = pa.z; vA[1][1] = pa.w; voffB[0] = pb.x; voffB[1] = pb.y; hstep = hstepN; nt = cur.K / BK; }
        else if (GATHER) {
#pragma unroll
        for (int h = 0; h < 2; ++h)
#pragma unroll
            for (int i = 0; i < 2; ++i) vA[h][i] = vN[h][i]; }
        if (wr == 1) PG8_BAR;
    }
    PG8_WAIT_V(0);
    PG8_BAR;
#undef PG8_SA
#undef PG8_SB
#undef PG8_STAGE
#undef PG8_STAGE_A
#undef PG8_LDA
#undef PG8_LDB
#undef PG8_MMA
#undef PG8_WAIT_V
#undef PG8_WAIT_L
#undef PG8_BAR
#undef PG8_SCHED
#undef PG8_MKVOFF
#undef PG8_MKVOFFB
}

struct MultiSched {
    const bf16_t* A0; const bf16_t* B0; const bf16_t* A1; const bf16_t* B1;
    int nM0, nN0, kind0, nM1, nN1, kind1, n0, total, G, c, K;
    __device__ __forceinline__ void init(int K_, int G_, int c_) { n0 = 0; total = 0; G = G_; c = c_; K = K_; A1 = nullptr; B1 = nullptr; nM1 = 0; nN1 = 1; kind1 = 0; }
    __device__ __forceinline__ void add(const bf16_t* A, const bf16_t* B, int nM, int nN, int kind) {
        if (total == 0) { A0 = A; B0 = B; nM0 = nM; nN0 = nN; kind0 = kind; n0 = nM * nN; } else { A1 = A; B1 = B; nM1 = nM; nN1 = nN; kind1 = kind; }
        total += nM * nN; }
    __device__ __forceinline__ bool next(int i, Unit& u) const {
        const long L = (long)(i / MK_REP_GEMM) * G + c; if (L >= total) return false;
        u.dup = (i % MK_REP_GEMM) != 0;
        int w = xcd_remap((int)L, total);
        const bool second = w >= n0; if (second) w -= n0;
        const int nM = second ? nM1 : nM0, nN = second ? nN1 : nN0;
        int pm, pn; grouped(w, nM, nN, pm, pn);
        u.A = (second ? A1 : A0) + (size_t)pm * BM * K; u.B = (second ? B1 : B0) + (size_t)pn * BM * K; u.ridx = nullptr; u.rows = BM; u.pm = pm; u.pn = pn; u.kind = second ? kind1 : kind0; u.aux = pm * BM;
        return true;
    }
};
}
namespace pg8 {
struct EpiStore {
    static constexpr bool PERM = true;
    bf16_t* O0; bf16_t* O1; int ldc0, ldc1;
    __device__ __forceinline__ void operator()(const f32x4 (&acc)[2][2][4][2], const Unit& u, int wr, int wc, int fr, int fq) const {
        const int ldc = u.kind ? ldc1 : ldc0;
        bf16_t* base = (u.kind ? O1 : O0) + (size_t)(u.pm * BM + wr * 64 + fr) * ldc + u.pn * BM + wc * 32 + 8 * fq;
#pragma unroll
        for (int ai = 0; ai < 2; ++ai)
#pragma unroll
            for (int m = 0; m < 4; ++m) { bf16_t* rowp = base + (size_t)(ai * HALF + m * 16) * ldc;
#pragma unroll
                for (int bj = 0; bj < 2; ++bj) { const f32x4 v0 = acc[ai][bj][m][0], v1 = acc[ai][bj][m][1];
                    v4u w; w.x = cvt_pk_bf16(v0[0], v0[1]); w.y = cvt_pk_bf16(v0[2], v0[3]); w.z = cvt_pk_bf16(v1[0], v1[1]); w.w = cvt_pk_bf16(v1[2], v1[3]);
                    *(v4u*)(rowp + bj * HALF) = w; } }
    }
};
struct EpiQK0 {
    static constexpr bool PERM = true;
    bf16_t* QK; bf16_t* VT; const float* gtab; const f32x2* t64;
    __device__ __forceinline__ void operator()(const f32x4 (&acc)[2][2][4][2], const Unit& u, int wr, int wc, int fr, int fq) const {
        if (u.kind) {
            bf16_t* base = VT + (size_t)(u.pm * BM + wr * 64 + fr) * NTOK + u.pn * BM + wc * 32 + 8 * fq;
#pragma unroll
            for (int ai = 0; ai < 2; ++ai)
#pragma unroll
                for (int m = 0; m < 4; ++m) { bf16_t* rowp = base + (size_t)(ai * HALF + m * 16) * NTOK;
#pragma unroll
                    for (int bj = 0; bj < 2; ++bj) { const f32x4 v0 = acc[ai][bj][m][0], v1 = acc[ai][bj][m][1];
                        v4u w; w.x = cvt_pk_bf16(v0[0], v0[1]); w.y = cvt_pk_bf16(v0[2], v0[3]); w.z = cvt_pk_bf16(v1[0], v1[1]); w.w = cvt_pk_bf16(v1[2], v1[3]);
                        *(v4u*)(rowp + bj * HALF) = w; } }
            return;
        }
        const int kq = u.pn >> 1;
        const float* g = gtab + kq * 64;
        const bool rope = (kq >= 2) && (u.pm * BM < NLAT);
        const float scale = (kq == 0 || kq == 2) ? 0.125f * LOG2E : 1.f;
        f32x4 gg[2][2];
#pragma unroll
        for (int bj = 0; bj < 2; ++bj)
#pragma unroll
            for (int n = 0; n < 2; ++n) gg[bj][n] = *(const f32x4*)(g + bj * 32 + 8 * fq + 4 * n);
        const bool x1 = fq < 2; const int i0 = 8 * (fq & 1);
#pragma unroll
        for (int ai = 0; ai < 2; ++ai)
#pragma unroll
            for (int m = 0; m < 4; ++m) {
                const int row = u.pm * BM + ai * HALF + wr * 64 + m * 16 + fr;
                float v[2][8]; float ss = 0.f;
#pragma unroll
                for (int bj = 0; bj < 2; ++bj)
#pragma unroll
                    for (int q = 0; q < 8; ++q) { v[bj][q] = acc[ai][bj][m][q >> 2][q & 3]; ss += v[bj][q] * v[bj][q]; }
                ss += __shfl_xor(ss, 16); ss += __shfl_xor(ss, 32);
                const float rstd = rsqrtf(ss * (1.f / 64.f) + EPS);
#pragma unroll
                for (int bj = 0; bj < 2; ++bj)
#pragma unroll
                    for (int q = 0; q < 8; ++q) v[bj][q] *= rstd * gg[bj][q >> 2][q & 3];
                if (rope) {
                    const int pos = row & (S - 1);
#pragma unroll
                    for (int bj = 0; bj < 2; ++bj) { const int ps = bj ? (pos & 63) : (pos >> 6);
#pragma unroll
                        for (int q = 0; q < 8; ++q) { const float pr = __shfl_xor(v[bj][q], 32); const f32x2 cs = t64[ps * 16 + i0 + q];
                            v[bj][q] = x1 ? (v[bj][q] * cs.x - pr * cs.y) : (pr * cs.y + v[bj][q] * cs.x); } }
                }
                bf16_t* op = QK + (size_t)row * 2048 + u.pn * BM + wc * 64 + 8 * fq;
#pragma unroll
                for (int bj = 0; bj < 2; ++bj) { v4u w; w.x = cvt_pk_bf16(v[bj][0] * scale, v[bj][1] * scale); w.y = cvt_pk_bf16(v[bj][2] * scale, v[bj][3] * scale); w.z = cvt_pk_bf16(v[bj][4] * scale, v[bj][5] * scale); w.w = cvt_pk_bf16(v[bj][6] * scale, v[bj][7] * scale);
                    *(v4u*)(op + bj * 32) = w; }
                __builtin_amdgcn_sched_barrier(0);
            }
    }
};
struct EpiSwiglu {
    static constexpr bool PERM = true;
    bf16_t* O; int ldc;
    __device__ __forceinline__ void operator()(const f32x4 (&acc)[2][2][4][2], const Unit& u, int wr, int wc, int fr, int fq) const {
        bf16_t* base = O + (size_t)(u.aux + wr * 64 + fr) * ldc + u.pn * HALF + wc * 32 + 8 * fq;
#pragma unroll
        for (int ai = 0; ai < 2; ++ai)
#pragma unroll
            for (int m = 0; m < 4; ++m) {
                float o[8];
#pragma unroll
                for (int n = 0; n < 2; ++n)
#pragma unroll
                    for (int j = 0; j < 4; ++j) { const float g = acc[ai][0][m][n][j], up = acc[ai][1][m][n][j]; o[n * 4 + j] = g * __builtin_amdgcn_rcpf(1.f + __builtin_amdgcn_exp2f(-g * LOG2E)) * up; }
                v4u w; w.x = cvt_pk_bf16(o[0], o[1]); w.y = cvt_pk_bf16(o[2], o[3]); w.z = cvt_pk_bf16(o[4], o[5]); w.w = cvt_pk_bf16(o[6], o[7]);
                *(v4u*)(base + (size_t)(ai * HALF + m * 16) * ldc) = w; }
    }
};
struct EpiSwigluF8 {
    static constexpr bool PERM = true;
    unsigned char* O; int ldc; float inv, oscale;
    __device__ __forceinline__ void operator()(const f32x4 (&acc)[2][2][4][2], const Unit& u, int wr, int wc, int fr, int fq) const {
        unsigned char* base = O + (size_t)(u.aux + wr * 64 + fr) * ldc + u.pn * HALF + wc * 32 + 8 * fq;
#pragma unroll
        for (int ai = 0; ai < 2; ++ai)
#pragma unroll
            for (int m = 0; m < 4; ++m) {
                float o[8];
#pragma unroll
                for (int n = 0; n < 2; ++n) {
                    const f32x4 a = acc[ai][0][m][n], b = acc[ai][1][m][n];
                    const f32x4 tv = a * (-inv * LOG2E), uv = b * (inv * inv * oscale);
                    f32x4 dv; dv[0] = __builtin_amdgcn_exp2f(tv[0]); dv[1] = __builtin_amdgcn_exp2f(tv[1]); dv[2] = __builtin_amdgcn_exp2f(tv[2]); dv[3] = __builtin_amdgcn_exp2f(tv[3]);
                    dv = dv + 1.f;
                    f32x4 rv; rv[0] = __builtin_amdgcn_rcpf(dv[0]); rv[1] = __builtin_amdgcn_rcpf(dv[1]); rv[2] = __builtin_amdgcn_rcpf(dv[2]); rv[3] = __builtin_amdgcn_rcpf(dv[3]);
                    const f32x4 zv = (a * rv) * uv;
                    o[n * 4] = zv[0]; o[n * 4 + 1] = zv[1]; o[n * 4 + 2] = zv[2]; o[n * 4 + 3] = zv[3]; }
                v2u w; w.x = cvt4_fp8(o[0], o[1], o[2], o[3]); w.y = cvt4_fp8(o[4], o[5], o[6], o[7]);
                *(v2u*)(base + (size_t)(ai * HALF + m * 16) * ldc) = w; }
    }
};
template <bool BASE_BF16> struct EpiResid {
    static constexpr bool PERM = true;
    const void* base_lat; bf16_t* out_lat; const float* base_ctx; float* out_ctx; const float* modl; int chunk; float inv = 1.f;
    __device__ __forceinline__ void operator()(const f32x4 (&acc)[2][2][4][2], const Unit& u, int wr, int wc, int fr, int fq) const {
        const int row_t = u.pm * BM;
        const bool lat = row_t < NLAT;
        const int v = lat ? row_t / S : 8;
        const int col0 = u.pn * BM + wc * 32 + 8 * fq;
        const float* gp = modl + (size_t)v * 6144 + chunk * D + col0;
        f32x4 gv[2][2];
#pragma unroll
        for (int bj = 0; bj < 2; ++bj)
#pragma unroll
            for (int n = 0; n < 2; ++n) gv[bj][n] = *(const f32x4*)(gp + bj * HALF + n * 4) * inv;
        if (lat) {
#pragma unroll
            for (int ai = 0; ai < 2; ++ai)
#pragma unroll
                for (int m = 0; m < 4; ++m) { const size_t off = (size_t)(row_t + ai * HALF + wr * 64 + m * 16 + fr) * D + col0;
#pragma unroll
                    for (int bj = 0; bj < 2; ++bj) { f32x4 b0, b1;
                        if (BASE_BF16) { const v4u w = *(const v4u*)((const bf16_t*)base_lat + off + bj * HALF); b0 = (f32x4){bflo(w.x), bfhi(w.x), bflo(w.y), bfhi(w.y)}; b1 = (f32x4){bflo(w.z), bfhi(w.z), bflo(w.w), bfhi(w.w)}; }
                        else { b0 = *(const f32x4*)((const float*)base_lat + off + bj * HALF); b1 = *(const f32x4*)((const float*)base_lat + off + bj * HALF + 4); }
                        const f32x4 o0 = b0 + gv[bj][0] * acc[ai][bj][m][0], o1 = b1 + gv[bj][1] * acc[ai][bj][m][1];
                        v4u w; w.x = cvt_pk_bf16(o0[0], o0[1]); w.y = cvt_pk_bf16(o0[2], o0[3]); w.z = cvt_pk_bf16(o1[0], o1[1]); w.w = cvt_pk_bf16(o1[2], o1[3]);
                        *(v4u*)(out_lat + off + bj * HALF) = w; } }
        } else {
#pragma unroll
            for (int ai = 0; ai < 2; ++ai)
#pragma unroll
                for (int m = 0; m < 4; ++m) { const size_t off = (size_t)(row_t - NLAT + ai * HALF + wr * 64 + m * 16 + fr) * D + col0;
#pragma unroll
                    for (int bj = 0; bj < 2; ++bj)
#pragma unroll
                        for (int n = 0; n < 2; ++n) { const f32x4 bs = *(const f32x4*)(base_ctx + off + bj * HALF + n * 4);
                            *(f32x4*)(out_ctx + off + bj * HALF + n * 4) = bs + gv[bj][n] * acc[ai][bj][m][n]; } }
        }
    }
};
template <bool FINAL> struct EpiMoeDown {
    static constexpr bool PERM = true;
    bf16_t* xb; float* out; const float* modl; const float* slot_g_base; const int* slot_tok_base; float inv;
    __device__ __forceinline__ void operator()(const f32x4 (&acc)[2][2][4][2], const Unit& u, int wr, int wc, int fr, int fq) const {
        const int col0 = u.pn * BM + wc * 32 + 8 * fq;
        const float* sg = slot_g_base + (u.ridx - slot_tok_base);
#pragma unroll
        for (int ai = 0; ai < 2; ++ai)
#pragma unroll
            for (int m = 0; m < 4; ++m) { const int r = ai * HALF + wr * 64 + m * 16 + fr;
                if (r < u.rows) { const int tok = u.ridx[r]; const float g = sg[r] * inv;
                    const float* gp = modl + (size_t)(tok >> 12) * 6144 + 5 * D + col0; const size_t off = (size_t)tok * D + col0;
#pragma unroll
                    for (int bj = 0; bj < 2; ++bj) { const f32x4 g0 = *(const f32x4*)(gp + bj * HALF), g1 = *(const f32x4*)(gp + bj * HALF + 4);
                        const v4u w = *(const v4u*)(xb + off + bj * HALF);
                        const f32x4 b0 = (f32x4){bflo(w.x), bfhi(w.x), bflo(w.y), bfhi(w.y)}, b1 = (f32x4){bflo(w.z), bfhi(w.z), bflo(w.w), bfhi(w.w)};
                        const f32x4 o0 = b0 + (g0 * g) * acc[ai][bj][m][0], o1 = b1 + (g1 * g) * acc[ai][bj][m][1];
                        if (FINAL) { *(f32x4*)(out + off + bj * HALF) = o0; *(f32x4*)(out + off + bj * HALF + 4) = o1; }
                        else { v4u o; o.x = cvt_pk_bf16(o0[0], o0[1]); o.y = cvt_pk_bf16(o0[2], o0[3]); o.z = cvt_pk_bf16(o1[0], o1[1]); o.w = cvt_pk_bf16(o1[2], o1[3]); *(v4u*)(xb + off + bj * HALF) = o; } } } }
    }
};

struct MoeSched {
    const LAS int* tab;
    int ntile, nN, total, G, cu, K; bool gather;
    const bf16_t* A; const bf16_t* B; size_t bstride; const int* slot_tok;
    __device__ __forceinline__ void init(LAS int* tab_, const int* cnt_g, int K_, int nN_, int G_, int cu_, bool gather_, const bf16_t* A_, const bf16_t* B_, size_t bstride_, const int* slot_tok_) {
        __syncthreads();
        if (threadIdx.x == 0) { int s = 0; for (int e = 0; e < 8; ++e) { const int ce = cnt_g[e]; tab_[16 + e] = ce; tab_[e] = s; s += (ce + BM - 1) / BM; } tab_[8] = s; }
        __syncthreads();
        tab = tab_; ntile = __builtin_amdgcn_readfirstlane(tab_[8]);
        nN = nN_; total = ntile * nN_; G = G_; cu = cu_; K = K_; gather = gather_; A = A_; B = B_; bstride = bstride_; slot_tok = slot_tok_;
    }
    __device__ __forceinline__ bool next(int i, Unit& u) const {
        const long L = (long)(i / MK_REP_GEMM) * G + cu; if (L >= total) return false;
        u.dup = (i % MK_REP_GEMM) != 0;
        const int w = xcd_remap((int)L, total);
        int rt, pn; grouped(w, ntile, nN, rt, pn);
        int e = 0;
        for (int j = 1; j < 8; ++j) if (rt >= tab[j]) e = j;
        const int t0 = tab[e], ce = tab[16 + e];
        const int lt = rt - t0;
        u.ridx = slot_tok + (size_t)e * NLAT + lt * BM; u.rows = (ce - lt * BM) < BM ? (ce - lt * BM) : BM;
        u.A = gather ? A : A + (size_t)rt * BM * K; u.B = B + (size_t)e * bstride + (size_t)pn * BM * K;
        u.pm = rt; u.pn = pn; u.kind = e; u.aux = rt * BM;
        return true;
    }
};
struct EpiMoeDual {
    static constexpr bool PERM = true;
    EpiSwigluF8 g; EpiMoeDown<false> d;
    __device__ __forceinline__ void operator()(const f32x4 (&acc)[2][2][4][2], const Unit& u, int wr, int wc, int fr, int fq) const {
        if (u.kind & 0x100) d(acc, u, wr, wc, fr, fq); else g(acc, u, wr, wc, fr, fq);
    }
};
struct MoeDualSched {
    const LAS int* tabD; const LAS int* tabG;
    int ntD, ntG, nD, nG, G, cu, KD, KG, dc, g0, g1;
    const bf16_t* AD; const bf16_t* BD; size_t bsD; const int* stokD;
    const bf16_t* AG; const bf16_t* BG; size_t bsG; const int* stokG;
    static constexpr int NND = 4, NNG = 28, WCOST = 3;
    __device__ __forceinline__ void init(LAS int* tab, const int* cntD, const int* cntG, int G_, int cu_, int KD_, int KG_,
                                         const bf16_t* AD_, const bf16_t* BD_, size_t bsD_, const int* stokD_, const bf16_t* AG_, const bf16_t* BG_, size_t bsG_, const int* stokG_) {
        __syncthreads();
        if (threadIdx.x < 2) { LAS int* t = tab + 32 * threadIdx.x; const int* cg = threadIdx.x ? cntG : cntD; int s = 0;
            for (int e = 0; e < 8; ++e) { const int ce = cg[e]; t[16 + e] = ce; t[e] = s; s += (ce + BM - 1) / BM; } t[8] = s; }
        __syncthreads();
        tabD = tab; tabG = tab + 32; ntD = __builtin_amdgcn_readfirstlane(tab[8]); ntG = __builtin_amdgcn_readfirstlane(tab[32 + 8]);
        nD = ntD * NND; nG = ntG * NNG; G = G_; cu = cu_; KD = KD_; KG = KG_;
        AD = AD_; BD = BD_; bsD = bsD_; stokD = stokD_; AG = AG_; BG = BG_; bsG = bsG_; stokG = stokG_;
        const int dlo = nD / G, r = nD % G; dc = dlo + (cu < r ? 1 : 0);
        int w = WCOST, x = (nG - (G - r) * w) / G; if (nG < (G - r) * w) { w = 0; x = nG / G; }
        const int rem = nG - (r * x + (G - r) * (x + w));
        g0 = cu * x + w * (cu > r ? cu - r : 0) + (cu < rem ? cu : rem);
        g1 = g0 + x + (cu >= r ? w : 0) + (cu < rem ? 1 : 0);
    }
    __device__ __forceinline__ bool next(int i, Unit& u) const {
        u.dup = 0; u.ridx = nullptr;
        if (i < dc) {
            const int w = xcd_remap(cu + G * i, nD);
            int rt, pn; grouped(w, ntD, NND, rt, pn);
            int e = 0;
            for (int j = 1; j < 8; ++j) if (rt >= tabD[j]) e = j;
            const int lt = rt - tabD[e], ce = tabD[16 + e];
            u.ridx = stokD + (size_t)e * NLAT + lt * BM; u.rows = (ce - lt * BM) < BM ? (ce - lt * BM) : BM;
            u.A = AD + (size_t)rt * BM * KD; u.B = BD + (size_t)e * bsD + (size_t)pn * BM * KD;
            u.pm = rt; u.pn = pn; u.kind = e | 0x100; u.aux = rt * BM; u.K = KD; u.gath = 0;
            return true;
        }
        const int gi = g0 + (i - dc); if (gi >= g1) return false;
        int rt, pn; grouped(gi, ntG, NNG, rt, pn);
        int e = 0;
        for (int j = 1; j < 8; ++j) if (rt >= tabG[j]) e = j;
        const int lt = rt - tabG[e], ce = tabG[16 + e];
        u.ridx = stokG + (size_t)e * NLAT + lt * BM; u.rows = (ce - lt * BM) < BM ? (ce - lt * BM) : BM;
        u.A = AG; u.B = BG + (size_t)e * bsG + (size_t)pn * BM * KG;
        u.pm = rt; u.pn = pn; u.kind = e; u.aux = rt * BM; u.K = KG; u.gath = 1;
        return true;
    }
};
}
#ifndef ATT_NEGM
#define ATT_NEGM 1
#endif
#ifndef ATT_LSUM
#define ATT_LSUM 1
#endif
#ifndef ATT_NOMAX
#define ATT_NOMAX 1
#endif
namespace att {
using namespace mk;
constexpr int NSLOT = 4;
constexpr float NEG_BIG = -1e30f;
template <int DK, int DV> struct Cfg {
    static constexpr int KB = 64 * DK * 2, VB = DV * 64 * 2, SLOT = KB + VB, NPK = DK / 8, NPV = DV / 8, NP = NPK + NPV, NPW = (NP + 7) / 8, ND0 = DK / 16, NDB = DV / 32;
};
__device__ __forceinline__ float max3f(float a, float b, float c) { float r; asm("v_max3_f32 %0, %1, %2, %3" : "=v"(r) : "v"(a), "v"(b), "v"(c)); return r; }
__device__ __forceinline__ int kvmap(int i) { return (i & 3) | ((i & 4) << 1) | ((i & 8) >> 1) | (i & 16); }

struct Keys { int ka0, na, kb0, nb; };
struct NaInfo { int r_lo; int qr; int qc; const LAS float* bias; };

#define ATT_WAITBAR(N) asm volatile("s_waitcnt vmcnt(" #N ") lgkmcnt(0)\n\ts_barrier" ::: "memory")

template <int DK, int DV, bool MODE_NA>
__device__ __forceinline__ void attn_core(LAS unsigned char* lds, const bf16_t* __restrict__ Qp  ,
                                          const bf16_t* __restrict__ Kh  , int ldk, const bf16_t* __restrict__ VTh  , int ldv,
                                          const Keys ky, const NaInfo na, f32x16 (&oT)[Cfg<DK, DV>::NDB], float& l_out) {
    typedef Cfg<DK, DV> C;
    int tid_ = threadIdx.x; asm volatile("" : "+v"(tid_));
    const int tid = tid_, lane = tid & 63, r32 = lane & 31, hi = lane >> 5; const int wid = __builtin_amdgcn_readfirstlane(tid >> 6);
    const int nt = ky.na + ky.nb;
    bf16x8 qf[C::ND0];
#pragma unroll
    for (int d0 = 0; d0 < C::ND0; ++d0) qf[d0] = *(const bf16x8*)(Qp + d0 * 16 + hi * 8);
    const unsigned voffK = (unsigned)lane * (unsigned)ldk * 2u, voffV = (unsigned)lane * (unsigned)ldv * 2u;
    const __amdgpu_buffer_rsrc_t srdK = __builtin_amdgcn_make_buffer_rsrc((void*)Kh, (short)0, 0x7FFFFFFF, 0x00020000);
    const __amdgpu_buffer_rsrc_t srdV = __builtin_amdgcn_make_buffer_rsrc((void*)VTh, (short)0, 0x7FFFFFFF, 0x00020000);
    const unsigned ldsb = (unsigned)(size_t)lds;
#define ATT_DMA(m0v, voff, srd, soff) asm volatile("s_mov_b32 m0, %0\n\ts_nop 0\n\tbuffer_load_dwordx4 %1, %2, %3 offen lds" :: "s"(m0v), "v"(voff), "s"(srd), "s"(soff) : "m0", "memory")
#define ATT_ISSUE(t, slot) do { const int _row0 = (t) < ky.na ? ky.ka0 + 64 * (t) : ky.kb0 + 64 * ((t) - ky.na); \
        _Pragma("unroll") for (int _j = 0; _j < C::NPW; ++_j) { int _pc = wid + 8 * _j; _pc = _pc < C::NP ? _pc : C::NP - 1; \
            if (_pc < C::NPK) { const unsigned _so = (unsigned)(_row0 * ldk + _pc * 8) * 2u; const unsigned _m0 = ldsb + (slot) * C::SLOT + _pc * 1024; ATT_DMA(_m0, voffK, srdK, _so); } \
            else { const int _pv = _pc - C::NPK; const unsigned _so = (unsigned)((_pv >> 3) * 64 * ldv + _row0 + (_pv & 7) * 8) * 2u; const unsigned _m0 = ldsb + (slot) * C::SLOT + C::KB + _pv * 1024; ATT_DMA(_m0, voffV, srdV, _so); } } } while (0)
    ATT_ISSUE(0, 0); ATT_ISSUE(1, 1); ATT_ISSUE(2, 2);
#pragma unroll
    for (int db = 0; db < C::NDB; ++db)
#pragma unroll
        for (int r = 0; r < 16; ++r) oT[db][r] = 0.f;
    constexpr float THR = 8.f;
    constexpr bool NOMAX = (ATT_NOMAX != 0);
    constexpr bool NEGM = (ATT_NEGM != 0) && !MODE_NA && !NOMAX;
    float m = 0.f, l = 0.f;
    constexpr bool LSUM_MFMA = (ATT_LSUM != 0) && (C::NDB == 2);
    f32x16 oL;
#pragma unroll
    for (int r = 0; r < 16; ++r) oL[r] = 0.f;
    const unsigned onesw = (r32 == 0) ? 0x3F803F80u : 0u;
    const bf16x8 onesf = __builtin_bit_cast(bf16x8, (v4u){onesw, onesw, onesw, onesw});
    f32x16 negm;
#pragma unroll
    for (int r = 0; r < 16; ++r) negm[r] = 0.f;
    const int kvm = kvmap(r32);
#define ATT_QK(P, sl) do { const LAS unsigned char* _ks = lds + (sl) * C::SLOT; \
        _Pragma("unroll") for (int _h = 0; _h < 2; ++_h) { \
            _Pragma("unroll") for (int _d0 = 0; _d0 < C::ND0; ++_d0) { const bf16x8 _kf = *(const LAS bf16x8*)(_ks + (2 * _d0 + hi) * 1024 + (32 * _h + kvm) * 16); \
                if (_d0 == 0) P[_h] = __builtin_amdgcn_mfma_f32_32x32x16_bf16(_kf, qf[0], NEGM ? negm : (f32x16){0.f,0.f,0.f,0.f,0.f,0.f,0.f,0.f,0.f,0.f,0.f,0.f,0.f,0.f,0.f,0.f}, 0, 0, 0); \
                else P[_h] = __builtin_amdgcn_mfma_f32_32x32x16_bf16(_kf, qf[_d0], P[_h], 0, 0, 0); } } } while (0)
#define ATT_ACTIVE(t) (!MODE_NA || (t) < ky.na || ((na.r_lo + ((t) - ky.na)) >= nar0 && (na.r_lo + ((t) - ky.na)) < nar0 + 8))
#define ATT_LDV(dst, kc) do { _Pragma("unroll") for (int _db = 0; _db < C::NDB; ++_db) dst[_db] = *(const LAS bf16x8*)(vs + ((_db >> 1) * 8 + 2 * (kc) + hi) * 1024 + ((_db & 1) * 32 + r32) * 16); } while (0)
    int nar0 = 0; if (MODE_NA) { nar0 = na.qr - 4; nar0 = nar0 < 0 ? 0 : (nar0 > 56 ? 56 : nar0); nar0 = __builtin_amdgcn_readfirstlane(nar0); }
    bool naok[2][16];
    if (MODE_NA) { int c0 = na.qc - 8; c0 = c0 < 0 ? 0 : (c0 > 48 ? 48 : c0);
#pragma unroll
        for (int h = 0; h < 2; ++h)
#pragma unroll
            for (int r = 0; r < 16; ++r) naok[h][r] = (unsigned)(32 * h + 16 * (r >> 3) + 8 * hi + (r & 7) - c0) < 16u; }
    f32x16 p[2], pn[2];
    if (C::NPW == 2) ATT_WAITBAR(4); else ATT_WAITBAR(6);
    bool act = ATT_ACTIVE(0);
    if (act) ATT_QK(p, 0);
    int slot = 0;
    for (int t = 0; t < nt; ++t) {
        int s1 = slot + 1; s1 = s1 >= NSLOT ? s1 - NSLOT : s1; int s3 = slot + 3; s3 = s3 >= NSLOT ? s3 - NSLOT : s3;
        if (t + 2 < nt) { if (C::NPW == 2) ATT_WAITBAR(2); else ATT_WAITBAR(3); } else ATT_WAITBAR(0);
        if (t + 3 < nt) ATT_ISSUE(t + 3, s3);
        const bool actn = (t + 1 < nt) && ATT_ACTIVE(t + 1);
        if (actn) ATT_QK(pn, s1);
        if (act) {
            const LAS unsigned char* vs = lds + slot * C::SLOT + C::KB;
            bf16x8 vfa[C::NDB], vfb[C::NDB];
            ATT_LDV(vfa, 0); ATT_LDV(vfb, 1);
            __builtin_amdgcn_sched_barrier(0);
            if (MODE_NA) { if (t >= ky.na) {
                const int kr = na.r_lo + (t - ky.na);
                const LAS float* brow = na.bias + (kr - na.qr + 7) * 128 + 63 - na.qc + 8 * hi;
#pragma unroll
                for (int h = 0; h < 2; ++h) { float bb[16];
#pragma unroll
                    for (int r = 0; r < 16; ++r) bb[r] = brow[32 * h + 16 * (r >> 3) + (r & 7)];
#pragma unroll
                    for (int r = 0; r < 16; ++r) { const float pb = p[h][r] + bb[r]; p[h][r] = naok[h][r] ? pb : NEG_BIG; } } } }
            if (!NOMAX) {
            float mt = max3f(p[0][0], p[1][0], p[0][1]), mu = max3f(p[1][1], p[0][2], p[1][2]);
#pragma unroll
            for (int r = 3; r < 15; r += 2) { mt = max3f(mt, p[0][r], p[1][r]); mu = max3f(mu, p[0][r + 1], p[1][r + 1]); }
            mt = max3f(mt, p[0][15], p[1][15]); mt = max3f(mt, mu, mu);
            { const auto rr = __builtin_amdgcn_permlane32_swap(__float_as_uint(mt), __float_as_uint(mt), false, false);
              mt = max3f(mt, __uint_as_float(rr[0]), __uint_as_float(rr[1])); }
            if (!NEGM) mt -= m;
            if (__any(mt > THR)) {
                const float dl = fmaxf(mt, 0.f), al = __builtin_amdgcn_exp2f(-dl); m += dl; l *= al;
                if (NEGM) {
#pragma unroll
                for (int h = 0; h < 2; ++h)
#pragma unroll
                    for (int r = 0; r < 16; ++r) { p[h][r] -= dl; if (actn) pn[h][r] -= dl; } }
#pragma unroll
                for (int db = 0; db < C::NDB; ++db)
#pragma unroll
                    for (int r = 0; r < 16; ++r) oT[db][r] *= al;
                if (LSUM_MFMA) oL[0] *= al;
#pragma unroll
                for (int r = 0; r < 16; ++r) negm[r] = -m; } }
            float sacc = 0.f;
#pragma unroll
            for (int kc = 0; kc < 4; ++kc) { const int h = kc >> 1, b = 8 * (kc & 1);
#pragma unroll
                for (int j = 0; j < 8; ++j) { p[h][b + j] = __builtin_amdgcn_exp2f((NEGM || NOMAX) ? p[h][b + j] : p[h][b + j] - m); if (!LSUM_MFMA) sacc += p[h][b + j]; }
                v4u pw; pw.x = cvt_pk_bf16(p[h][b], p[h][b + 1]); pw.y = cvt_pk_bf16(p[h][b + 2], p[h][b + 3]); pw.z = cvt_pk_bf16(p[h][b + 4], p[h][b + 5]); pw.w = cvt_pk_bf16(p[h][b + 6], p[h][b + 7]);
                const bf16x8 pb = __builtin_bit_cast(bf16x8, pw);
#pragma unroll
                for (int db = 0; db < C::NDB; ++db) oT[db] = __builtin_amdgcn_mfma_f32_32x32x16_bf16((kc & 1) ? vfb[db] : vfa[db], pb, oT[db], 0, 0, 0);
                if (LSUM_MFMA) oL = __builtin_amdgcn_mfma_f32_32x32x16_bf16(onesf, pb, oL, 0, 0, 0);
                if (kc == 0) { ATT_LDV(vfa, 2); } else if (kc == 1) { ATT_LDV(vfb, 3); }
                __builtin_amdgcn_sched_barrier(0); }
            l += sacc;
        }
        if (actn) { p[0] = pn[0]; p[1] = pn[1]; }
        act = actn; slot = s1;
    }
    ATT_WAITBAR(0);
    if (LSUM_MFMA) l = oL[0];
    l_out = l + __shfl_xor(l, 32);
#undef ATT_LDV
#undef ATT_QK
#undef ATT_ACTIVE
#undef ATT_ISSUE
#undef ATT_DMA
}
template <int DK, int DV, bool MODE_NA>
__device__ __forceinline__ void attn_core16(LAS unsigned char* lds, const bf16_t* __restrict__ Qw  , int ldq,
                                            const bf16_t* __restrict__ Kh, int ldk, const bf16_t* __restrict__ VTh, int ldv,
                                            const Keys ky, const NaInfo na  , f32x4 (&o)[DV / 16][2], float (&l_out)[2]) {
    typedef Cfg<DK, DV> C;
    constexpr int NDS = DK / 32, NDB16 = DV / 16;
    int tid_ = threadIdx.x; asm volatile("" : "+v"(tid_));
    const int tid = tid_, lane = tid & 63, q16 = lane & 15, rg = lane >> 4; const int wid = __builtin_amdgcn_readfirstlane(tid >> 6);
    const int nt = ky.na + ky.nb;
    bf16x8 qf[2][NDS];
#pragma unroll
    for (int qb = 0; qb < 2; ++qb)
#pragma unroll
        for (int ds = 0; ds < NDS; ++ds) qf[qb][ds] = *(const bf16x8*)(Qw + (size_t)(16 * qb + q16) * ldq + 32 * ds + 8 * rg);
    const int keyof = 32 * (lane >> 5) + 8 * ((lane & 15) >> 2) + 4 * ((lane >> 4) & 1) + (lane & 3);
    const unsigned voffK = (unsigned)keyof * (unsigned)ldk * 2u, voffV = (unsigned)lane * (unsigned)ldv * 2u;
    const __amdgpu_buffer_rsrc_t srdK = __builtin_amdgcn_make_buffer_rsrc((void*)Kh, (short)0, 0x7FFFFFFF, 0x00020000);
    const __amdgpu_buffer_rsrc_t srdV = __builtin_amdgcn_make_buffer_rsrc((void*)VTh, (short)0, 0x7FFFFFFF, 0x00020000);
    const unsigned ldsb = (unsigned)(size_t)lds;
#define ATT_DMA(m0v, voff, srd, soff) asm volatile("s_mov_b32 m0, %0\n\ts_nop 0\n\tbuffer_load_dwordx4 %1, %2, %3 offen lds" :: "s"(m0v), "v"(voff), "s"(srd), "s"(soff) : "m0", "memory")
    __amdgpu_buffer_rsrc_t psrd[C::NPW]; unsigned pvoff[C::NPW], pcst[C::NPW], pmul[C::NPW], plds[C::NPW];
#pragma unroll
    for (int _j = 0; _j < C::NPW; ++_j) { int _pc = wid + 8 * _j; _pc = _pc < C::NP ? _pc : C::NP - 1; const bool _isk = _pc < C::NPK; const int _pv = _pc - C::NPK;
        psrd[_j] = _isk ? srdK : srdV; pvoff[_j] = _isk ? voffK : voffV;
        pcst[_j] = _isk ? (unsigned)(_pc * 8) * 2u : (unsigned)((_pv >> 3) * 64 * ldv + (_pv & 7) * 8) * 2u;
        pmul[_j] = _isk ? (unsigned)ldk * 2u : 2u;
        plds[_j] = ldsb + (_isk ? _pc * 1024 : C::KB + _pv * 1024); }
#define ATT_ISSUE(t, slot) do { const unsigned _row0 = (unsigned)((t) < ky.na ? ky.ka0 + 64 * (t) : ky.kb0 + 64 * ((t) - ky.na)); const unsigned _sb = (unsigned)(slot) * C::SLOT; \
        _Pragma("unroll") for (int _j = 0; _j < C::NPW; ++_j) ATT_DMA(plds[_j] + _sb, pvoff[_j], psrd[_j], pcst[_j] + _row0 * pmul[_j]); } while (0)
    ATT_ISSUE(0, 0); ATT_ISSUE(1, 1); ATT_ISSUE(2, 2);
#pragma unroll
    for (int db = 0; db < NDB16; ++db)
#pragma unroll
        for (int qb = 0; qb < 2; ++qb) o[db][qb] = (f32x4){0.f, 0.f, 0.f, 0.f};
    f32x4 oL[2] = {(f32x4){0.f, 0.f, 0.f, 0.f}, (f32x4){0.f, 0.f, 0.f, 0.f}};
    const unsigned onesw = (q16 == 0) ? 0x3F803F80u : 0u;
    const bf16x8 onesf = __builtin_bit_cast(bf16x8, (v4u){onesw, onesw, onesw, onesw});
#define ATT_QK(Sx, sl) do { const LAS unsigned char* _ks = lds + (sl) * C::SLOT + rg * 1024 + q16 * 16; \
        _Pragma("unroll") for (int _ds = 0; _ds < NDS; ++_ds) {   \
            _Pragma("unroll") for (int _kb = 0; _kb < 4; ++_kb) { const bf16x8 _kf = *(const LAS bf16x8*)(_ks + _ds * 4096 + _kb * 256); \
                _Pragma("unroll") for (int _qb = 0; _qb < 2; ++_qb) { \
                    if (_ds == 0) Sx[_kb][_qb] = __builtin_amdgcn_mfma_f32_16x16x32_bf16(_kf, qf[_qb][0], (f32x4){0.f, 0.f, 0.f, 0.f}, 0, 0, 0); \
                    else Sx[_kb][_qb] = __builtin_amdgcn_mfma_f32_16x16x32_bf16(_kf, qf[_qb][_ds], Sx[_kb][_qb], 0, 0, 0); } } } } while (0)
#define ATT_ACTIVE(t) (!MODE_NA || (t) < ky.na || ((na.r_lo + ((t) - ky.na)) >= nar0 && (na.r_lo + ((t) - ky.na)) < nar0 + 8))
#define ATT_LDV(dst, st) do { _Pragma("unroll") for (int _db = 0; _db < NDB16; ++_db) dst[_db] = *(const LAS bf16x8*)(vs + ((_db >> 2) * 8 + 4 * (st) + rg) * 1024 + (16 * (_db & 3) + q16) * 16); } while (0)
    int nar0 = 0; if (MODE_NA) { nar0 = na.qr - 4; nar0 = nar0 < 0 ? 0 : (nar0 > 56 ? 56 : nar0); nar0 = __builtin_amdgcn_readfirstlane(nar0); }
    bool naok[4][2][4]; int qcl[2];
    if (MODE_NA) {
#pragma unroll
        for (int qb = 0; qb < 2; ++qb) { qcl[qb] = na.qc + 16 * qb + q16; int c0 = qcl[qb] - 8; c0 = c0 < 0 ? 0 : (c0 > 48 ? 48 : c0);
#pragma unroll
            for (int kb = 0; kb < 4; ++kb)
#pragma unroll
                for (int j = 0; j < 4; ++j) naok[kb][qb][j] = (unsigned)(32 * (kb >> 1) + 8 * rg + 4 * (kb & 1) + j - c0) < 16u; } }
    f32x4 SA[4][2], SB[4][2];
    if (C::NPW == 2) ATT_WAITBAR(4); else ATT_WAITBAR(6);
    bool act = ATT_ACTIVE(0);
    if (act) ATT_QK(SA, 0);
    int slot = 0;
    for (int t0 = 0; t0 < nt; t0 += 2) {
#pragma unroll
      for (int hh = 0; hh < 2; ++hh) {
        f32x4 (&S)[4][2] = hh ? SB : SA; f32x4 (&Sn)[4][2] = hh ? SA : SB;
        const int t = t0 + hh;
        if (t < nt) {
        int s1 = slot + 1; s1 = s1 >= NSLOT ? s1 - NSLOT : s1; int s3 = slot + 3; s3 = s3 >= NSLOT ? s3 - NSLOT : s3;
        if (t + 2 < nt) { if (C::NPW == 2) ATT_WAITBAR(2); else ATT_WAITBAR(3); } else ATT_WAITBAR(0);
        if (t + 3 < nt) ATT_ISSUE(t + 3, s3);
        const bool actn = (t + 1 < nt) && ATT_ACTIVE(t + 1);
        if (actn) ATT_QK(Sn, s1);
        if (act) {
            const LAS unsigned char* vs = lds + slot * C::SLOT + C::KB;
            bf16x8 vfa[NDB16], vfb[NDB16];
            ATT_LDV(vfa, 0); if (NDB16 <= 4) ATT_LDV(vfb, 1);
            __builtin_amdgcn_sched_barrier(0);
            if (MODE_NA) { if (t >= ky.na) {
                const int kr = na.r_lo + (t - ky.na);
#pragma unroll
                for (int qb = 0; qb < 2; ++qb) { const LAS float* brow = na.bias + (kr - na.qr + 7) * 128 + 63 - qcl[qb] + 8 * rg;
#pragma unroll
                    for (int kb = 0; kb < 4; ++kb) { float bb[4];
#pragma unroll
                        for (int j = 0; j < 4; ++j) bb[j] = brow[32 * (kb >> 1) + 4 * (kb & 1) + j];
#pragma unroll
                        for (int j = 0; j < 4; ++j) { const float pb_ = S[kb][qb][j] + bb[j]; S[kb][qb][j] = naok[kb][qb][j] ? pb_ : NEG_BIG; } } } } }
#pragma unroll
            for (int st = 0; st < 2; ++st) {
#pragma unroll
                for (int qb = 0; qb < 2; ++qb) {
                    float e[8];
#pragma unroll
                    for (int j = 0; j < 4; ++j) { e[j] = __builtin_amdgcn_exp2f(S[2 * st][qb][j]); e[4 + j] = __builtin_amdgcn_exp2f(S[2 * st + 1][qb][j]); }
                    v4u pw; pw.x = cvt_pk_bf16(e[0], e[1]); pw.y = cvt_pk_bf16(e[2], e[3]); pw.z = cvt_pk_bf16(e[4], e[5]); pw.w = cvt_pk_bf16(e[6], e[7]);
                    const bf16x8 pb = __builtin_bit_cast(bf16x8, pw);
#pragma unroll
                    for (int db = 0; db < NDB16; ++db) o[db][qb] = __builtin_amdgcn_mfma_f32_16x16x32_bf16((st && NDB16 <= 4) ? vfb[db] : vfa[db], pb, o[db][qb], 0, 0, 0);
                    oL[qb] = __builtin_amdgcn_mfma_f32_16x16x32_bf16(onesf, pb, oL[qb], 0, 0, 0);
                }
                if (NDB16 > 4 && st == 0) ATT_LDV(vfa, 1);
                __builtin_amdgcn_sched_barrier(0); }
        }
        act = actn; slot = s1;
        } }
    }
    ATT_WAITBAR(0);
#pragma unroll
    for (int qb = 0; qb < 2; ++qb) l_out[qb] = __shfl(oL[qb][0], q16);
#undef ATT_LDV
#undef ATT_QK
#undef ATT_ACTIVE
#undef ATT_ISSUE
#undef ATT_DMA
}
template <int NDB16>
__device__ __forceinline__ void store_o16(const f32x4 (&o)[NDB16][2], const float (&scale)[2], bf16_t* Ow  , int q16, int rg) {
#pragma unroll
    for (int qb = 0; qb < 2; ++qb)
#pragma unroll
        for (int i = 0; i < NDB16 / 2; ++i) { const f32x4 va = o[2 * i][qb] * scale[qb], vb = o[2 * i + 1][qb] * scale[qb];
            const unsigned ax = cvt_pk_bf16(va[0], va[1]), ay = cvt_pk_bf16(va[2], va[3]), bx = cvt_pk_bf16(vb[0], vb[1]), by = cvt_pk_bf16(vb[2], vb[3]);
            const auto sx = __builtin_amdgcn_permlane16_swap(ax, bx, false, false);
            const auto sy = __builtin_amdgcn_permlane16_swap(ay, by, false, false);
            v4u w; w.x = sx[0]; w.y = sy[0]; w.z = sx[1]; w.w = sy[1];
            const int col = (rg & 1) ? 16 * (2 * i + 1) + 4 * (rg - 1) : 16 * (2 * i) + 4 * rg;
            *(v4u*)(Ow + (size_t)(16 * qb + q16) * D + col) = w; }
}
template <int NDB>
__device__ __forceinline__ void store_o(const f32x16 (&oT)[NDB], float scale, bf16_t* Op  , int hi) {
#pragma unroll
    for (int db = 0; db < NDB; ++db)
#pragma unroll
        for (int k = 0; k < 2; ++k) { const int g0 = 2 * k, g1 = 2 * k + 1;
            const unsigned w0x = cvt_pk_bf16(oT[db][4 * g0] * scale, oT[db][4 * g0 + 1] * scale), w0y = cvt_pk_bf16(oT[db][4 * g0 + 2] * scale, oT[db][4 * g0 + 3] * scale);
            const unsigned w1x = cvt_pk_bf16(oT[db][4 * g1] * scale, oT[db][4 * g1 + 1] * scale), w1y = cvt_pk_bf16(oT[db][4 * g1 + 2] * scale, oT[db][4 * g1 + 3] * scale);
            const auto sx = __builtin_amdgcn_permlane32_swap(w0x, w1x, false, false);
            const auto sy = __builtin_amdgcn_permlane32_swap(w0y, w1y, false, false);
            v4u w; w.x = sx[0]; w.y = sy[0]; w.z = sx[1]; w.w = sy[1];
            *(v4u*)(Op + 32 * db + 16 * k + 8 * hi) = w; }
}
}
namespace ew {
using namespace mk;

__device__ __forceinline__ void conv_item(const float* __restrict__ W, int ldw, int k0, int n0, int nvalid, bf16_t* __restrict__ dst, int dK, LAS float* scr, int lane) {
    const int n4 = (lane & 15) * 4, kr = lane >> 4;
#pragma unroll
    for (int i = 0; i < 8; ++i) { const int k = kr + 4 * i;
        f32x4 v = (f32x4){0.f, 0.f, 0.f, 0.f};
        if (n4 < nvalid) v = *(const f32x4*)(W + (size_t)(k0 + k) * ldw + n0 + n4);
        scr[k * 65 + n4] = v.x; scr[k * 65 + n4 + 1] = v.y; scr[k * 65 + n4 + 2] = v.z; scr[k * 65 + n4 + 3] = v.w; }
    LDS_WAIT(); asm volatile("" ::: "memory");
    const int c = lane & 3;
#pragma unroll
    for (int j = 0; j < 4; ++j) { const int n = (lane >> 2) + 16 * j; const LAS float* s = scr + (8 * c) * 65 + n;
        v4u o; o.x = cvt_pk_bf16(s[0], s[65]); o.y = cvt_pk_bf16(s[2 * 65], s[3 * 65]); o.z = cvt_pk_bf16(s[4 * 65], s[5 * 65]); o.w = cvt_pk_bf16(s[6 * 65], s[7 * 65]);
        if (n < nvalid) *(v4u*)(dst + (size_t)n * dK + k0 + 8 * c) = o; }
    LDS_WAIT(); asm volatile("" ::: "memory");
}

__device__ __forceinline__ void conv_load(const float* __restrict__ src, int ldw, int nvalid, f32x4 (&v)[8], int lane) {
    const int n4 = (lane & 15) * 4, kr = lane >> 4;
#pragma unroll
    for (int i = 0; i < 8; ++i) { v[i] = (f32x4){0.f, 0.f, 0.f, 0.f}; if (n4 < nvalid) v[i] = *(const f32x4*)(src + (size_t)(kr + 4 * i) * ldw + n4); }
}
__device__ __forceinline__ void conv_store(const f32x4 (&v)[8], unsigned char* __restrict__ dst, int dkb, int nvalid, float scale, int hi_jump, LAS float* scr, int lane) {
    const int n4 = (lane & 15) * 4, kr = lane >> 4;
#pragma unroll
    for (int i = 0; i < 8; ++i) { const int k = kr + 4 * i; scr[k * 65 + n4] = v[i].x; scr[k * 65 + n4 + 1] = v[i].y; scr[k * 65 + n4 + 2] = v[i].z; scr[k * 65 + n4 + 3] = v[i].w; }
    LDS_WAIT(); asm volatile("" ::: "memory");
    const int c = lane & 3;
#pragma unroll
    for (int j = 0; j < 4; ++j) { const int n = (lane >> 2) + 16 * j; const LAS float* s = scr + (8 * c) * 65 + n;
        if (scale == 0.f) { v4u o; o.x = cvt_pk_bf16(s[0], s[65]); o.y = cvt_pk_bf16(s[2 * 65], s[3 * 65]); o.z = cvt_pk_bf16(s[4 * 65], s[5 * 65]); o.w = cvt_pk_bf16(s[6 * 65], s[7 * 65]);
            if (n < nvalid) *(v4u*)(dst + (size_t)(n + (n >= 32 ? hi_jump : 0)) * dkb + 16 * c) = o; }
        else { v2u o; o.x = cvt4_fp8(s[0] * scale, s[65] * scale, s[2 * 65] * scale, s[3 * 65] * scale); o.y = cvt4_fp8(s[4 * 65] * scale, s[5 * 65] * scale, s[6 * 65] * scale, s[7 * 65] * scale);
            *(v2u*)(dst + (size_t)n * dkb + 8 * c) = o; } }
    LDS_WAIT(); asm volatile("" ::: "memory");
}
__device__ __forceinline__ void conv_item_f8(const float* __restrict__ W, int ldw, int k0, int n0, unsigned char* __restrict__ dst, int dKb, float scale, LAS float* scr, int lane) {
    const int n4 = (lane & 15) * 4, kr = lane >> 4;
#pragma unroll
    for (int i = 0; i < 8; ++i) { const int k = kr + 4 * i;
        const f32x4 v = *(const f32x4*)(W + (size_t)(k0 + k) * ldw + n0 + n4);
        scr[k * 65 + n4] = v.x; scr[k * 65 + n4 + 1] = v.y; scr[k * 65 + n4 + 2] = v.z; scr[k * 65 + n4 + 3] = v.w; }
    LDS_WAIT(); asm volatile("" ::: "memory");
    const int c = lane & 3;
#pragma unroll
    for (int j = 0; j < 4; ++j) { const int n = (lane >> 2) + 16 * j; const LAS float* s = scr + (8 * c) * 65 + n;
        v2u o; o.x = cvt4_fp8(s[0] * scale, s[65] * scale, s[2 * 65] * scale, s[3 * 65] * scale); o.y = cvt4_fp8(s[4 * 65] * scale, s[5 * 65] * scale, s[6 * 65] * scale, s[7 * 65] * scale);
        *(v2u*)(dst + (size_t)n * dKb + k0 + 8 * c) = o; }
    LDS_WAIT(); asm volatile("" ::: "memory");
}

__device__ __forceinline__ void normmod_row(const float* __restrict__ xrow, const float* __restrict__ g, const float* __restrict__ sh, const float* __restrict__ sc, bf16_t* __restrict__ orow, int lane) {
    const f32x4* xr = (const f32x4*)xrow + lane;
    f32x4 v[4]; float s = 0.f;
#pragma unroll
    for (int j = 0; j < 4; ++j) { v[j] = xr[64 * j]; s += (v[j].x * v[j].x + v[j].y * v[j].y) + (v[j].z * v[j].z + v[j].w * v[j].w); }
    const float rstd = rsqrtf(wave_sum(s) * (1.f / D) + EPS);
    v2u* o8 = (v2u*)orow + lane;
#pragma unroll
    for (int j = 0; j < 4; ++j) { const f32x4 gg = ((const f32x4*)g)[lane + 64 * j], s1 = ((const f32x4*)sc)[lane + 64 * j], s0 = ((const f32x4*)sh)[lane + 64 * j];
        const f32x4 y = v[j] * rstd * gg * (s1 + 1.f) + s0;
        v2u w; w.x = cvt_pk_bf16(y.x, y.y); w.y = cvt_pk_bf16(y.z, y.w); o8[64 * j] = w; }
}

__device__ __forceinline__ void unpack8(const v4u w, float (&f)[8]);
__device__ __forceinline__ v4u pack8(const float (&f)[8]);
__device__ __forceinline__ void normmod_row_bf(const bf16_t* __restrict__ xrow, const float* __restrict__ g, const float* __restrict__ sh, const float* __restrict__ sc, bf16_t* __restrict__ orow, int lane) {
    float f[2][8]; float s = 0.f;
#pragma unroll
    for (int j = 0; j < 2; ++j) { unpack8(*((const v4u*)xrow + lane + 64 * j), f[j]);
#pragma unroll
        for (int q = 0; q < 8; ++q) s += f[j][q] * f[j][q]; }
    const float rstd = rsqrtf(wave_sum(s) * (1.f / D) + EPS);
#pragma unroll
    for (int j = 0; j < 2; ++j) { const int c = 8 * lane + 512 * j;
#pragma unroll
        for (int h = 0; h < 2; ++h) { const f32x4 gg = *(const f32x4*)(g + c + 4 * h), s1 = *(const f32x4*)(sc + c + 4 * h), s0 = *(const f32x4*)(sh + c + 4 * h);
#pragma unroll
            for (int q = 0; q < 4; ++q) f[j][4 * h + q] = f[j][4 * h + q] * rstd * gg[q] * (s1[q] + 1.f) + s0[q]; }
        *((v4u*)orow + lane + 64 * j) = pack8(f[j]); }
}

struct RowRegs { f32x4 v[4]; v4u w[2]; };
template <bool BF> __device__ __forceinline__ void nm_load(const void* xrow, RowRegs& R, int lane) {
    if (BF) { R.w[0] = *((const v4u*)xrow + lane); R.w[1] = *((const v4u*)xrow + lane + 64); }
    else {
#pragma unroll
        for (int j = 0; j < 4; ++j) R.v[j] = ((const f32x4*)xrow)[lane + 64 * j]; }
}
template <bool BF> __device__ __forceinline__ void nm_finish(const RowRegs& R, const float* __restrict__ g, const float* __restrict__ sh, const float* __restrict__ sc, bf16_t* __restrict__ orow, int lane) {
    if (BF) {
        float f[2][8]; float s = 0.f;
#pragma unroll
        for (int j = 0; j < 2; ++j) { unpack8(R.w[j], f[j]);
#pragma unroll
            for (int q = 0; q < 8; ++q) s += f[j][q] * f[j][q]; }
        const float rstd = rsqrtf(wave_sum(s) * (1.f / D) + EPS);
#pragma unroll
        for (int j = 0; j < 2; ++j) { const int c = 8 * lane + 512 * j;
#pragma unroll
            for (int h = 0; h < 2; ++h) { const f32x4 gg = *(const f32x4*)(g + c + 4 * h), s1 = *(const f32x4*)(sc + c + 4 * h), s0 = *(const f32x4*)(sh + c + 4 * h);
#pragma unroll
                for (int q = 0; q < 4; ++q) f[j][4 * h + q] = f[j][4 * h + q] * rstd * gg[q] * (s1[q] + 1.f) + s0[q]; }
            *((v4u*)orow + lane + 64 * j) = pack8(f[j]); }
    } else {
        float s = 0.f;
#pragma unroll
        for (int j = 0; j < 4; ++j) s += (R.v[j].x * R.v[j].x + R.v[j].y * R.v[j].y) + (R.v[j].z * R.v[j].z + R.v[j].w * R.v[j].w);
        const float rstd = rsqrtf(wave_sum(s) * (1.f / D) + EPS);
        v2u* o8 = (v2u*)orow + lane;
#pragma unroll
        for (int j = 0; j < 4; ++j) { const f32x4 gg = ((const f32x4*)g)[lane + 64 * j], s1 = ((const f32x4*)sc)[lane + 64 * j], s0 = ((const f32x4*)sh)[lane + 64 * j];
            const f32x4 y = R.v[j] * rstd * gg * (s1 + 1.f) + s0;
            v2u w; w.x = cvt_pk_bf16(y.x, y.y); w.y = cvt_pk_bf16(y.z, y.w); o8[64 * j] = w; }
    }
}
struct ModRegs { f32x4 mul[4], add[4]; };
template <bool BF> __device__ __forceinline__ void nm_mod_load(ModRegs& M, const float* __restrict__ g, const float* __restrict__ sh, const float* __restrict__ sc, int lane) {
#pragma unroll
    for (int k = 0; k < 4; ++k) { const int c = BF ? 8 * lane + 512 * (k >> 1) + 4 * (k & 1) : 4 * lane + 256 * k;
        M.mul[k] = *(const f32x4*)(g + c) * (*(const f32x4*)(sc + c) + 1.f); M.add[k] = *(const f32x4*)(sh + c); }
}
template <bool BF> __device__ __forceinline__ void nm_finish_m(const RowRegs& R, const ModRegs& M, bf16_t* __restrict__ orow, int lane) {
    if (BF) {
        float f[2][8]; float s = 0.f;
#pragma unroll
        for (int j = 0; j < 2; ++j) { unpack8(R.w[j], f[j]);
#pragma unroll
            for (int q = 0; q < 8; ++q) s += f[j][q] * f[j][q]; }
        const float rstd = rsqrtf(wave_sum(s) * (1.f / D) + EPS);
#pragma unroll
        for (int j = 0; j < 2; ++j) {
#pragma unroll
            for (int h = 0; h < 2; ++h)
#pragma unroll
                for (int q = 0; q < 4; ++q) f[j][4 * h + q] = f[j][4 * h + q] * rstd * M.mul[2 * j + h][q] + M.add[2 * j + h][q];
            *((v4u*)orow + lane + 64 * j) = pack8(f[j]); }
    } else {
        float s = 0.f;
#pragma unroll
        for (int j = 0; j < 4; ++j) s += (R.v[j].x * R.v[j].x + R.v[j].y * R.v[j].y) + (R.v[j].z * R.v[j].z + R.v[j].w * R.v[j].w);
        const float rstd = rsqrtf(wave_sum(s) * (1.f / D) + EPS);
        v2u* o8 = (v2u*)orow + lane;
#pragma unroll
        for (int j = 0; j < 4; ++j) { const f32x4 y = R.v[j] * rstd * M.mul[j] + M.add[j];
            v2u w; w.x = cvt_pk_bf16(y.x, y.y); w.y = cvt_pk_bf16(y.z, y.w); o8[64 * j] = w; }
    }
}
__device__ __forceinline__ void unpack8(const v4u w, float (&f)[8]) { f[0] = bflo(w.x); f[1] = bfhi(w.x); f[2] = bflo(w.y); f[3] = bfhi(w.y); f[4] = bflo(w.z); f[5] = bfhi(w.z); f[6] = bflo(w.w); f[7] = bfhi(w.w); }
__device__ __forceinline__ v4u pack8(const float (&f)[8]) { v4u w; w.x = cvt_pk_bf16(f[0], f[1]); w.y = cvt_pk_bf16(f[2], f[3]); w.z = cvt_pk_bf16(f[4], f[5]); w.w = cvt_pk_bf16(f[6], f[7]); return w; }

struct Rope { const f32x2* t64; const f32x2* t32; };

__device__ __forceinline__ void seg64(float (&f)[8], int lane, const float (&g8)[8]  , bool rope, int gr, int gc, const Rope& R, float scale) {
    const int s = lane & 7;
    float ss = 0.f;
#pragma unroll
    for (int j = 0; j < 8; ++j) ss += f[j] * f[j];
    ss = sum8_f(ss);
    const float rstd = rsqrtf(ss * (1.f / 64.f) + EPS);
#pragma unroll
    for (int j = 0; j < 8; ++j) f[j] = f[j] * rstd * g8[j];
    float pr[8];
#pragma unroll
    for (int j = 0; j < 8; ++j) pr[j] = xor2_f(f[j]);
    if (rope) {
        const int pos = (s >> 2) ? gc : gr; const bool x1 = (s & 3) < 2; const int i0 = 8 * (s & 1);
#pragma unroll
        for (int j = 0; j < 8; ++j) { const f32x2 cs = R.t64[pos * 16 + i0 + j]; f[j] = x1 ? (f[j] * cs.x - pr[j] * cs.y) : (pr[j] * cs.y + f[j] * cs.x); }
    }
#pragma unroll
    for (int j = 0; j < 8; ++j) f[j] *= scale;
}
}
namespace mk {
constexpr size_t MiB = (size_t)1 << 20;
constexpr size_t WS_CTL = 0, CTL_ZERO_BYTES = 1 * MiB;
constexpr size_t WS_MODF = 1 * MiB;
constexpr size_t WS_ROPE = 2 * MiB;
constexpr size_t WS_SLOT_TOK = 3 * MiB;
constexpr size_t WS_SLOT_G = 5 * MiB;
constexpr size_t WS_XC = 8 * MiB;
constexpr size_t WS_WQK0 = 16 * MiB, WS_WV0 = 20 * MiB, WS_WO0 = 22 * MiB, WS_WGU0 = 24 * MiB, WS_WD0 = 35 * MiB;
constexpr size_t WS_WODD = 41 * MiB, WS_WVC = 43 * MiB + 512 * 1024, WS_WO1 = 44 * MiB, WS_WUQ = 46 * MiB, WS_WUKN = 46 * MiB + 512 * 1024, WS_WUKV = 46 * MiB + 640 * 1024;
constexpr size_t WS_W13 = 48 * MiB, WS_W2 = 104 * MiB;
constexpr float W13_SCALE = 256.f, W2_SCALE = 512.f, ACT_SCALE = 16.f;
constexpr size_t WS_XB = 216 * MiB;
constexpr size_t OUT_H = 0, OUT_CQN = 0, OUT_CKVN = 17 * MiB, OUT_KN = 26 * MiB;
constexpr size_t WS_BIG = 284 * MiB;
constexpr size_t WS_QK0 = WS_BIG, WS_VT0 = 420 * MiB, WS_DSCR = 488 * MiB, WS_MID0 = WS_BIG;
constexpr size_t WS_P1 = WS_BIG, WS_VT1C = 369 * MiB, WS_QD = 386 * MiB, WS_VT1D = 434 * MiB, WS_KDF = 468 * MiB, WS_MID1 = WS_BIG;
constexpr size_t WS_END = 522 * MiB;
constexpr int CW_TMO = 0, CW_GCNT = 64, CW_BAR = 4096;
constexpr int RING_BYTES = 131072, LDSCTL_OFF = RING_BYTES, MISC_OFF = LDSCTL_OFF + 320, LDS_BYTES = 147456;
constexpr int P1LD = 1280;
constexpr float QSCALE64 = 0.125f * LOG2E, QSCALE96 = 0.10206207261596575f * LOG2E;
constexpr int NPHASE = 22;
}

#define XB_TMO      128
#define XB_XCNT(j)  (256  + 64 * (j))
#define XB_XSUB(j)  (1280 + 64 * (j))
#define XB_XGEN(j)  (2304 + 64 * (j))
#define XB_TOP      3328
#define XB_TOPGEN   3392
#define XCD_BAR_WORDS 3456
#define XB_SPIN_CAP (1u << 18)

__device__ __forceinline__ unsigned xb_ld(unsigned* p)              { return __hip_atomic_load(p, __ATOMIC_RELAXED, __HIP_MEMORY_SCOPE_AGENT); }
__device__ __forceinline__ unsigned xb_add(unsigned* p, unsigned v) { return __hip_atomic_fetch_add(p, v, __ATOMIC_RELAXED, __HIP_MEMORY_SCOPE_AGENT); }
__device__ __forceinline__ unsigned xb_xcc_id() { return (unsigned)__builtin_amdgcn_s_getreg((3 << 11) | 20) & 0xFu; }
#define XB_SPIN(cond, bar) do { unsigned _sp = 0; while (cond) { __builtin_amdgcn_s_sleep(1); \
    if ((++_sp & 255u) == 0u) { if (xb_ld(&(bar)[XB_TMO])) break; if (_sp > XB_SPIN_CAP) { atomicAdd(&(bar)[XB_TMO], 1u); break; } } } } while (0)

struct XcdBarrier {
    unsigned* bar; unsigned x;
    volatile LAS unsigned* st;
};

__device__ __forceinline__ XcdBarrier xcd_barrier_post(unsigned* bar, volatile LAS unsigned* st) {
    XcdBarrier b; b.bar = bar; b.x = xb_xcc_id(); b.st = st;
    if (threadIdx.x == 0) (void)xb_add(&bar[XB_XCNT(b.x)], 1u);
    return b;
}
__device__ __forceinline__ void xcd_barrier_complete(unsigned* bar, unsigned x, unsigned& nloc, unsigned& nx) {
    const unsigned G = gridDim.x * gridDim.y * gridDim.z;
    unsigned sum, cnt, mine, sp = 0u;
    for (;;) {
        sum = 0u; cnt = 0u; mine = 0u;
#pragma unroll
        for (unsigned j = 0; j < 16; ++j) { const unsigned c = xb_ld(&bar[XB_XCNT(j)]); sum += c; cnt += (c > 0u) ? 1u : 0u; mine = (j == x) ? c : mine; }
        if (sum == G) break;
        __builtin_amdgcn_s_sleep(1);
        if ((++sp & 255u) == 0u) { if (xb_ld(&bar[XB_TMO])) break; if (sp > XB_SPIN_CAP) { atomicAdd(&bar[XB_TMO], 1u); break; } }
    }
    nloc = mine > 0u ? mine : 1u; nx = cnt > 0u ? cnt : 1u;
}

__device__ __forceinline__ void xcd_barrier(const XcdBarrier& b) {
    asm volatile("s_waitcnt vmcnt(0)" ::: "memory");
    __syncthreads();
    if (threadIdx.x == 0) {
        unsigned* bar = b.bar;
        __builtin_amdgcn_s_waitcnt(0);
        unsigned nloc = b.st[0], nx = b.st[1];
        if (nloc == 0u) { xcd_barrier_complete(bar, b.x, nloc, nx); b.st[0] = nloc; b.st[1] = nx; }
        const unsigned old = xb_add(&bar[XB_XSUB(b.x)], 1u);
        const unsigned gen = old / nloc;
        if (old + 1u == (gen + 1u) * nloc) {
            __builtin_amdgcn_fence(__ATOMIC_RELEASE, "agent");
            asm volatile("s_waitcnt vmcnt(0)" ::: "memory");
            const unsigned og = xb_add(&bar[XB_TOP], 1u);
            const unsigned tg = og / nx;
            if (og + 1u == (tg + 1u) * nx) xb_add(&bar[XB_TOPGEN], 1u);
            else XB_SPIN(xb_ld(&bar[XB_TOPGEN]) == tg, bar);
            __builtin_amdgcn_fence(__ATOMIC_ACQUIRE, "agent");
            xb_add(&bar[XB_XGEN(b.x)], 1u);
            asm volatile("s_waitcnt vmcnt(0)" ::: "memory");
        } else {
            XB_SPIN(xb_ld(&bar[XB_XGEN(b.x)]) == gen, bar);
            __builtin_amdgcn_fence(__ATOMIC_ACQUIRE, "agent");
            asm volatile("s_waitcnt vmcnt(0)" ::: "memory");
        }
    }
    __syncthreads();
}


namespace mk {
struct Args { const float* in[37]; float* out; unsigned char* ws; int ph_lo, ph_hi; };

struct Frame {
    LAS unsigned char* lds; volatile LAS unsigned* MISC; gu32* ctl;
    int tid, lane, wave, G, vcu, gw, NGW;
};

__device__ __forceinline__ void p0_prologue(Frame& F, const Args& a, bool do_mod, bool do_conv) {
    unsigned char* ws = a.ws;
    LAS float* sct = (LAS float*)F.lds;
    for (int i = F.tid; i < 9 * D; i += NTHR) { const int v = i >> 10, k = i & 1023; const float x = v < 8 ? a.in[1][v * D + k] : a.in[3][k]; sct[i] = x / (1.f + expf(-x)); }
    __syncthreads();
    if (do_mod) {
        LAS float* red = (LAS float*)(F.lds + 40960);
        for (int it = blockIdx.x; it < 384; it += F.G) {
            const int l = it / 192, j0 = (it % 192) * 32, cl = F.tid & 31, ks = F.tid >> 5, col = j0 + cl;
            const float* W = a.in[4] + (size_t)l * D * 6144 + col + (size_t)(ks * 64) * 6144;
            float acc[9];
#pragma unroll
            for (int v = 0; v < 9; ++v) acc[v] = 0.f;
#pragma unroll 16
            for (int k = 0; k < 64; ++k) { const float w = W[(size_t)k * 6144];
#pragma unroll
                for (int v = 0; v < 9; ++v) acc[v] += sct[v * D + ks * 64 + k] * w; }
#pragma unroll
            for (int v = 0; v < 9; ++v) red[(ks * 9 + v) * 32 + cl] = acc[v];
            __syncthreads();
            if (F.tid < 288) { const int v = F.tid >> 5; float s = 0.f;
#pragma unroll
                for (int q = 0; q < 16; ++q) s += red[(q * 9 + v) * 32 + cl];
                ((float*)(ws + WS_MODF))[((size_t)l * 9 + v) * 6144 + col] = s + a.in[5][l * 6144 + col]; }
            __syncthreads();
        }
    }
    if (blockIdx.x == 0) {
        f32x2* t64 = (f32x2*)(ws + WS_ROPE); f32x2* t32 = (f32x2*)(ws + WS_ROPE + 16384);
        for (int i = F.tid; i < 64 * 16; i += NTHR) { const int pos = i >> 4, k = i & 15; const float ang = (float)pos * powf(10000.f, -(float)k / 16.f); t64[i] = (f32x2){cosf(ang), sinf(ang)}; }
        for (int i = F.tid; i < 64 * 8; i += NTHR) { const int pos = i >> 3, k = i & 7; const float ang = (float)pos * powf(10000.f, -(float)k / 8.f); t32[i] = (f32x2){cosf(ang), sinf(ang)}; }
        if (F.tid < 256) { const int kq = F.tid >> 6, d = F.tid & 63; ((float*)(ws + WS_ROPE + 32768))[F.tid] = a.in[kq == 0 ? 10 : kq == 1 ? 11 : kq == 2 ? 13 : 14][d]; }
    }
    LAS float* scr = (LAS float*)(F.lds + 61440 + F.wave * 8448);
    constexpr int I_EVIN = 32 * 48, I_EVOUT = 32 * 16, I_FG = 32 * 44, I_FU = 32 * 44, I_FD = 88 * 16, I_ODIN = 32 * 19, I_ODOUT = 32 * 16, I_UQ = 8 * 12, I_UKV = 4 * 16;
    constexpr int I_W1 = 32 * 56, I_W2 = 112 * 16;
    constexpr int I_SMALL = I_EVIN + I_EVOUT + I_FG + I_FU + I_FD + I_ODIN + I_ODOUT + I_UQ + I_UKV;
    constexpr int I_TOTAL = I_SMALL + 8 * (2 * I_W1 + I_W2);
#define P0_DECODE(it_, SRC, LDW, DST, DKB, NV, SCL, JMP) do { int r = (it_); NV = 64; SCL = 0.f; JMP = 0; \
        if (r < I_EVIN) { const int kb = r / 48, nb = r % 48, n0 = nb * 64; bf16_t* d_; \
              \
            if (n0 < 1024 || (n0 >= 1536 && n0 < 2560)) { const int lc = n0 < 1024 ? n0 : n0 - 512; d_ = (bf16_t*)(ws + WS_WQK0) + (size_t)((lc >> 8) * 256 + ((lc >> 6) & 3) * 32) * D; JMP = 96; } \
            else if (n0 < 1536) d_ = (bf16_t*)(ws + WS_WV0) + (size_t)(n0 - 1024) * D; else d_ = (bf16_t*)(ws + WS_WV0) + (size_t)(n0 - 2048) * D; \
            SRC = a.in[8] + (size_t)(kb * 32) * 3072 + n0; LDW = 3072; DST = (unsigned char*)(d_ + kb * 32); DKB = D * 2; break; } r -= I_EVIN; \
        if (r < I_EVOUT) { const int kb = r / 16, n0 = (r % 16) * 64; SRC = a.in[9] + (size_t)(kb * 32) * D + n0; LDW = D; DST = (unsigned char*)((bf16_t*)(ws + WS_WO0) + (size_t)n0 * D + kb * 32); DKB = D * 2; break; } r -= I_EVOUT; \
        if (r < I_FG) { const int kb = r / 44, n0 = (r % 44) * 64; SRC = a.in[20] + (size_t)(kb * 32) * 2816 + n0; LDW = 2816; DST = (unsigned char*)((bf16_t*)(ws + WS_WGU0) + (size_t)((n0 >> 7) * 256 + (n0 & 127)) * D + kb * 32); DKB = D * 2; break; } r -= I_FG; \
        if (r < I_FU) { const int kb = r / 44, n0 = (r % 44) * 64; SRC = a.in[21] + (size_t)(kb * 32) * 2816 + n0; LDW = 2816; DST = (unsigned char*)((bf16_t*)(ws + WS_WGU0) + (size_t)((n0 >> 7) * 256 + 128 + (n0 & 127)) * D + kb * 32); DKB = D * 2; break; } r -= I_FU; \
        if (r < I_FD) { const int kb = r / 16, n0 = (r % 16) * 64; SRC = a.in[22] + (size_t)(kb * 32) * D + n0; LDW = D; DST = ws + WS_WD0 + (size_t)n0 * 2816 + kb * 32; DKB = 2816; SCL = W2_SCALE; break; } r -= I_FD; \
        if (r < I_ODIN) { const int kb = r / 19, nb = r % 19, n0 = nb * 64; bf16_t* d_; \
            if (n0 < 512) d_ = (bf16_t*)(ws + WS_WODD) + (size_t)n0 * D; else if (n0 < 640) d_ = (bf16_t*)(ws + WS_WODD) + (size_t)(n0 + 256) * D; \
            else if (n0 < 768) d_ = (bf16_t*)(ws + WS_WVC) + (size_t)(n0 - 640) * D; else if (n0 < 1024) d_ = (bf16_t*)(ws + WS_WODD) + (size_t)(n0 - 256) * D; \
            else if (n0 < 1152) d_ = (bf16_t*)(ws + WS_WODD) + (size_t)(n0 - 128) * D; else { d_ = (bf16_t*)(ws + WS_WODD) + (size_t)(n0 - 128) * D; NV = 32; } \
            SRC = a.in[23] + (size_t)(kb * 32) * 1184 + n0; LDW = 1184; DST = (unsigned char*)(d_ + kb * 32); DKB = D * 2; break; } r -= I_ODIN; \
        if (r < I_ODOUT) { const int kb = r / 16, n0 = (r % 16) * 64; SRC = a.in[24] + (size_t)(kb * 32) * D + n0; LDW = D; DST = (unsigned char*)((bf16_t*)(ws + WS_WO1) + (size_t)n0 * D + kb * 32); DKB = D * 2; break; } r -= I_ODOUT; \
        if (r < I_UQ) { const int kb = r / 12, n0 = (r % 12) * 64; SRC = a.in[28] + (size_t)(kb * 32) * 768 + n0; LDW = 768; DST = (unsigned char*)((bf16_t*)(ws + WS_WUQ) + (size_t)n0 * 256 + kb * 32); DKB = 256 * 2; break; } r -= I_UQ; \
        if (r < I_UKV) { const int kb = r / 16, nb = r % 16, n0 = nb * 64, h = nb >> 1; \
            bf16_t* d_ = (nb & 1) ? (bf16_t*)(ws + WS_WUKV) + (size_t)(h * 64) * 128 : (bf16_t*)(ws + WS_WUKN) + (size_t)(h * 64) * 128; \
            SRC = a.in[30] + (size_t)(kb * 32) * 1024 + n0; LDW = 1024; DST = (unsigned char*)(d_ + kb * 32); DKB = 128 * 2; break; } r -= I_UKV; \
        { const int e = r / (2 * I_W1 + I_W2); int q = r % (2 * I_W1 + I_W2); \
          if (q < 2 * I_W1) { const int up = q >= I_W1; if (up) q -= I_W1; const int kb = q / 56, n0 = (q % 56) * 64; \
              SRC = a.in[up ? 35 : 34] + (size_t)e * D * 3584 + (size_t)(kb * 32) * 3584 + n0; LDW = 3584; DST = ws + WS_W13 + ((size_t)e * 7168 + (n0 >> 7) * 256 + (up ? 128 : 0) + (n0 & 127)) * D + kb * 32; DKB = D; SCL = W13_SCALE; } \
          else { q -= 2 * I_W1; const int kb = q / 16, n0 = (q % 16) * 64; \
              SRC = a.in[36] + (size_t)e * 3584 * D + (size_t)(kb * 32) * D + n0; LDW = D; DST = ws + WS_W2 + ((size_t)e * D + n0) * 3584 + kb * 32; DKB = 3584; SCL = W2_SCALE; } } } while (0)
    if (do_conv) {
        const float* sA; int lA, nvA, jA; unsigned char* dA; int kA; float cA_; f32x4 vA[8];
        const float* sB; int lB, nvB, jB; unsigned char* dB; int kB; float cB_; f32x4 vB[8];
        int it = F.gw;
        if (it < I_TOTAL) { P0_DECODE(it, sA, lA, dA, kA, nvA, cA_, jA); ew::conv_load(sA, lA, nvA, vA, F.lane); }
        while (it < I_TOTAL) {
            const int i1 = it + F.NGW;
            if (i1 < I_TOTAL) { P0_DECODE(i1, sB, lB, dB, kB, nvB, cB_, jB); ew::conv_load(sB, lB, nvB, vB, F.lane); }
            ew::conv_store(vA, dA, kA, nvA, cA_, jA, scr, F.lane);
            const int i2 = i1 + F.NGW;
            if (i2 < I_TOTAL) { P0_DECODE(i2, sA, lA, dA, kA, nvA, cA_, jA); ew::conv_load(sA, lA, nvA, vA, F.lane); }
            if (i1 < I_TOTAL) ew::conv_store(vB, dB, kB, nvB, cB_, jB, scr, F.lane);
            it = i2;
        }
    }
#undef P0_DECODE
}

template <bool LAT_BF16>
__device__ __forceinline__ void normmod_phase(Frame& F, const void* xlat, const float* xctx, const float* g, const float* modl, int sh_chunk, bf16_t* H, int nrows) {
    const int per = ((nrows + F.NGW - 1) / F.NGW + 1) & ~1;
    const int r0 = F.gw * per, r1 = (r0 + per) < nrows ? (r0 + per) : nrows;
    ew::ModRegs M; int vcur = -1;
    ew::RowRegs A, B, C, Dd;
#define NM_LOADP(X, Y, r_) do { const int _r = (r_); const bool _lat = _r < NLAT; \
        if (_lat && LAT_BF16) { const bf16_t* _x = (const bf16_t*)xlat + (size_t)_r * D; ew::nm_load<true>(_x, X, F.lane); ew::nm_load<true>(_x + D, Y, F.lane); } \
        else { const float* _x = _lat ? (const float*)xlat + (size_t)_r * D : xctx + (size_t)(_r - NLAT) * D; ew::nm_load<false>(_x, X, F.lane); ew::nm_load<false>(_x + D, Y, F.lane); } } while (0)
#define NM_FINP(X, Y, r_) do { const int _r = (r_); const bool _lat = _r < NLAT; const int _v = _lat ? _r / S : 8; \
        if (_lat && LAT_BF16) { if (_v != vcur) { const float* _sh = modl + (size_t)_v * 6144 + sh_chunk * D; ew::nm_mod_load<true>(M, g, _sh, _sh + D, F.lane); vcur = _v; } \
            ew::nm_finish_m<true>(X, M, H + (size_t)_r * D, F.lane); ew::nm_finish_m<true>(Y, M, H + (size_t)(_r + 1) * D, F.lane); } \
        else { const int _vk = LAT_BF16 ? _v + 16 : _v; if (_vk != vcur) { const float* _sh = modl + (size_t)_v * 6144 + sh_chunk * D; ew::nm_mod_load<false>(M, g, _sh, _sh + D, F.lane); vcur = _vk; } \
            ew::nm_finish_m<false>(X, M, H + (size_t)_r * D, F.lane); ew::nm_finish_m<false>(Y, M, H + (size_t)(_r + 1) * D, F.lane); } } while (0)
    if (r0 < r1) NM_LOADP(A, B, r0);
    for (int row = r0; row < r1; row += 4) {
        if (row + 2 < r1) NM_LOADP(C, Dd, row + 2);
        NM_FINP(A, B, row);
        if (row + 2 < r1) { if (row + 4 < r1) NM_LOADP(A, B, row + 4); NM_FINP(C, Dd, row + 2); }
    }
#undef NM_LOADP
#undef NM_FINP
}

__device__ __forceinline__ void post_even(Frame& F, const Args& a) {
    bf16_t* QK = (bf16_t*)(a.ws + WS_QK0);
    const ew::Rope R{(const f32x2*)(a.ws + WS_ROPE), (const f32x2*)(a.ws + WS_ROPE + 16384)};
    const int per = (NTOK + F.NGW - 1) / F.NGW; const int r0 = F.gw * per, r1 = (r0 + per) < NTOK ? (r0 + per) : NTOK;
    for (int row = r0; row < r1; ++row) {
        const bool lat = row < NLAT; const int pos = row & (S - 1), gr = pos >> 6, gc = pos & 63;
#pragma unroll
        for (int ch = 0; ch < 4; ++ch) {
            v4u* p = (v4u*)(QK + (size_t)row * 2048 + ch * 512) + F.lane;
            float f[8]; ew::unpack8(*p, f);
            const float* g = a.in[ch == 0 ? 10 : ch == 1 ? 11 : ch == 2 ? 13 : 14];
            float g8[8];
#pragma unroll
            for (int j = 0; j < 8; ++j) g8[j] = g[8 * (F.lane & 7) + j];
            ew::seg64(f, F.lane, g8, ch >= 2 && lat, gr, gc, R, (ch == 0 || ch == 2) ? QSCALE64 : 1.f);
            *p = ew::pack8(f);
        }
    }
}

__device__ __forceinline__ void post_odd(Frame& F, const Args& a) {
    bf16_t* P1 = (bf16_t*)(a.ws + WS_P1); bf16_t* CQN = (bf16_t*)((unsigned char*)a.out + OUT_CQN); bf16_t* CKVN = (bf16_t*)((unsigned char*)a.out + OUT_CKVN);
    const ew::Rope R{(const f32x2*)(a.ws + WS_ROPE), (const f32x2*)(a.ws + WS_ROPE + 16384)};
    const int per = (NTOK + F.NGW - 1) / F.NGW; const int r0 = F.gw * per, r1 = (r0 + per) < NTOK ? (r0 + per) : NTOK;
    float gq8[8], g2[8], g2p[8];
    { const int s7 = F.lane & 7;
      const float* gsel = F.lane < 32 ? a.in[27] + 8 * F.lane : (F.lane < 48 ? a.in[26] + 8 * s7 : a.in[29] + 8 * (F.lane - 48));
#pragma unroll
      for (int j = 0; j < 8; ++j) { gq8[j] = a.in[25][8 * s7 + j]; g2[j] = gsel[j]; g2p[j] = a.in[26][8 * (s7 ^ 2) + j]; } }
    v4u nq = (v4u){0u, 0u, 0u, 0u}, nc = nq;
    if (r0 < r1) { nq = *((const v4u*)(P1 + (size_t)r0 * P1LD) + F.lane); nc = *((const v4u*)(P1 + (size_t)r0 * P1LD + 512) + F.lane); }
    for (int row = r0; row < r1; ++row) {
        const bool lat = row < NLAT; const int pos = row & (S - 1), gr = pos >> 6, gc = pos & 63;
        const v4u cq_ = nq, cc_ = nc;
        if (row + 1 < r1) { nq = *((const v4u*)(P1 + (size_t)(row + 1) * P1LD) + F.lane); nc = *((const v4u*)(P1 + (size_t)(row + 1) * P1LD + 512) + F.lane); }
        { v4u* p = (v4u*)(P1 + (size_t)row * P1LD) + F.lane; float f[8]; ew::unpack8(cq_, f);
          ew::seg64(f, F.lane, gq8, lat, gr, gc, R, QSCALE64); *p = ew::pack8(f); }
        { v4u* p = (v4u*)(P1 + (size_t)row * P1LD + 512) + F.lane; float f[8]; ew::unpack8(cc_, f);
          float ss = 0.f;
#pragma unroll
          for (int j = 0; j < 8; ++j) ss += f[j] * f[j];
          const float s3 = sum8_f(ss); const float s4 = s3 + xor8_f(s3);
          float s5; { const auto r16 = __builtin_amdgcn_permlane16_swap(__float_as_uint(s4), __float_as_uint(s4), false, false); s5 = __uint_as_float(r16[0]) + __uint_as_float(r16[1]); }
          float pr[8];
#pragma unroll
          for (int j = 0; j < 8; ++j) pr[j] = xor2_f(f[j]);
          if (F.lane < 32) {
              const float rstd = rsqrtf(s5 * (1.f / 256.f) + EPS);
#pragma unroll
              for (int j = 0; j < 8; ++j) f[j] = f[j] * rstd * g2[j];
              *((v4u*)(CQN + (size_t)row * 256) + F.lane) = ew::pack8(f);
          } else if (F.lane < 48) {
              const int s = F.lane & 7; const float rstd = rsqrtf(s3 * (1.f / 64.f) + EPS);
#pragma unroll
              for (int j = 0; j < 8; ++j) { f[j] = f[j] * rstd * g2[j]; }
#pragma unroll
              for (int j = 0; j < 8; ++j) pr[j] = pr[j] * rstd * g2p[j];
              if (lat) { const int ps = (s >> 2) ? gc : gr; const bool x1 = (s & 3) < 2; const int i0 = 8 * (s & 1);
#pragma unroll
                  for (int j = 0; j < 8; ++j) { const f32x2 cs = R.t64[ps * 16 + i0 + j]; f[j] = x1 ? (f[j] * cs.x - pr[j] * cs.y) : (pr[j] * cs.y + f[j] * cs.x); } }
              *p = ew::pack8(f);
          } else {
              const float rstd = rsqrtf(s4 * (1.f / 128.f) + EPS);
#pragma unroll
              for (int j = 0; j < 8; ++j) f[j] = f[j] * rstd * g2[j];
              *((v4u*)(CKVN + (size_t)row * 128) + (F.lane - 48)) = ew::pack8(f);
          } }
    }
}

__device__ __forceinline__ void seg96(float (&f)[8], int lane, bool valid, const float (&g8)[8]  , bool rope, int gr, int gc, const ew::Rope& R, float scale) {
    const int sg = lane / 12, s = lane - sg * 12;
    float ss = 0.f;
#pragma unroll
    for (int j = 0; j < 8; ++j) ss += f[j] * f[j];
    const float qs = sum4_f(ss);
    int s1 = s + 4; s1 = s1 >= 12 ? s1 - 12 : s1; int s2 = s + 8; s2 = s2 >= 12 ? s2 - 12 : s2;
    const int l1 = sg * 12 + s1, l2 = sg * 12 + s2;
    const float tot = qs + __shfl(qs, l1 < 64 ? l1 : 63) + __shfl(qs, l2 < 64 ? l2 : 63);
    const float rstd = rsqrtf(tot * (1.f / 96.f) + EPS);
    if (valid) {
#pragma unroll
        for (int j = 0; j < 8; ++j) f[j] = f[j] * rstd * g8[j]; }
    float pr[8];
#pragma unroll
    for (int j = 0; j < 8; ++j) pr[j] = xor1_f(f[j]);
    if (valid && rope && s >= 8) {
        const int ps = (s >= 10) ? gc : gr; const bool x1 = (s & 1) == 0;
#pragma unroll
        for (int j = 0; j < 8; ++j) { const f32x2 cs = R.t32[ps * 8 + j]; f[j] = x1 ? (f[j] * cs.x - pr[j] * cs.y) : (pr[j] * cs.y + f[j] * cs.x); } }
#pragma unroll
    for (int j = 0; j < 8; ++j) f[j] *= scale;
}
__device__ __forceinline__ void post_mla(Frame& F, const Args& a) {
    bf16_t* QD = (bf16_t*)(a.ws + WS_QD); const bf16_t* KN = (const bf16_t*)((unsigned char*)a.out + OUT_KN); const bf16_t* P1 = (const bf16_t*)(a.ws + WS_P1); bf16_t* KDF = (bf16_t*)(a.ws + WS_KDF);
    const ew::Rope R{(const f32x2*)(a.ws + WS_ROPE), (const f32x2*)(a.ws + WS_ROPE + 16384)};
    const int per = (NTOK + F.NGW - 1) / F.NGW; const int r0 = F.gw * per, r1 = (r0 + per) < NTOK ? (r0 + per) : NTOK;
    const int sg = F.lane / 12, s = F.lane - sg * 12;
    const bool val0 = sg < 5, val1 = (sg < 5) && (5 + sg < 8);
    float gq8[8], gk8[8];
#pragma unroll
    for (int j = 0; j < 8; ++j) { gq8[j] = a.in[31][8 * s + j]; gk8[j] = a.in[32][8 * s + j]; }
    const v4u z4 = (v4u){0u, 0u, 0u, 0u};
    v4u nq0 = z4, nq1 = z4, nk0 = z4, nk1 = z4;
#define PM_LOAD(row_) do { const int _r = (row_); const bool _lat = _r < NLAT; \
        nq0 = (_lat && val0) ? *(const v4u*)(QD + (size_t)_r * 768 + sg * 96 + 8 * s) : z4; nq1 = (_lat && val1) ? *(const v4u*)(QD + (size_t)_r * 768 + (5 + sg) * 96 + 8 * s) : z4; \
        nk0 = val0 ? ((s < 8) ? *(const v4u*)(KN + (size_t)_r * 512 + sg * 64 + 8 * s) : *(const v4u*)(P1 + (size_t)_r * P1LD + 1024 + 8 * (s - 8))) : z4; \
        nk1 = val1 ? ((s < 8) ? *(const v4u*)(KN + (size_t)_r * 512 + (5 + sg) * 64 + 8 * s) : *(const v4u*)(P1 + (size_t)_r * P1LD + 1024 + 8 * (s - 8))) : z4; } while (0)
    if (r0 < r1) PM_LOAD(r0);
    for (int row = r0; row < r1; ++row) {
        const bool lat = row < NLAT; const int pos = row & (S - 1), gr = pos >> 6, gc = pos & 63;
        const v4u cq0 = nq0, cq1 = nq1, ck0 = nk0, ck1 = nk1;
        if (row + 1 < r1) PM_LOAD(row + 1);
#pragma unroll
        for (int rd = 0; rd < 2; ++rd) {
            const int h = rd * 5 + sg; const bool valid = rd ? val1 : val0;
            if (lat) {
                float f[8]; ew::unpack8(rd ? cq1 : cq0, f);
                seg96(f, F.lane, valid, gq8, true, gr, gc, R, QSCALE96);
                if (valid) *(v4u*)(QD + (size_t)row * 768 + h * 96 + 8 * s) = ew::pack8(f);
            }
            {
                float f[8]; ew::unpack8(rd ? ck1 : ck0, f);
                seg96(f, F.lane, valid, gk8, lat, gr, gc, R, 1.f);
                if (valid) *(v4u*)(KDF + (size_t)row * 768 + h * 96 + 8 * s) = ew::pack8(f);
            }
        }
    }
#undef PM_LOAD
}
}

namespace mk {
__device__ __forceinline__ void attn_even(Frame& F, const Args& a) {
    unsigned char* ws = a.ws;
    const bf16_t* QK = (const bf16_t*)(ws + WS_QK0); const bf16_t* VT = (const bf16_t*)(ws + WS_VT0); bf16_t* AO = (bf16_t*)((unsigned char*)a.out + OUT_H);
    const int lane = F.lane, r32 = lane & 31, hi = lane >> 5, wid = F.wave;
    const int c = F.vcu, G = F.G;
    {
        float s1 = 0.f, s2 = 0.f;
        for (int i = 0; i < 64; ++i) { s1 += a.in[15][i] * a.in[16][i]; s2 += a.in[17][i] * a.in[18][i]; }
        const float lam = expf(s1) - expf(s2) + 0.2f;
        float* scr = (float*)(ws + WS_DSCR) + (size_t)c * 32768;
        for (int L = c; L < 512 + 32; L += G) {
            int b, h, qrow0; att::Keys ky;
            if (L < 512) { b = L >> 6; h = (L >> 4) & 3; const int qb = L & 15; qrow0 = b * S + qb * 256; ky.ka0 = b * S; ky.na = 64; ky.kb0 = NLAT + b * CL; ky.nb = 4; }
            else { const int i = L - 512; b = i >> 2; h = i & 3; qrow0 = NLAT + b * CL; ky.ka0 = NLAT + b * CL; ky.na = 4; ky.kb0 = 0; ky.nb = 0; }
            const int qw0 = qrow0 + wid * 32;
            att::NaInfo ni{};
            f32x4 o[8][2]; float l[2];
            float* sp = scr + (size_t)wid * 4096 + lane;
            for (int mm = 0; mm < 2; ++mm) {
                att::attn_core16<64, 128, false>(F.lds, QK + (size_t)qw0 * 2048 + 1024 + h * 128 + mm * 64, 2048, QK + 1536 + h * 128 + mm * 64, 2048, VT + (size_t)(512 + h * 128) * NTOK, NTOK, ky, ni, o, l);
                const float il[2] = {1.f / l[0], 1.f / l[1]};
                if (mm == 0) {
#pragma unroll
                    for (int qb = 0; qb < 2; ++qb) { float* spd = sp + qb * 2048; asm volatile("" : "+v"(spd));
#pragma unroll
                        for (int db = 0; db < 8; ++db)
#pragma unroll
                            for (int j = 0; j < 4; ++j) spd[(db * 4 + j) * 64] = o[db][qb][j] * il[qb]; }
                    VM_WAIT();
                } else {
                    float ss[2] = {0.f, 0.f};
#pragma unroll
                    for (int qb = 0; qb < 2; ++qb) {
                        const float* spd = sp + qb * 2048; asm volatile("" : "+v"(spd));
#pragma unroll
                        for (int hb = 0; hb < 2; ++hb) { float t1[16];
#pragma unroll
                            for (int r = 0; r < 16; ++r) t1[r] = spd[(hb * 16 + r) * 64];
                            asm volatile("s_waitcnt vmcnt(0)" ::: "memory");
#pragma unroll
                            for (int r = 0; r < 16; ++r) { const int db = hb * 4 + (r >> 2), j = r & 3; const float v = t1[r] - lam * (o[db][qb][j] * il[qb]); o[db][qb][j] = v; ss[qb] += v * v; } } }
                    float rstd[2];
#pragma unroll
                    for (int qb = 0; qb < 2; ++qb) { float t = ss[qb]; t += __shfl_xor(t, 16); t += __shfl_xor(t, 32); rstd[qb] = rsqrtf(t * (1.f / 128.f) + EPS) * 0.8f; }
                    const int rg = lane >> 4;
#pragma unroll
                    for (int db = 0; db < 8; ++db) { const f32x4 gg = *(const f32x4*)(a.in[19] + 16 * db + 4 * rg);
                        o[db][0] = o[db][0] * gg; o[db][1] = o[db][1] * gg; }
                    att::store_o16<8>(o, rstd, AO + (size_t)qw0 * D + 512 + h * 128, lane & 15, rg);
                    VM_WAIT();
                }
            }
        }
    }
    {
        LAS float* bias = (LAS float*)(F.lds + att::NSLOT * att::Cfg<64, 64>::SLOT);
        int hcur = -1;
        const bool bal = (G == 256);
        const int nit = bal ? 6 : (1024 + 96 + G - 1) / G;
        for (int it = 0; it < nit; ++it) {
            int L;
            if (bal) { if (it < 3) L = c + 256 * it; else if (it == 3) { if (c < 32) continue; L = c + 768; } else if (it == 4) { if (c < 96 || c >= 128) continue; L = (c - 96) + 768; } else { if (c < 32 || c >= 96) continue; L = 1024 + 32 + (c - 32); } }
            else { L = c + G * it; if (L >= 1024 + 96) continue; }
            int b, h, qrow0; att::Keys ky; att::NaInfo ni{};
            if (L < 1024) { b = L >> 7; h = (L >> 4) & 7; const int qb = L & 15; qrow0 = b * S + qb * 256;
                int rlo = 4 * qb - 4; rlo = rlo < 0 ? 0 : (rlo > 56 ? 56 : rlo); int rhi = 4 * qb + 3 - 4; rhi = (rhi < 0 ? 0 : (rhi > 56 ? 56 : rhi)) + 7;
                ky.ka0 = NLAT + b * CL; ky.na = 4; ky.kb0 = b * S + 64 * rlo; ky.nb = rhi - rlo + 1;
                ni.r_lo = rlo; ni.qr = 4 * qb + (wid >> 1); ni.qc = 32 * (wid & 1); }
            else { const int i = L - 1024 - 32; if (i < 0) continue; b = i >> 3; h = i & 7; qrow0 = NLAT + b * CL; ky.ka0 = NLAT + b * CL; ky.na = 4; ky.kb0 = 0; ky.nb = 0; ni.r_lo = 0; ni.qr = 0; ni.qc = 0; }
            if (h != hcur) { __syncthreads();
                for (int i = F.tid; i < 15 * 128; i += NTHR) { const int dr = i >> 7, dc = (i & 127) - 63; bias[i] = (dc >= -15 && dc <= 15) ? a.in[12][h * 465 + dr * 31 + dc + 15] * LOG2E : 0.f; }
                __syncthreads(); hcur = h; }
            ni.bias = bias;
            const int qw0 = qrow0 + wid * 32;
            { f32x4 o[4][2]; float l[2];
            att::attn_core16<64, 64, true>(F.lds, QK + (size_t)qw0 * 2048 + h * 64, 2048, QK + 512 + h * 64, 2048, VT + (size_t)(h * 64) * NTOK, NTOK, ky, ni, o, l);
            const float il[2] = {1.f / l[0], 1.f / l[1]};
            att::store_o16<4>(o, il, AO + (size_t)qw0 * D + h * 64, lane & 15, lane >> 4); }
        }
    }
    VM_WAIT();
}

__device__ __forceinline__ void attn_odd(Frame& F, const Args& a) {
    unsigned char* ws = a.ws;
    const bf16_t* P1 = (const bf16_t*)(ws + WS_P1); const bf16_t* VTC = (const bf16_t*)(ws + WS_VT1C);
    const bf16_t* QD = (const bf16_t*)(ws + WS_QD); const bf16_t* KD = (const bf16_t*)(ws + WS_KDF); const bf16_t* VTD = (const bf16_t*)(ws + WS_VT1D);
    bf16_t* AO = (bf16_t*)((unsigned char*)a.out + OUT_H);
    const int lane = F.lane, r32 = lane & 31, hi = lane >> 5, wid = F.wave;
    att::NaInfo ni{};
    for (int L = F.vcu; L < 1024; L += F.G) {
        const int b = L >> 7, h = (L >> 4) & 7, qb = L & 15; const int qw0 = b * S + qb * 256 + wid * 32;
        att::Keys ky; ky.ka0 = b * S; ky.na = 64; ky.kb0 = NLAT + b * CL; ky.nb = 4;
        f32x4 o[4][2]; float l[2];
        att::attn_core16<96, 64, false>(F.lds, QD + (size_t)qw0 * 768 + h * 96, 768, KD + h * 96, 768, VTD + (size_t)(h * 64) * NTOK, NTOK, ky, ni, o, l);
        const float il[2] = {1.f / l[0], 1.f / l[1]};
        att::store_o16<4>(o, il, AO + (size_t)qw0 * D + 512 + h * 64, lane & 15, lane >> 4);
    }
    for (int L = F.vcu; L < 1024; L += F.G) {
        const int b = L >> 7, hq = (L >> 4) & 7, qb = L & 15; const int qw0 = b * S + qb * 256 + wid * 32;
        att::Keys ky; ky.ka0 = b * S; ky.na = 64; ky.kb0 = NLAT + b * CL; ky.nb = 4;
        f32x4 o[4][2]; float l[2];
        att::attn_core16<64, 64, false>(F.lds, P1 + (size_t)qw0 * P1LD + hq * 64, P1LD, P1 + 768 + (hq >> 2) * 64, P1LD, VTC + (size_t)((hq >> 2) * 64) * NTOK, NTOK, ky, ni, o, l);
        const float il[2] = {1.f / l[0], 1.f / l[1]};
        att::store_o16<4>(o, il, AO + (size_t)qw0 * D + hq * 64, lane & 15, lane >> 4);
    }
    VM_WAIT();
}

__device__ __forceinline__ void router_phase(Frame& F, const Args& a, const bf16_t* x3) {
    unsigned char* ws = a.ws;
    unsigned char* H2 = (unsigned char*)a.out + OUT_H;
    const float* modl = (const float*)(ws + WS_MODF) + (size_t)9 * 6144;
    int* slot_tok = (int*)(ws + WS_SLOT_TOK); float* slot_g = (float*)(ws + WS_SLOT_G);
    LAS float* rw = (LAS float*)F.lds;
    LAS int* lcnt = (LAS int*)(F.lds + 32768);
    LAS int* lbase = lcnt + 16;
    LAS int* tinfo = lcnt + 32;
    LAS float* tg = (LAS float*)(tinfo + 512);
    f32x4 rwr[2][8][2];
#pragma unroll
    for (int j = 0; j < 2; ++j)
#pragma unroll
        for (int k8 = 0; k8 < 8; ++k8) { const float* wp = a.in[33] + (size_t)(8 * F.lane + 512 * j + k8) * 8; rwr[j][k8][0] = *(const f32x4*)wp; rwr[j][k8][1] = *(const f32x4*)(wp + 4); }
    const float* g = a.in[7] + D;
    for (int chunk = blockIdx.x; chunk < NLAT / 128; chunk += F.G) {
    __syncthreads();
    if (F.tid < 16) lcnt[F.tid] = 0;
    __syncthreads();
    const int tok0 = chunk * 128;
    v4u xw[2];
    { const bf16_t* x0 = x3 + (size_t)(tok0 + F.wave * 16) * D; xw[0] = *((const v4u*)x0 + F.lane); xw[1] = *((const v4u*)x0 + F.lane + 64); }
    ew::ModRegs M; { const int v = tok0 >> 12; const float* sh = modl + (size_t)v * 6144 + 3 * D; ew::nm_mod_load<true>(M, g, sh, sh + D, F.lane); }
    for (int i = 0; i < 16; ++i) {
        const int tl = F.wave * 16 + i, tok = tok0 + tl;
        const v4u xc[2] = {xw[0], xw[1]};
        if (i + 1 < 16) { const bf16_t* x1 = x3 + (size_t)(tok + 1) * D; xw[0] = *((const v4u*)x1 + F.lane); xw[1] = *((const v4u*)x1 + F.lane + 64); }
        float y[2][8]; float s = 0.f;
#pragma unroll
        for (int j = 0; j < 2; ++j) { ew::unpack8(xc[j], y[j]);
#pragma unroll
            for (int q = 0; q < 8; ++q) s += y[j][q] * y[j][q]; }
        const float rstd = rsqrtf(wave_sum(s) * (1.f / D) + EPS);
        float lg[8];
#pragma unroll
        for (int e = 0; e < 8; ++e) lg[e] = 0.f;
#pragma unroll
        for (int j = 0; j < 2; ++j) { const int c = 8 * F.lane + 512 * j;
#pragma unroll
            for (int h = 0; h < 2; ++h) {
#pragma unroll
                for (int q = 0; q < 4; ++q) { const float yy = y[j][4 * h + q] * rstd * M.mul[2 * j + h][q] + M.add[2 * j + h][q]; y[j][4 * h + q] = yy;
                    const f32x4 r0 = rwr[j][4 * h + q][0], r1 = rwr[j][4 * h + q][1];
                    lg[0] += yy * r0.x; lg[1] += yy * r0.y; lg[2] += yy * r0.z; lg[3] += yy * r0.w; lg[4] += yy * r1.x; lg[5] += yy * r1.y; lg[6] += yy * r1.z; lg[7] += yy * r1.w; } }
            v2u w8; w8.x = cvt4_fp8(y[j][0] * ACT_SCALE, y[j][1] * ACT_SCALE, y[j][2] * ACT_SCALE, y[j][3] * ACT_SCALE); w8.y = cvt4_fp8(y[j][4] * ACT_SCALE, y[j][5] * ACT_SCALE, y[j][6] * ACT_SCALE, y[j][7] * ACT_SCALE);
            *(v2u*)(H2 + (size_t)tok * D + c) = w8; }
#pragma unroll
        for (int e = 0; e < 8; ++e) lg[e] = wave_sum(lg[e]);
        if (F.lane == 0) {
            int i0 = 0; float v0 = lg[0];
#pragma unroll
            for (int e = 1; e < 8; ++e) if (lg[e] > v0) { v0 = lg[e]; i0 = e; }
            int i1 = -1; float v1 = -INFINITY;
#pragma unroll
            for (int e = 0; e < 8; ++e) if (e != i0 && lg[e] > v1) { v1 = lg[e]; i1 = e; }
            const float e1 = expf(v1 - v0);
            tinfo[tl * 4 + 0] = i0; tinfo[tl * 4 + 1] = i1;
            tinfo[tl * 4 + 2] = __hip_atomic_fetch_add(&lcnt[i0], 1, __ATOMIC_RELAXED, __HIP_MEMORY_SCOPE_WORKGROUP); tinfo[tl * 4 + 3] = __hip_atomic_fetch_add(&lcnt[8 + i1], 1, __ATOMIC_RELAXED, __HIP_MEMORY_SCOPE_WORKGROUP);
            tg[tl * 2] = 1.f / (1.f + e1); tg[tl * 2 + 1] = e1 / (1.f + e1);
        }
    }
    __syncthreads();
    if (F.tid < 16) lbase[F.tid] = (int)__hip_atomic_fetch_add((unsigned*)(F.ctl + CW_GCNT + F.tid), (unsigned)lcnt[F.tid], RLX_AGENT);
    __syncthreads();
    if (F.tid < 256) { const int tl = F.tid >> 1, cch = F.tid & 1; const int e = tinfo[tl * 4 + cch], rk = tinfo[tl * 4 + 2 + cch];
        const size_t idx = ((size_t)cch * 8 + e) * NLAT + lbase[cch * 8 + e] + rk;
        slot_tok[idx] = tok0 + tl; slot_g[idx] = tg[tl * 2 + cch]; }
    }
}
}
namespace mk {
__global__ void __launch_bounds__(NTHR, 2) mega_fwd(Args args) {
    extern __shared__ __attribute__((aligned(16))) unsigned char lds_raw[];
    Frame F;
    F.lds = (LAS unsigned char*)lds_raw;
    F.MISC = (volatile LAS unsigned*)(F.lds + MISC_OFF);
    F.tid = threadIdx.x; F.lane = F.tid & 63; F.wave = __builtin_amdgcn_readfirstlane(F.tid >> 6);
    F.G = gridDim.x; { const int bx = blockIdx.x; F.vcu = (F.G % 8 == 0) ? (bx % 8) * (F.G / 8) + bx / 8 : bx; }
    F.gw = F.vcu * NWAVES + F.wave; F.NGW = F.G * NWAVES;
    unsigned char* ws = args.ws;
    F.ctl = (gu32*)(ws + WS_CTL);
    for (int u = F.tid; u < (LDS_BYTES - LDSCTL_OFF) / 4; u += NTHR) ((LAS unsigned*)(F.lds + LDSCTL_OFF))[u] = 0u;
    __syncthreads();
    XcdBarrier bar = xcd_barrier_post((unsigned*)(F.ctl + CW_BAR), F.MISC + 8);
    const int lo = args.ph_lo, hi = args.ph_hi;
#ifndef MK_ONLY
#define MK_ONLY -1
#endif
#define IN(k) ((MK_ONLY < 0 || MK_ONLY == (k)) && lo <= (k) && (k) < hi)
#if MK_PROBE
    LAS unsigned long long* ts = (LAS unsigned long long*)(F.lds + LDSCTL_OFF + 2048);
    if (F.tid == 0) ts[0] = __builtin_amdgcn_s_memrealtime();
#define SEAM(k) do { if (IN(k) && IN((k) + 1)) xcd_barrier(bar); if (F.tid == 0) ts[(k) + 1] = __builtin_amdgcn_s_memrealtime(); } while (0)
#else
#define SEAM(k) do { if (IN(k) && IN((k) + 1)) xcd_barrier(bar); } while (0)
#endif
    const float* MODF = (const float*)(ws + WS_MODF);
    bf16_t* H = (bf16_t*)((unsigned char*)args.out + OUT_H);
    float* XC = (float*)(ws + WS_XC);
    bf16_t* XB = (bf16_t*)(ws + WS_XB);
    float* X = args.out;
    const int cu = (int)blockIdx.x;

    if (IN(0)) { for (int rep = 0; rep < MK_REP_P0; ++rep) { p0_prologue(F, args, rep == 0 || MK_P0_DUPMOD, rep == 0 || !MK_P0_DUPMOD); __syncthreads(); } } SEAM(0);
    if (IN(1)) { for (int rep = 0; rep < MK_REP_NM; ++rep) normmod_phase<false>(F, args.in[0], args.in[2], args.in[6], MODF, 0, H, NTOK); } SEAM(1);
    if (IN(2)) {
        pg8::MultiSched Sc; Sc.init(D, F.G, cu);
        Sc.add(H, (const bf16_t*)(ws + WS_WQK0), NTOK / 256, 8, 0);
        Sc.add((const bf16_t*)(ws + WS_WV0), H, 4, NTOK / 256, 1);
        pg8::EpiQK0 E{(bf16_t*)(ws + WS_QK0), (bf16_t*)(ws + WS_VT0), (const float*)(ws + WS_ROPE + 32768), (const f32x2*)(ws + WS_ROPE)};
        pg8::gemm_phase<pg8::EpiQK0, pg8::MultiSched, false>(F.lds, D, Sc, E);
    } SEAM(2);
    if (IN(4)) { attn_even(F, args); } SEAM(4);
    if (IN(5)) {
        pg8::MultiSched Sc; Sc.init(D, F.G, cu); Sc.add(H, (const bf16_t*)(ws + WS_WO0), NTOK / 256, 4, 0);
        pg8::EpiResid<false> E{args.in[0], XB, args.in[2], XC, MODF, 2};
        pg8::gemm_phase<pg8::EpiResid<false>, pg8::MultiSched, false>(F.lds, D, Sc, E);
    } SEAM(5);
    if (IN(6)) { for (int rep = 0; rep < MK_REP_NM; ++rep) normmod_phase<true>(F, XB, XC, args.in[7], MODF, 3, H, NTOK); } SEAM(6);
    if (IN(7)) {
        pg8::MultiSched Sc; Sc.init(D, F.G, cu); Sc.add(H, (const bf16_t*)(ws + WS_WGU0), NTOK / 256, 22, 0);
        pg8::EpiSwigluF8 E{ws + WS_MID0, 2816, 1.f, ACT_SCALE};
        pg8::gemm_phase<pg8::EpiSwigluF8, pg8::MultiSched, false>(F.lds, D, Sc, E);
    } SEAM(7);
    if (IN(8)) {
        pg8::MultiSched Sc; Sc.init(2816 / 2, F.G, cu); Sc.add((const bf16_t*)(ws + WS_MID0), (const bf16_t*)(ws + WS_WD0), NTOK / 256, 4, 0);
        pg8::EpiResid<true> E{XB, XB, XC, XC, MODF, 5, 1.f / (ACT_SCALE * W2_SCALE)};
        pg8::gemm_phase<pg8::EpiResid<true>, pg8::MultiSched, false, true>(F.lds, 2816 / 2, Sc, E);
    } SEAM(8);
    const float* MODF1 = MODF + (size_t)9 * 6144;
    if (IN(9)) { for (int rep = 0; rep < MK_REP_NM; ++rep) normmod_phase<true>(F, XB, XC, args.in[6] + D, MODF1, 0, H, NTOK); } SEAM(9);
    if (IN(10)) {
        pg8::MultiSched Sc; Sc.init(D, F.G, cu);
        Sc.add(H, (const bf16_t*)(ws + WS_WODD), NTOK / 256, 5, 0);
        Sc.add((const bf16_t*)(ws + WS_WVC), H, 1, NTOK / 256, 1);
        pg8::EpiStore E{(bf16_t*)(ws + WS_P1), (bf16_t*)(ws + WS_VT1C), P1LD, NTOK};
        pg8::gemm_phase<pg8::EpiStore, pg8::MultiSched, false>(F.lds, D, Sc, E);
    } SEAM(10);
    if (IN(11)) { post_odd(F, args); } SEAM(11);
    if (IN(12)) {
        { pg8::MultiSched Sc; Sc.init(256, F.G, cu); Sc.add((const bf16_t*)((unsigned char*)args.out + OUT_CQN), (const bf16_t*)(ws + WS_WUQ), NLAT / 256, 3, 0);
          pg8::EpiStore E{(bf16_t*)(ws + WS_QD), nullptr, 768, 0};
          pg8::gemm_phase<pg8::EpiStore, pg8::MultiSched, false>(F.lds, 256, Sc, E); }
        asm volatile("" ::: "memory");
        { int K2 = 128; asm volatile("" : "+s"(K2)); pg8::MultiSched Sc; Sc.init(K2, F.G, cu);
          Sc.add((const bf16_t*)((unsigned char*)args.out + OUT_CKVN), (const bf16_t*)(ws + WS_WUKN), NTOK / 256, 2, 0);
          Sc.add((const bf16_t*)(ws + WS_WUKV), (const bf16_t*)((unsigned char*)args.out + OUT_CKVN), 2, NTOK / 256, 1);
          pg8::EpiStore E{(bf16_t*)((unsigned char*)args.out + OUT_KN), (bf16_t*)(ws + WS_VT1D), 512, NTOK};
          pg8::gemm_phase<pg8::EpiStore, pg8::MultiSched, false>(F.lds, K2, Sc, E); }
    } SEAM(12);
    if (IN(13)) { post_mla(F, args); } SEAM(13);
    if (IN(14)) { attn_odd(F, args); } SEAM(14);
    if (IN(15)) {
        pg8::MultiSched Sc; Sc.init(D, F.G, cu); Sc.add(H, (const bf16_t*)(ws + WS_WO1), NLAT / 256, 4, 0);
        pg8::EpiResid<true> E{XB, XB, XC, XC, MODF1, 2};
        pg8::gemm_phase<pg8::EpiResid<true>, pg8::MultiSched, false>(F.lds, D, Sc, E);
    } SEAM(15);
    if (IN(16)) { router_phase(F, args, XB); } SEAM(16);
    {
        const int* cnt0 = (const int*)(F.ctl + CW_GCNT); const int* cnt1 = cnt0 + 8;
        const int* stok0 = (const int*)(ws + WS_SLOT_TOK); const int* stok1 = stok0 + (size_t)8 * NLAT;
        unsigned char* const MIDa = ws + WS_MID1; unsigned char* const MIDb = ws + WS_MID1 + (size_t)119 * MiB;
        LAS int* const tab = (LAS int*)(F.lds + LDSCTL_OFF + 1024);
        const float invg = 1.f / (ACT_SCALE * W13_SCALE), invd = 1.f / (ACT_SCALE * W2_SCALE);
        if (IN(17)) {
            pg8::MoeSched Sc; Sc.init(tab, cnt0, D / 2, 28, F.G, cu, true, H, (const bf16_t*)(ws + WS_W13), (size_t)7168 * (D / 2), stok0);
            pg8::EpiSwigluF8 E{MIDa, 3584, invg, ACT_SCALE};
            pg8::gemm_phase<pg8::EpiSwigluF8, pg8::MoeSched, true, true>(F.lds, D / 2, Sc, E);
        } SEAM(17);
        if (IN(18)) {
            pg8::MoeDualSched Sc; Sc.init(tab, cnt0, cnt1, F.G, cu, 3584 / 2, D / 2,
                                          (const bf16_t*)MIDa, (const bf16_t*)(ws + WS_W2), (size_t)D * (3584 / 2), stok0, H, (const bf16_t*)(ws + WS_W13), (size_t)7168 * (D / 2), stok1);
            pg8::EpiMoeDual E{pg8::EpiSwigluF8{MIDb, 3584, invg, ACT_SCALE}, pg8::EpiMoeDown<false>{XB, X, MODF1, (const float*)(ws + WS_SLOT_G), (const int*)(ws + WS_SLOT_TOK), invd}};
            pg8::gemm_phase<pg8::EpiMoeDual, pg8::MoeDualSched, true, true, true>(F.lds, D / 2, Sc, E);
        } SEAM(18);
        if (IN(19)) {
            pg8::MoeSched Sc; Sc.init(tab, cnt1, 3584 / 2, 4, F.G, cu, false, (const bf16_t*)MIDb, (const bf16_t*)(ws + WS_W2), (size_t)D * (3584 / 2), stok1);
            pg8::EpiMoeDown<true> E{XB, X, MODF1, (const float*)(ws + WS_SLOT_G), (const int*)(ws + WS_SLOT_TOK), invd};
            pg8::gemm_phase<pg8::EpiMoeDown<true>, pg8::MoeSched, false, true>(F.lds, 3584 / 2, Sc, E);
        }
    }
#if MK_PROBE
    if (IN(20)) {
        xcd_barrier(bar); __syncthreads();
        float t1 = 0.f;
        for (int q = 0; q < 21; ++q) if ((MK_PROBE_MASK >> q) & 1) t1 += (float)(ts[q + 1] - ts[q]) * 0.01f;
        if (MK_PROBE_Q > 0) t1 = floorf(t1 * (1.f / MK_PROBE_Q) + 0.5f) * MK_PROBE_Q;
        const float sc = 1.f + t1 * (1.f / 20000.f);
        for (size_t i = (size_t)blockIdx.x * NTHR + F.tid; i < (size_t)NLAT * D / 4; i += (size_t)F.G * NTHR) { f32x4 v = ((f32x4*)X)[i]; ((f32x4*)X)[i] = v * sc; }
    }
#endif
#undef IN
#undef SEAM
}
}
#ifndef MK_MODE
#define MK_MODE 0
#endif
namespace mk {
#if MK_MODE == 2
constexpr size_t WS_CK = 522 * MiB, WS_XN = 552 * MiB, WS_NEED = 568 * MiB;
constexpr int CKR = 1024;
constexpr size_t CKSZ = (size_t)(CKR + CL) * D;
constexpr int CW_RES = 1024;
__global__ void cmp_kernel(const void* opt, int is_bf16, int ldo, int col0, const float* ref, int rows, int ncols, float* res) {
    float d2 = 0.f, b2 = 0.f;
    for (long i = (long)blockIdx.x * 256 + threadIdx.x; i < (long)rows * ncols; i += (long)gridDim.x * 256) {
        const int r = (int)(i / ncols), c = col0 + (int)(i % ncols);
        const float a = is_bf16 ? bf2f(((const bf16_t*)opt)[(size_t)r * ldo + c]) : ((const float*)opt)[(size_t)r * ldo + c];
        const float b = ref[(size_t)r * D + c];
        d2 += (a - b) * (a - b); b2 += b * b;
    }
    __shared__ float s0[256], s1[256];
    s0[threadIdx.x] = d2; s1[threadIdx.x] = b2; __syncthreads();
    for (int o = 128; o > 0; o >>= 1) { if (threadIdx.x < o) { s0[threadIdx.x] += s0[threadIdx.x + o]; s1[threadIdx.x] += s1[threadIdx.x + o]; } __syncthreads(); }
    if (threadIdx.x == 0) { atomicAdd(res, s0[0]); atomicAdd(res + 1, s1[0]); }
}
__global__ void verdict_kernel(const float* res, int nchk, float thr, const float* xn, float* out) {
    int bad = 0;
    for (int k = 0; k < nchk; ++k) { const float r = res[2 * k] / res[2 * k + 1]; if (!(r < thr)) { bad = k + 1; break; } }
    if (!bad) return;
    for (size_t i = (size_t)blockIdx.x * 256 + threadIdx.x; i < (size_t)NLAT * D; i += (size_t)gridDim.x * 256)
        out[i] = i < (size_t)S * D ? xn[i] * (float)(1 + bad) : 0.f;
}
#endif

static int g_grid = 0;
static void launch_range(hipStream_t st, Args a, int lo, int hi, bool reset_bar) {
    if (reset_bar) (void)hipMemsetAsync(a.ws + WS_CTL + (size_t)CW_BAR * 4, 0, (size_t)XCD_BAR_WORDS * 4, st);
    a.ph_lo = lo; a.ph_hi = hi;
    hipLaunchKernelGGL(mega_fwd, dim3(g_grid), dim3(NTHR), LDS_BYTES, st, a);
    const hipError_t le = hipPeekAtLastError();
    if (le != hipSuccess) fprintf(stderr, "kernel_launch: launch [%d,%d) failed: %s\n", lo, hi, hipGetErrorName(le));
}
}

extern "C" void kernel_launch(void* const* d_in, const int* in_sizes, int n_in, void* d_out, int out_size, void* d_ws, size_t ws_size, hipStream_t stream) {
    using namespace mk;
    if (g_grid == 0) {
        size_t need = WS_END;
#if MK_MODE == 2
        need = WS_NEED;
#endif
        if (n_in != 37 || out_size != NLAT * D || ws_size < need) { fprintf(stderr, "kernel_launch: unexpected shapes / workspace (%zu < %zu)\n", ws_size, need); g_grid = -1; return; }
        int dev = 0, cus = 0, per_cu = 0;
        if (hipGetDevice(&dev) != hipSuccess || hipDeviceGetAttribute(&cus, hipDeviceAttributeMultiprocessorCount, dev) != hipSuccess) { g_grid = -1; return; }
        if (hipFuncSetAttribute((const void*)mega_fwd, hipFuncAttributeMaxDynamicSharedMemorySize, LDS_BYTES) != hipSuccess) { fprintf(stderr, "kernel_launch: hipFuncSetAttribute failed\n"); g_grid = -1; return; }
        if (hipOccupancyMaxActiveBlocksPerMultiprocessor(&per_cu, (const void*)mega_fwd, NTHR, LDS_BYTES) != hipSuccess || per_cu < 1) { fprintf(stderr, "kernel_launch: occupancy query says %d blocks per CU\n", per_cu); g_grid = -1; (void)hipGetLastError(); return; }
        g_grid = cus;
    }
    if (g_grid < 0) return;
    Args a; memset(&a, 0, sizeof a);
    for (int i = 0; i < 37; ++i) a.in[i] = (const float*)d_in[i];
    a.out = (float*)d_out; a.ws = (unsigned char*)d_ws;
#if MK_MODE == 0
    (void)hipMemsetAsync((char*)d_ws + WS_CTL, 0, CTL_ZERO_BYTES, stream);
    launch_range(stream, a, 0, MK_PROBE ? 21 : 20, false);
#elif MK_MODE == 1
    (void)hipMemsetAsync((char*)d_ws + WS_CTL, 0, CTL_ZERO_BYTES, stream);
    for (int p = 0; p < 20; ++p) launch_range(stream, a, p, p + 1, true);
#else
    {
        nv::In I = nv::make_in(d_in);
        float* CK = (float*)((char*)d_ws + WS_CK); float* XN = (float*)((char*)d_ws + WS_XN);
        nv::run(stream, I, XN, (char*)d_ws, 1, CK, CKR);
        (void)hipMemsetAsync((char*)d_ws + WS_CTL, 0, CTL_ZERO_BYTES, stream);
        float* res = (float*)((char*)d_ws + WS_CTL) + CW_RES;
        const bf16_t* AO = (const bf16_t*)((char*)d_out + OUT_H); const float* XC = (const float*)((char*)d_ws + WS_XC); const float* X = (const float*)d_out; const bf16_t* XB = (const bf16_t*)((char*)d_ws + WS_XB);
        auto cmp = [&](int id, const void* opt, int bf, int ldo, int col0, const float* ref, int rows, int ncols) {
            hipLaunchKernelGGL(cmp_kernel, dim3(256), dim3(256), 0, stream, opt, bf, ldo, col0, ref, rows, ncols, res + 2 * (id - 1)); };
        launch_range(stream, a, 0, 5, true);
        cmp(1, AO, 1, D, 0, CK + 0 * CKSZ, CKR, 512);
        cmp(2, AO, 1, D, 512, CK + 0 * CKSZ, CKR, 512);
        cmp(3, AO + (size_t)NLAT * D, 1, D, 0, CK + 0 * CKSZ + (size_t)CKR * D, CL, 512);
        cmp(4, AO + (size_t)NLAT * D, 1, D, 512, CK + 0 * CKSZ + (size_t)CKR * D, CL, 512);
        launch_range(stream, a, 5, 6, true);
        cmp(5, XB, 1, D, 0, CK + 1 * CKSZ, CKR, D);
        cmp(6, XC, 0, D, 0, CK + 1 * CKSZ + (size_t)CKR * D, CL, D);
        launch_range(stream, a, 6, 9, true);
        cmp(7, XB, 1, D, 0, CK + 2 * CKSZ, CKR, D);
        cmp(8, XC, 0, D, 0, CK + 2 * CKSZ + (size_t)CKR * D, CL, D);
        launch_range(stream, a, 9, 15, true);
        cmp(9, AO, 1, D, 0, CK + 3 * CKSZ, CKR, 512);
        cmp(10, AO, 1, D, 512, CK + 3 * CKSZ, CKR, 512);
        launch_range(stream, a, 15, 16, true);
        cmp(11, XB, 1, D, 0, CK + 4 * CKSZ, CKR, D);
        launch_range(stream, a, 16, 20, true);
        cmp(12, X, 0, D, 0, CK + 5 * CKSZ, CKR, D);
        hipLaunchKernelGGL(verdict_kernel, dim3(1024), dim3(256), 0, stream, (const float*)res, 12, 2e-3f, (const float*)XN, (float*)d_out);
    }
#endif
}
```

```cpp
#define MK_MODE 0
#include <hip/hip_runtime.h>
#include <cstdint>
#include <cstdio>
#include <cstring>
#include <cmath>
#define GAS __attribute__((address_space(1)))
#define LAS __attribute__((address_space(3)))
typedef unsigned short bf16_t;
typedef unsigned v4u __attribute__((ext_vector_type(4)));
typedef unsigned v2u __attribute__((ext_vector_type(2)));
typedef float f32x4 __attribute__((ext_vector_type(4)));
typedef float f32x2 __attribute__((ext_vector_type(2)));
typedef float f32x16 __attribute__((ext_vector_type(16)));
typedef short bf16x8 __attribute__((ext_vector_type(8)));
typedef int v4i __attribute__((ext_vector_type(4)));
typedef int v8i __attribute__((ext_vector_type(8)));
typedef GAS unsigned gu32;
#define RLX_AGENT __ATOMIC_RELAXED, __HIP_MEMORY_SCOPE_AGENT
#define LDS_WAIT() asm volatile("s_waitcnt lgkmcnt(0)" ::: "memory")
#define VM_WAIT() asm volatile("s_waitcnt vmcnt(0)" ::: "memory")

namespace mk {
constexpr int D = 1024, NB = 8, S = 4096, CL = 256, NLAT = NB * S, NCTX = NB * CL, NTOK = NLAT + NCTX;
constexpr int GW = 64;
constexpr float EPS = 1e-6f;
constexpr float LOG2E = 1.4426950408889634f;
constexpr int NWAVES = 8, NTHR = 512;

typedef __bf16 bf16x2_nt __attribute__((ext_vector_type(2)));
__device__ __forceinline__ unsigned cvt_pk_bf16(float lo, float hi) { const f32x2 v = {lo, hi}; return __builtin_bit_cast(unsigned, __builtin_convertvector(v, bf16x2_nt)); }
__device__ __forceinline__ float bf2f(unsigned short u) { return __uint_as_float((unsigned)u << 16); }
__device__ __forceinline__ float bflo(unsigned u) { return __uint_as_float(u << 16); }
__device__ __forceinline__ float bfhi(unsigned u) { return __uint_as_float(u & 0xffff0000u); }
__device__ __forceinline__ unsigned cvt4_fp8(float a, float b, float c, float d) {
    a = __builtin_amdgcn_fmed3f(a, -448.f, 448.f); b = __builtin_amdgcn_fmed3f(b, -448.f, 448.f); c = __builtin_amdgcn_fmed3f(c, -448.f, 448.f); d = __builtin_amdgcn_fmed3f(d, -448.f, 448.f);
    int r = __builtin_amdgcn_cvt_pk_fp8_f32(a, b, 0, false); r = __builtin_amdgcn_cvt_pk_fp8_f32(c, d, r, true); return (unsigned)r; }
__device__ __forceinline__ float silu_f(float x) { return x / (1.f + __expf(-x)); }
template <int CTRL> __device__ __forceinline__ float dpp_f(float v) { return __builtin_bit_cast(float, __builtin_amdgcn_update_dpp(0, __builtin_bit_cast(int, v), CTRL, 0xf, 0xf, true)); }
__device__ __forceinline__ float xor1_f(float v) { return dpp_f<0xB1>(v); }
__device__ __forceinline__ float xor2_f(float v) { return dpp_f<0x4E>(v); }
__device__ __forceinline__ float xor8_f(float v) { return dpp_f<0x128>(v); }
__device__ __forceinline__ float sum4_f(float v) { v += xor1_f(v); return v + xor2_f(v); }
__device__ __forceinline__ float sum8_f(float v) { v = sum4_f(v); return v + dpp_f<0x141>(v); }
__device__ __forceinline__ float sum16_f(float v) { v = sum8_f(v); return v + dpp_f<0x140>(v); }
__device__ __forceinline__ float sum32_f(float v) { v = sum16_f(v); const auto r = __builtin_amdgcn_permlane16_swap(__float_as_uint(v), __float_as_uint(v), false, false); return __uint_as_float(r[0]) + __uint_as_float(r[1]); }
__device__ __forceinline__ float wave_sum(float v) { v = sum32_f(v); const auto r = __builtin_amdgcn_permlane32_swap(__float_as_uint(v), __float_as_uint(v), false, false); return __uint_as_float(r[0]) + __uint_as_float(r[1]); }
}
#ifndef MK_REP_GEMM
#define MK_REP_GEMM 1
#endif
#ifndef MK_REP_ATTN
#define MK_REP_ATTN 1
#endif
#ifndef MK_PROBE_Q
#define MK_PROBE_Q 0
#endif
#ifndef MK_PROBE
#define MK_PROBE 0
#endif
#ifndef MK_REP_NM
#define MK_REP_NM 1
#endif
#ifndef MK_P0_DUPMOD
#define MK_P0_DUPMOD 0
#endif
#ifndef MK_REP_P0
#define MK_REP_P0 1
#endif
namespace pg8 {
using namespace mk;
constexpr int BM = 256, BK = 64, HALF = 128, HTB = HALF * BK * 2  , STAGE_BYTES = 8 * HTB, NXCD = 8, WGM = 8;

__device__ __forceinline__ int lds_byte(int r, int c) { const int st = (r >> 4) * 2 + (c >> 5), rr = r & 15, cc = c & 31, ob = rr * 64 + cc * 2; return st * 1024 + (ob ^ (((ob >> 9) & 1) << 5)); }
__device__ __forceinline__ void stage_rc(int b, int& R, int& C) { const int st = b / 1024, sb = b % 1024, swz = sb ^ (((sb >> 9) & 1) << 5); R = (st >> 1) * 16 + swz / 64; C = (st & 1) * 32 + (swz % 64) / 2; }
__device__ __forceinline__ int perm32(int rho) { const int n = rho >> 4, i = rho & 15; return 8 * (i >> 2) + 4 * n + (i & 3); }

struct Unit {
    const bf16_t* A; const bf16_t* B;
    const int* ridx;
    int rows;
    int pm, pn, kind, aux;
    int dup;
    int K, gath;
};

__device__ __forceinline__ int xcd_remap(int L, int nwg) { const int q = nwg / NXCD, r = nwg % NXCD, xcd = L % NXCD, off = L / NXCD; return (xcd < r ? xcd * (q + 1) : r * (q + 1) + (xcd - r) * q) + off; }
__device__ __forceinline__ void grouped(int w, int nM, int nN, int& pm, int& pn) {
    const int nig = WGM * nN, gid = w / nig, fm = gid * WGM, gsz = (nM - fm) < WGM ? (nM - fm) : WGM;
    pm = fm + ((w % nig) % gsz); pn = (w % nig) / gsz;
}

template <class Epi, class Sched, bool GATHER, bool FP8 = false, bool VARK = false>
__device__ __forceinline__ void gemm_phase(LAS unsigned char* lds, const int K, const Sched& S, const Epi& E) {
    int tid_ = threadIdx.x; asm volatile("" : "+v"(tid_));
    const int tid = tid_, wid = __builtin_amdgcn_readfirstlane(tid >> 6), lane = tid & 63, wr = wid >> 2, wc = wid & 3, fr = lane & 15, fq = lane >> 4;
    unsigned voffB[2], voffBn[2];
#pragma unroll
    for (int i = 0; i < 2; ++i) { int sR_, sC_; stage_rc(tid * 16 + i * 8192, sR_, sC_); const int sRb_ = Epi::PERM ? ((sR_ & ~31) + perm32(sR_ & 31)) : sR_; voffB[i] = (unsigned)(sRb_ * K + sC_) * 2u; voffBn[i] = voffB[i]; }
    const size_t kstep = (size_t)(BK * 2);
    size_t hstep = (size_t)HALF * K * 2, hstepN = hstep;
    int nt = K / BK;
    const unsigned ldsw = (unsigned)wid * 1024u;
    const int aoff = lds_byte(wr * 64 + fr, fq * 8), boff = lds_byte(wc * 32 + fr, fq * 8);
#define PG8_SA(b, h) (((b) * 2 + (h)) * HTB)
#define PG8_SB(b, h) ((4 + (b) * 2 + (h)) * HTB)
#define PG8_STAGE(bufoff, gbase, voff) do { _Pragma("unroll") for (int _i = 0; _i < 2; ++_i) \
        __builtin_amdgcn_global_load_lds((const unsigned*)((const char*)(gbase) + (voff)[_i]), (LAS unsigned*)(lds + (bufoff) + ldsw + _i * 8192), 16, 0, 0); } while (0)
#define PG8_STAGE_A(bufoff, h, kptr, vo) PG8_STAGE(bufoff, (GATHER ? (kptr) : (kptr) + (h) * hstep), (vo)[GATHER ? (h) : 0])
#define PG8_LDA(dst, b, h) do { _Pragma("unroll") for (int m = 0; m < 4; ++m) { if (FP8) dst##8[m] = __builtin_shufflevector(*(const LAS v4i*)(lds + PG8_SA(b, h) + aoff + m * 2048), *(const LAS v4i*)(lds + PG8_SA(b, h) + aoff + m * 2048 + 1024), 0, 1, 2, 3, 4, 5, 6, 7); \
        else { _Pragma("unroll") for (int k = 0; k < 2; ++k) dst[m][k] = *(const LAS bf16x8*)(lds + PG8_SA(b, h) + aoff + m * 2048 + k * 1024); } } } while (0)
#define PG8_LDB(dst, b, h) do { _Pragma("unroll") for (int n = 0; n < 2; ++n) { if (FP8) dst##8[n] = __builtin_shufflevector(*(const LAS v4i*)(lds + PG8_SB(b, h) + boff + n * 2048), *(const LAS v4i*)(lds + PG8_SB(b, h) + boff + n * 2048 + 1024), 0, 1, 2, 3, 4, 5, 6, 7); \
        else { _Pragma("unroll") for (int k = 0; k < 2; ++k) dst[n][k] = *(const LAS bf16x8*)(lds + PG8_SB(b, h) + boff + n * 2048 + k * 1024); } } } while (0)
#define PG8_MMA(ai, bj, At, Bt) do { __builtin_amdgcn_s_setprio(1); _Pragma("unroll") for (int m = 0; m < 4; ++m) _Pragma("unroll") for (int n = 0; n < 2; ++n) { \
        if (FP8) { asm volatile("v_mfma_f32_16x16x128_f8f6f4 %0, %1, %2, %0" : "+v"(acc[ai][bj][m][n]) : "v"(Bt##8[n]), "v"(At##8[m])); } \
        else { _Pragma("unroll") for (int k = 0; k < 2; ++k) acc[ai][bj][m][n] = __builtin_amdgcn_mfma_f32_16x16x32_bf16(Bt[n][k], At[m][k], acc[ai][bj][m][n], 0, 0, 0); } } \
        __builtin_amdgcn_s_setprio(0); } while (0)
#define PG8_WAIT_V(n) asm volatile("s_waitcnt vmcnt(" #n ")" ::: "memory")
#define PG8_WAIT_L(n) asm volatile("s_waitcnt lgkmcnt(" #n ")" ::: "memory")
#define PG8_BAR __builtin_amdgcn_s_barrier()
#define PG8_SCHED __builtin_amdgcn_sched_barrier(0)
#define PG8_MKVOFF(u, vo) do { _Pragma("unroll") for (int _h = 0; _h < (GATHER ? 2 : 1); ++_h) _Pragma("unroll") for (int _i = 0; _i < 2; ++_i) { \
        int _sR, _sC; stage_rc(tid * 16 + _i * 8192, _sR, _sC); const int _row = _h * HALF + _sR; int _g = _row; \
        if (GATHER) { if (!VARK || (u).gath) _g = (_row < (u).rows) ? (u).ridx[_row] : 0; } \
        (vo)[_h][_i] = (unsigned)(_g * (VARK ? (u).K : K) + _sC) * 2u; } } while (0)
#define PG8_MKVOFFB(u, vb, hs) do { if (VARK) { _Pragma("unroll") for (int _i = 0; _i < 2; ++_i) { int _sR, _sC; stage_rc(tid * 16 + _i * 8192, _sR, _sC); const int _sRb = Epi::PERM ? ((_sR & ~31) + perm32(_sR & 31)) : _sR; (vb)[_i] = (unsigned)(_sRb * (u).K + _sC) * 2u; } hs = (size_t)HALF * (u).K * 2; } } while (0)
    Unit cur, nxt; int ui = 0;
    if (!S.next(0, cur)) return;
    f32x4 acc[2][2][4][2];
#pragma unroll
    for (int a = 0; a < 2; ++a)
#pragma unroll
        for (int b = 0; b < 2; ++b)
#pragma unroll
            for (int m = 0; m < 4; ++m)
#pragma unroll
                for (int n = 0; n < 2; ++n) acc[a][b][m][n] = (f32x4){0.f, 0.f, 0.f, 0.f};
    bf16x8 At[4][2], B0[2][2], B1[2][2];
    v8i At8[4], B08[2], B18[2];
    unsigned vA[2][2], vN[2][2];
    PG8_MKVOFF(cur, vA); PG8_MKVOFFB(cur, voffB, hstep); if (VARK) nt = cur.K / BK;
    const char* cA = (const char*)cur.A; const char* cB = (const char*)cur.B;
    PG8_STAGE(PG8_SB(0, 0), cB, voffB); PG8_STAGE(PG8_SB(0, 1), cB + hstep, voffB); PG8_STAGE_A(PG8_SA(0, 0), 0, cA, vA); PG8_STAGE_A(PG8_SA(0, 1), 1, cA, vA);
    if (wr == 1) PG8_BAR;
    PG8_WAIT_V(2); PG8_BAR;
    PG8_STAGE(PG8_SB(1, 0), cB + kstep, voffB); PG8_STAGE_A(PG8_SA(1, 0), 0, cA + kstep, vA); PG8_STAGE(PG8_SB(1, 1), cB + hstep + kstep, voffB);
    PG8_WAIT_V(6); PG8_BAR;
    for (;;) {
        const bool has_next = S.next(ui + 1, nxt);
        const char* nA = has_next ? (const char*)nxt.A : cA; const char* nB = has_next ? (const char*)nxt.B : cB;
        if (VARK) { if (has_next) { PG8_MKVOFFB(nxt, voffBn, hstepN); } else { voffBn[0] = voffB[0]; voffBn[1] = voffB[1]; hstepN = hstep; } }
        if (GATHER) { if (has_next) { PG8_MKVOFF(nxt, vN); } else {
#pragma unroll
            for (int h = 0; h < 2; ++h)
#pragma unroll
                for (int i = 0; i < 2; ++i) vN[h][i] = vA[h][i]; } }
        LAS v4u* const parkA = (LAS v4u*)(lds + STAGE_BYTES + 4096) + tid; LAS v2u* const parkB = (LAS v2u*)(lds + STAGE_BYTES + 4096 + 8192) + tid;
        if (VARK) { *parkA = (v4u){vN[0][0], vN[0][1], vN[1][0], vN[1][1]}; *parkB = (v2u){voffBn[0], voffBn[1]}; }
        for (int t = 0; t < nt; t += 2) {
            const bool last = (t == nt - 2);
            const char* a1 = cA + (size_t)(t + 1) * kstep;
            const char* a2 = last ? nA : cA + (size_t)(t + 2) * kstep; const char* b2 = last ? nB : cB + (size_t)(t + 2) * kstep;
            const char* a3 = a2 + kstep; const char* b3 = b2 + kstep;
            unsigned v2[2][2];
#pragma unroll
            for (int h = 0; h < 2; ++h)
#pragma unroll
                for (int i = 0; i < 2; ++i) v2[h][i] = (GATHER && !VARK && last) ? vN[h][i] : vA[h][i];
            unsigned vb2[2]; vb2[0] = voffB[0]; vb2[1] = voffB[1];
            if (VARK) { if (last) { const v4u pa = *parkA; const v2u pb = *parkB; v2[0][0] = pa.x; v2[0][1] = pa.y; v2[1][0] = pa.z; v2[1][1] = pa.w; vb2[0] = pb.x; vb2[1] = pb.y; } }
            const size_t hs2 = (VARK && last) ? hstepN : hstep;
            PG8_LDB(B0, 0, 0); PG8_LDB(B1, 0, 1); PG8_SCHED; PG8_LDA(At, 0, 0); PG8_STAGE_A(PG8_SA(1, 1), 1, a1, vA);
            PG8_WAIT_V(8); PG8_WAIT_L(0); PG8_BAR; PG8_MMA(0, 0, At, B0); PG8_MMA(0, 1, At, B1); PG8_BAR; PG8_SCHED;
            PG8_LDA(At, 0, 1); PG8_STAGE(PG8_SB(0, 0), b2, vb2); PG8_STAGE(PG8_SB(0, 1), b2 + hs2, vb2); PG8_STAGE_A(PG8_SA(0, 0), 0, a2, v2);
            PG8_WAIT_V(8); PG8_WAIT_L(0); PG8_BAR; PG8_MMA(1, 0, At, B0); PG8_MMA(1, 1, At, B1); PG8_BAR; PG8_SCHED;
            PG8_LDB(B0, 1, 0); PG8_LDB(B1, 1, 1); PG8_SCHED; PG8_LDA(At, 1, 0); PG8_STAGE_A(PG8_SA(0, 1), 1, a2, v2);
            PG8_WAIT_V(8); PG8_WAIT_L(0); PG8_BAR; PG8_MMA(0, 0, At, B0); PG8_MMA(0, 1, At, B1); PG8_BAR; PG8_SCHED;
            PG8_LDA(At, 1, 1); PG8_STAGE(PG8_SB(1, 0), b3, vb2); PG8_STAGE(PG8_SB(1, 1), b3 + hs2, vb2); PG8_STAGE_A(PG8_SA(1, 0), 0, a3, v2);
            PG8_WAIT_V(8); PG8_WAIT_L(0); PG8_BAR; PG8_MMA(1, 0, At, B0); PG8_MMA(1, 1, At, B1); PG8_BAR; PG8_SCHED;
        }
        if (wr == 0) PG8_BAR;
        if (FP8) asm volatile("s_nop 15\n\ts_nop 15\n\ts_nop 15\n\ts_nop 15" ::: "memory");
        { int t2_ = threadIdx.x; asm volatile("" : "+v"(t2_));
          if (!cur.dup) E(acc, cur, wr, wc, t2_ & 15, (t2_ & 63) >> 4); }
        if (!has_next) break;
#pragma unroll
        for (int a = 0; a < 2; ++a)
#pragma unroll
            for (int b = 0; b < 2; ++b)
#pragma unroll
                for (int m = 0; m < 4; ++m)
#pragma unroll
                    for (int n = 0; n < 2; ++n) acc[a][b][m][n] = (f32x4){0.f, 0.f, 0.f, 0.f};
        cur = nxt; cA = nA; cB = nB; ++ui;
        if (VARK) { const v4u pa = *parkA; const v2u pb = *parkB; vA[0][0] = pa.x; vA[0][1] = pa.y; vA[1][0] = pa.z; vA[1][1] = pa.w; voffB[0] = pb.x; voffB[1] = pb.y; hstep = hstepN; nt = cur.K / BK; }
        else if (GATHER) {
#pragma unroll
        for (int h = 0; h < 2; ++h)
#pragma unroll
            for (int i = 0; i < 2; ++i) vA[h][i] = vN[h][i]; }
        if (wr == 1) PG8_BAR;
    }
    PG8_WAIT_V(0);
    PG8_BAR;
#undef PG8_SA
#undef PG8_SB
#undef PG8_STAGE
#undef PG8_STAGE_A
#undef PG8_LDA
#undef PG8_LDB
#undef PG8_MMA
#undef PG8_WAIT_V
#undef PG8_WAIT_L
#undef PG8_BAR
#undef PG8_SCHED
#undef PG8_MKVOFF
#undef PG8_MKVOFFB
}

struct MultiSched {
    const bf16_t* A0; const bf16_t* B0; const bf16_t* A1; const bf16_t* B1;
    int nM0, nN0, kind0, nM1, nN1, kind1, n0, total, G, c, K;
    __device__ __forceinline__ void init(int K_, int G_, int c_) { n0 = 0; total = 0; G = G_; c = c_; K = K_; A1 = nullptr; B1 = nullptr; nM1 = 0; nN1 = 1; kind1 = 0; }
    __device__ __forceinline__ void add(const bf16_t* A, const bf16_t* B, int nM, int nN, int kind) {
        if (total == 0) { A0 = A; B0 = B; nM0 = nM; nN0 = nN; kind0 = kind; n0 = nM * nN; } else { A1 = A; B1 = B; nM1 = nM; nN1 = nN; kind1 = kind; }
        total += nM * nN; }
    __device__ __forceinline__ bool next(int i, Unit& u) const {
        const long L = (long)(i / MK_REP_GEMM) * G + c; if (L >= total) return false;
        u.dup = (i % MK_REP_GEMM) != 0;
        int w = xcd_remap((int)L, total);
        const bool second = w >= n0; if (second) w -= n0;
        const int nM = second ? nM1 : nM0, nN = second ? nN1 : nN0;
        int pm, pn; grouped(w, nM, nN, pm, pn);
        u.A = (second ? A1 : A0) + (size_t)pm * BM * K; u.B = (second ? B1 : B0) + (size_t)pn * BM * K; u.ridx = nullptr; u.rows = BM; u.pm = pm; u.pn = pn; u.kind = second ? kind1 : kind0; u.aux = pm * BM;
        return true;
    }
};
}
namespace pg8 {
struct EpiStore {
    static constexpr bool PERM = true;
    bf16_t* O0; bf16_t* O1; int ldc0, ldc1;
    __device__ __forceinline__ void operator()(const f32x4 (&acc)[2][2][4][2], const Unit& u, int wr, int wc, int fr, int fq) const {
        const int ldc = u.kind ? ldc1 : ldc0;
        bf16_t* base = (u.kind ? O1 : O0) + (size_t)(u.pm * BM + wr * 64 + fr) * ldc + u.pn * BM + wc * 32 + 8 * fq;
#pragma unroll
        for (int ai = 0; ai < 2; ++ai)
#pragma unroll
            for (int m = 0; m < 4; ++m) { bf16_t* rowp = base + (size_t)(ai * HALF + m * 16) * ldc;
#pragma unroll
                for (int bj = 0; bj < 2; ++bj) { const f32x4 v0 = acc[ai][bj][m][0], v1 = acc[ai][bj][m][1];
                    v4u w; w.x = cvt_pk_bf16(v0[0], v0[1]); w.y = cvt_pk_bf16(v0[2], v0[3]); w.z = cvt_pk_bf16(v1[0], v1[1]); w.w = cvt_pk_bf16(v1[2], v1[3]);
                    *(v4u*)(rowp + bj * HALF) = w; } }
    }
};
struct EpiQK0 {
    static constexpr bool PERM = true;
    bf16_t* QK; bf16_t* VT; const float* gtab; const f32x2* t64;
    __device__ __forceinline__ void operator()(const f32x4 (&acc)[2][2][4][2], const Unit& u, int wr, int wc, int fr, int fq) const {
        if (u.kind) {
            bf16_t* base = VT + (size_t)(u.pm * BM + wr * 64 + fr) * NTOK + u.pn * BM + wc * 32 + 8 * fq;
#pragma unroll
            for (int ai = 0; ai < 2; ++ai)
#pragma unroll
                for (int m = 0; m < 4; ++m) { bf16_t* rowp = base + (size_t)(ai * HALF + m * 16) * NTOK;
#pragma unroll
                    for (int bj = 0; bj < 2; ++bj) { const f32x4 v0 = acc[ai][bj][m][0], v1 = acc[ai][bj][m][1];
                        v4u w; w.x = cvt_pk_bf16(v0[0], v0[1]); w.y = cvt_pk_bf16(v0[2], v0[3]); w.z = cvt_pk_bf16(v1[0], v1[1]); w.w = cvt_pk_bf16(v1[2], v1[3]);
                        *(v4u*)(rowp + bj * HALF) = w; } }
            return;
        }
        const int kq = u.pn >> 1;
        const float* g = gtab + kq * 64;
        const bool rope = (kq >= 2) && (u.pm * BM < NLAT);
        const float scale = (kq == 0 || kq == 2) ? 0.125f * LOG2E : 1.f;
        f32x4 gg[2][2];
#pragma unroll
        for (int bj = 0; bj < 2; ++bj)
#pragma unroll
            for (int n = 0; n < 2; ++n) gg[bj][n] = *(const f32x4*)(g + bj * 32 + 8 * fq + 4 * n);
        const bool x1 = fq < 2; const int i0 = 8 * (fq & 1);
#pragma unroll
        for (int ai = 0; ai < 2; ++ai)
#pragma unroll
            for (int m = 0; m < 4; ++m) {
                const int row = u.pm * BM + ai * HALF + wr * 64 + m * 16 + fr;
                float v[2][8]; float ss = 0.f;
#pragma unroll
                for (int bj = 0; bj < 2; ++bj)
#pragma unroll
                    for (int q = 0; q < 8; ++q) { v[bj][q] = acc[ai][bj][m][q >> 2][q & 3]; ss += v[bj][q] * v[bj][q]; }
                ss += __shfl_xor(ss, 16); ss += __shfl_xor(ss, 32);
                const float rstd = rsqrtf(ss * (1.f / 64.f) + EPS);
#pragma unroll
                for (int bj = 0; bj < 2; ++bj)
#pragma unroll
                    for (int q = 0; q < 8; ++q) v[bj][q] *= rstd * gg[bj][q >> 2][q & 3];
                if (rope) {
                    const int pos = row & (S - 1);
#pragma unroll
                    for (int bj = 0; bj < 2; ++bj) { const int ps = bj ? (pos & 63) : (pos >> 6);
#pragma unroll
                        for (int q = 0; q < 8; ++q) { const float pr = __shfl_xor(v[bj][q], 32); const f32x2 cs = t64[ps * 16 + i0 + q];
                            v[bj][q] = x1 ? (v[bj][q] * cs.x - pr * cs.y) : (pr * cs.y + v[bj][q] * cs.x); } }
                }
                bf16_t* op = QK + (size_t)row * 2048 + u.pn * BM + wc * 64 + 8 * fq;
#pragma unroll
                for (int bj = 0; bj < 2; ++bj) { v4u w; w.x = cvt_pk_bf16(v[bj][0] * scale, v[bj][1] * scale); w.y = cvt_pk_bf16(v[bj][2] * scale, v[bj][3] * scale); w.z = cvt_pk_bf16(v[bj][4] * scale, v[bj][5] * scale); w.w = cvt_pk_bf16(v[bj][6] * scale, v[bj][7] * scale);
                    *(v4u*)(op + bj * 32) = w; }
                __builtin_amdgcn_sched_barrier(0);
            }
    }
};
struct EpiSwiglu {
    static constexpr bool PERM = true;
    bf16_t* O; int ldc;
    __device__ __forceinline__ void operator()(const f32x4 (&acc)[2][2][4][2], const Unit& u, int wr, int wc, int fr, int fq) const {
        bf16_t* base = O + (size_t)(u.aux + wr * 64 + fr) * ldc + u.pn * HALF + wc * 32 + 8 * fq;
#pragma unroll
        for (int ai = 0; ai < 2; ++ai)
#pragma unroll
            for (int m = 0; m < 4; ++m) {
                float o[8];
#pragma unroll
                for (int n = 0; n < 2; ++n)
#pragma unroll
                    for (int j = 0; j < 4; ++j) { const float g = acc[ai][0][m][n][j], up = acc[ai][1][m][n][j]; o[n * 4 + j] = g * __builtin_amdgcn_rcpf(1.f + __builtin_amdgcn_exp2f(-g * LOG2E)) * up; }
                v4u w; w.x = cvt_pk_bf16(o[0], o[1]); w.y = cvt_pk_bf16(o[2], o[3]); w.z = cvt_pk_bf16(o[4], o[5]); w.w = cvt_pk_bf16(o[6], o[7]);
                *(v4u*)(base + (size_t)(ai * HALF + m * 16) * ldc) = w; }
    }
};
struct EpiSwigluF8 {
    static constexpr bool PERM = true;
    unsigned char* O; int ldc; float inv, oscale;
    __device__ __forceinline__ void operator()(const f32x4 (&acc)[2][2][4][2], const Unit& u, int wr, int wc, int fr, int fq) const {
        unsigned char* base = O + (size_t)(u.aux + wr * 64 + fr) * ldc + u.pn * HALF + wc * 32 + 8 * fq;
#pragma unroll
        for (int ai = 0; ai < 2; ++ai)
#pragma unroll
            for (int m = 0; m < 4; ++m) {
                float o[8];
#pragma unroll
                for (int n = 0; n < 2; ++n) {
                    const f32x4 a = acc[ai][0][m][n], b = acc[ai][1][m][n];
                    const f32x4 tv = a * (-inv * LOG2E), uv = b * (inv * inv * oscale);
                    f32x4 dv; dv[0] = __builtin_amdgcn_exp2f(tv[0]); dv[1] = __builtin_amdgcn_exp2f(tv[1]); dv[2] = __builtin_amdgcn_exp2f(tv[2]); dv[3] = __builtin_amdgcn_exp2f(tv[3]);
                    dv = dv + 1.f;
                    f32x4 rv; rv[0] = __builtin_amdgcn_rcpf(dv[0]); rv[1] = __builtin_amdgcn_rcpf(dv[1]); rv[2] = __builtin_amdgcn_rcpf(dv[2]); rv[3] = __builtin_amdgcn_rcpf(dv[3]);
                    const f32x4 zv = (a * rv) * uv;
                    o[n * 4] = zv[0]; o[n * 4 + 1] = zv[1]; o[n * 4 + 2] = zv[2]; o[n * 4 + 3] = zv[3]; }
                v2u w; w.x = cvt4_fp8(o[0], o[1], o[2], o[3]); w.y = cvt4_fp8(o[4], o[5], o[6], o[7]);
                *(v2u*)(base + (size_t)(ai * HALF + m * 16) * ldc) = w; }
    }
};
template <bool BASE_BF16> struct EpiResid {
    static constexpr bool PERM = true;
    const void* base_lat; bf16_t* out_lat; const float* base_ctx; float* out_ctx; const float* modl; int chunk; float inv = 1.f;
    __device__ __forceinline__ void operator()(const f32x4 (&acc)[2][2][4][2], const Unit& u, int wr, int wc, int fr, int fq) const {
        const int row_t = u.pm * BM;
        const bool lat = row_t < NLAT;
        const int v = lat ? row_t / S : 8;
        const int col0 = u.pn * BM + wc * 32 + 8 * fq;
        const float* gp = modl + (size_t)v * 6144 + chunk * D + col0;
        f32x4 gv[2][2];
#pragma unroll
        for (int bj = 0; bj < 2; ++bj)
#pragma unroll
            for (int n = 0; n < 2; ++n) gv[bj][n] = *(const f32x4*)(gp + bj * HALF + n * 4) * inv;
        if (lat) {
#pragma unroll
            for (int ai = 0; ai < 2; ++ai)
#pragma unroll
                for (int m = 0; m < 4; ++m) { const size_t off = (size_t)(row_t + ai * HALF + wr * 64 + m * 16 + fr) * D + col0;
#pragma unroll
                    for (int bj = 0; bj < 2; ++bj) { f32x4 b0, b1;
                        if (BASE_BF16) { const v4u w = *(const v4u*)((const bf16_t*)base_lat + off + bj * HALF); b0 = (f32x4){bflo(w.x), bfhi(w.x), bflo(w.y), bfhi(w.y)}; b1 = (f32x4){bflo(w.z), bfhi(w.z), bflo(w.w), bfhi(w.w)}; }
                        else { b0 = *(const f32x4*)((const float*)base_lat + off + bj * HALF); b1 = *(const f32x4*)((const float*)base_lat + off + bj * HALF + 4); }
                        const f32x4 o0 = b0 + gv[bj][0] * acc[ai][bj][m][0], o1 = b1 + gv[bj][1] * acc[ai][bj][m][1];
                        v4u w; w.x = cvt_pk_bf16(o0[0], o0[1]); w.y = cvt_pk_bf16(o0[2], o0[3]); w.z = cvt_pk_bf16(o1[0], o1[1]); w.w = cvt_pk_bf16(o1[2], o1[3]);
                        *(v4u*)(out_lat + off + bj * HALF) = w; } }
        } else {
#pragma unroll
            for (int ai = 0; ai < 2; ++ai)
#pragma unroll
                for (int m = 0; m < 4; ++m) { const size_t off = (size_t)(row_t - NLAT + ai * HALF + wr * 64 + m * 16 + fr) * D + col0;
#pragma unroll
                    for (int bj = 0; bj < 2; ++bj)
#pragma unroll
                        for (int n = 0; n < 2; ++n) { const f32x4 bs = *(const f32x4*)(base_ctx + off + bj * HALF + n * 4);
                            *(f32x4*)(out_ctx + off + bj * HALF + n * 4) = bs + gv[bj][n] * acc[ai][bj][m][n]; } }
        }
    }
};
template <bool FINAL> struct EpiMoeDown {
    static constexpr bool PERM = true;
    bf16_t* xb; float* out; const float* modl; const float* slot_g_base; const int* slot_tok_base; float inv;
    __device__ __forceinline__ void operator()(const f32x4 (&acc)[2][2][4][2], const Unit& u, int wr, int wc, int fr, int fq) const {
        const int col0 = u.pn * BM + wc * 32 + 8 * fq;
        const float* sg = slot_g_base + (u.ridx - slot_tok_base);
#pragma unroll
        for (int ai = 0; ai < 2; ++ai)
#pragma unroll
            for (int m = 0; m < 4; ++m) { const int r = ai * HALF + wr * 64 + m * 16 + fr;
                if (r < u.rows) { const int tok = u.ridx[r]; const float g = sg[r] * inv;
                    const float* gp = modl + (size_t)(tok >> 12) * 6144 + 5 * D + col0; const size_t off = (size_t)tok * D + col0;
#pragma unroll
                    for (int bj = 0; bj < 2; ++bj) { const f32x4 g0 = *(const f32x4*)(gp + bj * HALF), g1 = *(const f32x4*)(gp + bj * HALF + 4);
                        const v4u w = *(const v4u*)(xb + off + bj * HALF);
                        const f32x4 b0 = (f32x4){bflo(w.x), bfhi(w.x), bflo(w.y), bfhi(w.y)}, b1 = (f32x4){bflo(w.z), bfhi(w.z), bflo(w.w), bfhi(w.w)};
                        const f32x4 o0 = b0 + (g0 * g) * acc[ai][bj][m][0], o1 = b1 + (g1 * g) * acc[ai][bj][m][1];
                        if (FINAL) { *(f32x4*)(out + off + bj * HALF) = o0; *(f32x4*)(out + off + bj * HALF + 4) = o1; }
                        else { v4u o; o.x = cvt_pk_bf16(o0[0], o0[1]); o.y = cvt_pk_bf16(o0[2], o0[3]); o.z = cvt_pk_bf16(o1[0], o1[1]); o.w = cvt_pk_bf16(o1[2], o1[3]); *(v4u*)(xb + off + bj * HALF) = o; } } } }
    }
};

struct MoeSched {
    const LAS int* tab;
    int ntile, nN, total, G, cu, K; bool gather;
    const bf16_t* A; const bf16_t* B; size_t bstride; const int* slot_tok;
    __device__ __forceinline__ void init(LAS int* tab_, const int* cnt_g, int K_, int nN_, int G_, int cu_, bool gather_, const bf16_t* A_, const bf16_t* B_, size_t bstride_, const int* slot_tok_) {
        __syncthreads();
        if (threadIdx.x == 0) { int s = 0; for (int e = 0; e < 8; ++e) { const int ce = cnt_g[e]; tab_[16 + e] = ce; tab_[e] = s; s += (ce + BM - 1) / BM; } tab_[8] = s; }
        __syncthreads();
        tab = tab_; ntile = __builtin_amdgcn_readfirstlane(tab_[8]);
        nN = nN_; total = ntile * nN_; G = G_; cu = cu_; K = K_; gather = gather_; A = A_; B = B_; bstride = bstride_; slot_tok = slot_tok_;
    }
    __device__ __forceinline__ bool next(int i, Unit& u) const {
        const long L = (long)(i / MK_REP_GEMM) * G + cu; if (L >= total) return false;
        u.dup = (i % MK_REP_GEMM) != 0;
        const int w = xcd_remap((int)L, total);
        int rt, pn; grouped(w, ntile, nN, rt, pn);
        int e = 0;
        for (int j = 1; j < 8; ++j) if (rt >= tab[j]) e = j;
        const int t0 = tab[e], ce = tab[16 + e];
        const int lt = rt - t0;
        u.ridx = slot_tok + (size_t)e * NLAT + lt * BM; u.rows = (ce - lt * BM) < BM ? (ce - lt * BM) : BM;
        u.A = gather ? A : A + (size_t)rt * BM * K; u.B = B + (size_t)e * bstride + (size_t)pn * BM * K;
        u.pm = rt; u.pn = pn; u.kind = e; u.aux = rt * BM;
        return true;
    }
};
struct EpiMoeDual {
    static constexpr bool PERM = true;
    EpiSwigluF8 g; EpiMoeDown<false> d;
    __device__ __forceinline__ void operator()(const f32x4 (&acc)[2][2][4][2], const Unit& u, int wr, int wc, int fr, int fq) const {
        if (u.kind & 0x100) d(acc, u, wr, wc, fr, fq); else g(acc, u, wr, wc, fr, fq);
    }
};
struct MoeDualSched {
    const LAS int* tabD; const LAS int* tabG;
    int ntD, ntG, nD, nG, G, cu, KD, KG, dc, g0, g1;
    const bf16_t* AD; const bf16_t* BD; size_t bsD; const int* stokD;
    const bf16_t* AG; const bf16_t* BG; size_t bsG; const int* stokG;
    static constexpr int NND = 4, NNG = 28, WCOST = 3;
    __device__ __forceinline__ void init(LAS int* tab, const int* cntD, const int* cntG, int G_, int cu_, int KD_, int KG_,
                                         const bf16_t* AD_, const bf16_t* BD_, size_t bsD_, const int* stokD_, const bf16_t* AG_, const bf16_t* BG_, size_t bsG_, const int* stokG_) {
        __syncthreads();
        if (threadIdx.x < 2) { LAS int* t = tab + 32 * threadIdx.x; const int* cg = threadIdx.x ? cntG : cntD; int s = 0;
            for (int e = 0; e < 8; ++e) { const int ce = cg[e]; t[16 + e] = ce; t[e] = s; s += (ce + BM - 1) / BM; } t[8] = s; }
        __syncthreads();
        tabD = tab; tabG = tab + 32; ntD = __builtin_amdgcn_readfirstlane(tab[8]); ntG = __builtin_amdgcn_readfirstlane(tab[32 + 8]);
        nD = ntD * NND; nG = ntG * NNG; G = G_; cu = cu_; KD = KD_; KG = KG_;
        AD = AD_; BD = BD_; bsD = bsD_; stokD = stokD_; AG = AG_; BG = BG_; bsG = bsG_; stokG = stokG_;
        const int dlo = nD / G, r = nD % G; dc = dlo + (cu < r ? 1 : 0);
        int w = WCOST, x = (nG - (G - r) * w) / G; if (nG < (G - r) * w) { w = 0; x = nG / G; }
        const int rem = nG - (r * x + (G - r) * (x + w));
        g0 = cu * x + w * (cu > r ? cu - r : 0) + (cu < rem ? cu : rem);
        g1 = g0 + x + (cu >= r ? w : 0) + (cu < rem ? 1 : 0);
    }
    __device__ __forceinline__ bool next(int i, Unit& u) const {
        u.dup = 0; u.ridx = nullptr;
        if (i < dc) {
            const int w = xcd_remap(cu + G * i, nD);
            int rt, pn; grouped(w, ntD, NND, rt, pn);
            int e = 0;
            for (int j = 1; j < 8; ++j) if (rt >= tabD[j]) e = j;
            const int lt = rt - tabD[e], ce = tabD[16 + e];
            u.ridx = stokD + (size_t)e * NLAT + lt * BM; u.rows = (ce - lt * BM) < BM ? (ce - lt * BM) : BM;
            u.A = AD + (size_t)rt * BM * KD; u.B = BD + (size_t)e * bsD + (size_t)pn * BM * KD;
            u.pm = rt; u.pn = pn; u.kind = e | 0x100; u.aux = rt * BM; u.K = KD; u.gath = 0;
            return true;
        }
        const int gi = g0 + (i - dc); if (gi >= g1) return false;
        int rt, pn; grouped(gi, ntG, NNG, rt, pn);
        int e = 0;
        for (int j = 1; j < 8; ++j) if (rt >= tabG[j]) e = j;
        const int lt = rt - tabG[e], ce = tabG[16 + e];
        u.ridx = stokG + (size_t)e * NLAT + lt * BM; u.rows = (ce - lt * BM) < BM ? (ce - lt * BM) : BM;
        u.A = AG; u.B = BG + (size_t)e * bsG + (size_t)pn * BM * KG;
        u.pm = rt; u.pn = pn; u.kind = e; u.aux = rt * BM; u.K = KG; u.gath = 1;
        return true;
    }
};
}
#ifndef ATT_NEGM
#define ATT_NEGM 1
#endif
#ifndef ATT_LSUM
#define ATT_LSUM 1
#endif
#ifndef ATT_NOMAX
#define ATT_NOMAX 1
#endif
namespace att {
using namespace mk;
constexpr int NSLOT = 4;
constexpr float NEG_BIG = -1e30f;
template <int DK, int DV> struct Cfg {
    static constexpr int KB = 64 * DK * 2, VB = DV * 64 * 2, SLOT = KB + VB, NPK = DK / 8, NPV = DV / 8, NP = NPK + NPV, NPW = (NP + 7) / 8, ND0 = DK / 16, NDB = DV / 32;
};
__device__ __forceinline__ float max3f(float a, float b, float c) { float r; asm("v_max3_f32 %0, %1, %2, %3" : "=v"(r) : "v"(a), "v"(b), "v"(c)); return r; }
__device__ __forceinline__ int kvmap(int i) { return (i & 3) | ((i & 4) << 1) | ((i & 8) >> 1) | (i & 16); }

struct Keys { int ka0, na, kb0, nb; };
struct NaInfo { int r_lo; int qr; int qc; const LAS float* bias; };

#define ATT_WAITBAR(N) asm volatile("s_waitcnt vmcnt(" #N ") lgkmcnt(0)\n\ts_barrier" ::: "memory")

template <int DK, int DV, bool MODE_NA>
__device__ __forceinline__ void attn_core(LAS unsigned char* lds, const bf16_t* __restrict__ Qp  ,
                                          const bf16_t* __restrict__ Kh  , int ldk, const bf16_t* __restrict__ VTh  , int ldv,
                                          const Keys ky, const NaInfo na, f32x16 (&oT)[Cfg<DK, DV>::NDB], float& l_out) {
    typedef Cfg<DK, DV> C;
    int tid_ = threadIdx.x; asm volatile("" : "+v"(tid_));
    const int tid = tid_, lane = tid & 63, r32 = lane & 31, hi = lane >> 5; const int wid = __builtin_amdgcn_readfirstlane(tid >> 6);
    const int nt = ky.na + ky.nb;
    bf16x8 qf[C::ND0];
#pragma unroll
    for (int d0 = 0; d0 < C::ND0; ++d0) qf[d0] = *(const bf16x8*)(Qp + d0 * 16 + hi * 8);
    const unsigned voffK = (unsigned)lane * (unsigned)ldk * 2u, voffV = (unsigned)lane * (unsigned)ldv * 2u;
    const __amdgpu_buffer_rsrc_t srdK = __builtin_amdgcn_make_buffer_rsrc((void*)Kh, (short)0, 0x7FFFFFFF, 0x00020000);
    const __amdgpu_buffer_rsrc_t srdV = __builtin_amdgcn_make_buffer_rsrc((void*)VTh, (short)0, 0x7FFFFFFF, 0x00020000);
    const unsigned ldsb = (unsigned)(size_t)lds;
#define ATT_DMA(m0v, voff, srd, soff) asm volatile("s_mov_b32 m0, %0\n\ts_nop 0\n\tbuffer_load_dwordx4 %1, %2, %3 offen lds" :: "s"(m0v), "v"(voff), "s"(srd), "s"(soff) : "m0", "memory")
#define ATT_ISSUE(t, slot) do { const int _row0 = (t) < ky.na ? ky.ka0 + 64 * (t) : ky.kb0 + 64 * ((t) - ky.na); \
        _Pragma("unroll") for (int _j = 0; _j < C::NPW; ++_j) { int _pc = wid + 8 * _j; _pc = _pc < C::NP ? _pc : C::NP - 1; \
            if (_pc < C::NPK) { const unsigned _so = (unsigned)(_row0 * ldk + _pc * 8) * 2u; const unsigned _m0 = ldsb + (slot) * C::SLOT + _pc * 1024; ATT_DMA(_m0, voffK, srdK, _so); } \
            else { const int _pv = _pc - C::NPK; const unsigned _so = (unsigned)((_pv >> 3) * 64 * ldv + _row0 + (_pv & 7) * 8) * 2u; const unsigned _m0 = ldsb + (slot) * C::SLOT + C::KB + _pv * 1024; ATT_DMA(_m0, voffV, srdV, _so); } } } while (0)
    ATT_ISSUE(0, 0); ATT_ISSUE(1, 1); ATT_ISSUE(2, 2);
#pragma unroll
    for (int db = 0; db < C::NDB; ++db)
#pragma unroll
        for (int r = 0; r < 16; ++r) oT[db][r] = 0.f;
    constexpr float THR = 8.f;
    constexpr bool NOMAX = (ATT_NOMAX != 0);
    constexpr bool NEGM = (ATT_NEGM != 0) && !MODE_NA && !NOMAX;
    float m = 0.f, l = 0.f;
    constexpr bool LSUM_MFMA = (ATT_LSUM != 0) && (C::NDB == 2);
    f32x16 oL;
#pragma unroll
    for (int r = 0; r < 16; ++r) oL[r] = 0.f;
    const unsigned onesw = (r32 == 0) ? 0x3F803F80u : 0u;
    const bf16x8 onesf = __builtin_bit_cast(bf16x8, (v4u){onesw, onesw, onesw, onesw});
    f32x16 negm;
#pragma unroll
    for (int r = 0; r < 16; ++r) negm[r] = 0.f;
    const int kvm = kvmap(r32);
#define ATT_QK(P, sl) do { const LAS unsigned char* _ks = lds + (sl) * C::SLOT; \
        _Pragma("unroll") for (int _h = 0; _h < 2; ++_h) { \
            _Pragma("unroll") for (int _d0 = 0; _d0 < C::ND0; ++_d0) { const bf16x8 _kf = *(const LAS bf16x8*)(_ks + (2 * _d0 + hi) * 1024 + (32 * _h + kvm) * 16); \
                if (_d0 == 0) P[_h] = __builtin_amdgcn_mfma_f32_32x32x16_bf16(_kf, qf[0], NEGM ? negm : (f32x16){0.f,0.f,0.f,0.f,0.f,0.f,0.f,0.f,0.f,0.f,0.f,0.f,0.f,0.f,0.f,0.f}, 0, 0, 0); \
                else P[_h] = __builtin_amdgcn_mfma_f32_32x32x16_bf16(_kf, qf[_d0], P[_h], 0, 0, 0); } } } while (0)
#define ATT_ACTIVE(t) (!MODE_NA || (t) < ky.na || ((na.r_lo + ((t) - ky.na)) >= nar0 && (na.r_lo + ((t) - ky.na)) < nar0 + 8))
#define ATT_LDV(dst, kc) do { _Pragma("unroll") for (int _db = 0; _db < C::NDB; ++_db) dst[_db] = *(const LAS bf16x8*)(vs + ((_db >> 1) * 8 + 2 * (kc) + hi) * 1024 + ((_db & 1) * 32 + r32) * 16); } while (0)
    int nar0 = 0; if (MODE_NA) { nar0 = na.qr - 4; nar0 = nar0 < 0 ? 0 : (nar0 > 56 ? 56 : nar0); nar0 = __builtin_amdgcn_readfirstlane(nar0); }
    bool naok[2][16];
    if (MODE_NA) { int c0 = na.qc - 8; c0 = c0 < 0 ? 0 : (c0 > 48 ? 48 : c0);
#pragma unroll
        for (int h = 0; h < 2; ++h)
#pragma unroll
            for (int r = 0; r < 16; ++r) naok[h][r] = (unsigned)(32 * h + 16 * (r >> 3) + 8 * hi + (r & 7) - c0) < 16u; }
    f32x16 p[2], pn[2];
    if (C::NPW == 2) ATT_WAITBAR(4); else ATT_WAITBAR(6);
    bool act = ATT_ACTIVE(0);
    if (act) ATT_QK(p, 0);
    int slot = 0;
    for (int t = 0; t < nt; ++t) {
        int s1 = slot + 1; s1 = s1 >= NSLOT ? s1 - NSLOT : s1; int s3 = slot + 3; s3 = s3 >= NSLOT ? s3 - NSLOT : s3;
        if (t + 2 < nt) { if (C::NPW == 2) ATT_WAITBAR(2); else ATT_WAITBAR(3); } else ATT_WAITBAR(0);
        if (t + 3 < nt) ATT_ISSUE(t + 3, s3);
        const bool actn = (t + 1 < nt) && ATT_ACTIVE(t + 1);
        if (actn) ATT_QK(pn, s1);
        if (act) {
            const LAS unsigned char* vs = lds + slot * C::SLOT + C::KB;
            bf16x8 vfa[C::NDB], vfb[C::NDB];
            ATT_LDV(vfa, 0); ATT_LDV(vfb, 1);
            __builtin_amdgcn_sched_barrier(0);
            if (MODE_NA) { if (t >= ky.na) {
                const int kr = na.r_lo + (t - ky.na);
                const LAS float* brow = na.bias + (kr - na.qr + 7) * 128 + 63 - na.qc + 8 * hi;
#pragma unroll
                for (int h = 0; h < 2; ++h) { float bb[16];
#pragma unroll
                    for (int r = 0; r < 16; ++r) bb[r] = brow[32 * h + 16 * (r >> 3) + (r & 7)];
#pragma unroll
                    for (int r = 0; r < 16; ++r) { const float pb = p[h][r] + bb[r]; p[h][r] = naok[h][r] ? pb : NEG_BIG; } } } }
            if (!NOMAX) {
            float mt = max3f(p[0][0], p[1][0], p[0][1]), mu = max3f(p[1][1], p[0][2], p[1][2]);
#pragma unroll
            for (int r = 3; r < 15; r += 2) { mt = max3f(mt, p[0][r], p[1][r]); mu = max3f(mu, p[0][r + 1], p[1][r + 1]); }
            mt = max3f(mt, p[0][15], p[1][15]); mt = max3f(mt, mu, mu);
            { const auto rr = __builtin_amdgcn_permlane32_swap(__float_as_uint(mt), __float_as_uint(mt), false, false);
              mt = max3f(mt, __uint_as_float(rr[0]), __uint_as_float(rr[1])); }
            if (!NEGM) mt -= m;
            if (__any(mt > THR)) {
                const float dl = fmaxf(mt, 0.f), al = __builtin_amdgcn_exp2f(-dl); m += dl; l *= al;
                if (NEGM) {
#pragma unroll
                for (int h = 0; h < 2; ++h)
#pragma unroll
                    for (int r = 0; r < 16; ++r) { p[h][r] -= dl; if (actn) pn[h][r] -= dl; } }
#pragma unroll
                for (int db = 0; db < C::NDB; ++db)
#pragma unroll
                    for (int r = 0; r < 16; ++r) oT[db][r] *= al;
                if (LSUM_MFMA) oL[0] *= al;
#pragma unroll
                for (int r = 0; r < 16; ++r) negm[r] = -m; } }
            float sacc = 0.f;
#pragma unroll
            for (int kc = 0; kc < 4; ++kc) { const int h = kc >> 1, b = 8 * (kc & 1);
#pragma unroll
                for (int j = 0; j < 8; ++j) { p[h][b + j] = __builtin_amdgcn_exp2f((NEGM || NOMAX) ? p[h][b + j] : p[h][b + j] - m); if (!LSUM_MFMA) sacc += p[h][b + j]; }
                v4u pw; pw.x = cvt_pk_bf16(p[h][b], p[h][b + 1]); pw.y = cvt_pk_bf16(p[h][b + 2], p[h][b + 3]); pw.z = cvt_pk_bf16(p[h][b + 4], p[h][b + 5]); pw.w = cvt_pk_bf16(p[h][b + 6], p[h][b + 7]);
                const bf16x8 pb = __builtin_bit_cast(bf16x8, pw);
#pragma unroll
                for (int db = 0; db < C::NDB; ++db) oT[db] = __builtin_amdgcn_mfma_f32_32x32x16_bf16((kc & 1) ? vfb[db] : vfa[db], pb, oT[db], 0, 0, 0);
                if (LSUM_MFMA) oL = __builtin_amdgcn_mfma_f32_32x32x16_bf16(onesf, pb, oL, 0, 0, 0);
                if (kc == 0) { ATT_LDV(vfa, 2); } else if (kc == 1) { ATT_LDV(vfb, 3); }
                __builtin_amdgcn_sched_barrier(0); }
            l += sacc;
        }
        if (actn) { p[0] = pn[0]; p[1] = pn[1]; }
        act = actn; slot = s1;
    }
    ATT_WAITBAR(0);
    if (LSUM_MFMA) l = oL[0];
    l_out = l + __shfl_xor(l, 32);
#undef ATT_LDV
#undef ATT_QK
#undef ATT_ACTIVE
#undef ATT_ISSUE
#undef ATT_DMA
}
template <int DK, int DV, bool MODE_NA>
__device__ __forceinline__ void attn_core16(LAS unsigned char* lds, const bf16_t* __restrict__ Qw  , int ldq,
                                            const bf16_t* __restrict__ Kh, int ldk, const bf16_t* __restrict__ VTh, int ldv,
                                            const Keys ky, const NaInfo na  , f32x4 (&o)[DV / 16][2], float (&l_out)[2]) {
    typedef Cfg<DK, DV> C;
    constexpr int NDS = DK / 32, NDB16 = DV / 16;
    int tid_ = threadIdx.x; asm volatile("" : "+v"(tid_));
    const int tid = tid_, lane = tid & 63, q16 = lane & 15, rg = lane >> 4; const int wid = __builtin_amdgcn_readfirstlane(tid >> 6);
    const int nt = ky.na + ky.nb;
    bf16x8 qf[2][NDS];
#pragma unroll
    for (int qb = 0; qb < 2; ++qb)
#pragma unroll
        for (int ds = 0; ds < NDS; ++ds) qf[qb][ds] = *(const bf16x8*)(Qw + (size_t)(16 * qb + q16) * ldq + 32 * ds + 8 * rg);
    const int keyof = 32 * (lane >> 5) + 8 * ((lane & 15) >> 2) + 4 * ((lane >> 4) & 1) + (lane & 3);
    const unsigned voffK = (unsigned)keyof * (unsigned)ldk * 2u, voffV = (unsigned)lane * (unsigned)ldv * 2u;
    const __amdgpu_buffer_rsrc_t srdK = __builtin_amdgcn_make_buffer_rsrc((void*)Kh, (short)0, 0x7FFFFFFF, 0x00020000);
    const __amdgpu_buffer_rsrc_t srdV = __builtin_amdgcn_make_buffer_rsrc((void*)VTh, (short)0, 0x7FFFFFFF, 0x00020000);
    const unsigned ldsb = (unsigned)(size_t)lds;
#define ATT_DMA(m0v, voff, srd, soff) asm volatile("s_mov_b32 m0, %0\n\ts_nop 0\n\tbuffer_load_dwordx4 %1, %2, %3 offen lds" :: "s"(m0v), "v"(voff), "s"(srd), "s"(soff) : "m0", "memory")
    __amdgpu_buffer_rsrc_t psrd[C::NPW]; unsigned pvoff[C::NPW], pcst[C::NPW], pmul[C::NPW], plds[C::NPW];
#pragma unroll
    for (int _j = 0; _j < C::NPW; ++_j) { int _pc = wid + 8 * _j; _pc = _pc < C::NP ? _pc : C::NP - 1; const bool _isk = _pc < C::NPK; const int _pv = _pc - C::NPK;
        psrd[_j] = _isk ? srdK : srdV; pvoff[_j] = _isk ? voffK : voffV;
        pcst[_j] = _isk ? (unsigned)(_pc * 8) * 2u : (unsigned)((_pv >> 3) * 64 * ldv + (_pv & 7) * 8) * 2u;
        pmul[_j] = _isk ? (unsigned)ldk * 2u : 2u;
        plds[_j] = ldsb + (_isk ? _pc * 1024 : C::KB + _pv * 1024); }
#define ATT_ISSUE(t, slot) do { const unsigned _row0 = (unsigned)((t) < ky.na ? ky.ka0 + 64 * (t) : ky.kb0 + 64 * ((t) - ky.na)); const unsigned _sb = (unsigned)(slot) * C::SLOT; \
        _Pragma("unroll") for (int _j = 0; _j < C::NPW; ++_j) ATT_DMA(plds[_j] + _sb, pvoff[_j], psrd[_j], pcst[_j] + _row0 * pmul[_j]); } while (0)
    ATT_ISSUE(0, 0); ATT_ISSUE(1, 1); ATT_ISSUE(2, 2);
#pragma unroll
    for (int db = 0; db < NDB16; ++db)
#pragma unroll
        for (int qb = 0; qb < 2; ++qb) o[db][qb] = (f32x4){0.f, 0.f, 0.f, 0.f};
    f32x4 oL[2] = {(f32x4){0.f, 0.f, 0.f, 0.f}, (f32x4){0.f, 0.f, 0.f, 0.f}};
    const unsigned onesw = (q16 == 0) ? 0x3F803F80u : 0u;
    const bf16x8 onesf = __builtin_bit_cast(bf16x8, (v4u){onesw, onesw, onesw, onesw});
#define ATT_QK(Sx, sl) do { const LAS unsigned char* _ks = lds + (sl) * C::SLOT + rg * 1024 + q16 * 16; \
        _Pragma("unroll") for (int _ds = 0; _ds < NDS; ++_ds) {   \
            _Pragma("unroll") for (int _kb = 0; _kb < 4; ++_kb) { const bf16x8 _kf = *(const LAS bf16x8*)(_ks + _ds * 4096 + _kb * 256); \
                _Pragma("unroll") for (int _qb = 0; _qb < 2; ++_qb) { \
                    if (_ds == 0) Sx[_kb][_qb] = __builtin_amdgcn_mfma_f32_16x16x32_bf16(_kf, qf[_qb][0], (f32x4){0.f, 0.f, 0.f, 0.f}, 0, 0, 0); \
                    else Sx[_kb][_qb] = __builtin_amdgcn_mfma_f32_16x16x32_bf16(_kf, qf[_qb][_ds], Sx[_kb][_qb], 0, 0, 0); } } } } while (0)
#define ATT_ACTIVE(t) (!MODE_NA || (t) < ky.na || ((na.r_lo + ((t) - ky.na)) >= nar0 && (na.r_lo + ((t) - ky.na)) < nar0 + 8))
#define ATT_LDV(dst, st) do { _Pragma("unroll") for (int _db = 0; _db < NDB16; ++_db) dst[_db] = *(const LAS bf16x8*)(vs + ((_db >> 2) * 8 + 4 * (st) + rg) * 1024 + (16 * (_db & 3) + q16) * 16); } while (0)
    int nar0 = 0; if (MODE_NA) { nar0 = na.qr - 4; nar0 = nar0 < 0 ? 0 : (nar0 > 56 ? 56 : nar0); nar0 = __builtin_amdgcn_readfirstlane(nar0); }
    bool naok[4][2][4]; int qcl[2];
    if (MODE_NA) {
#pragma unroll
        for (int qb = 0; qb < 2; ++qb) { qcl[qb] = na.qc + 16 * qb + q16; int c0 = qcl[qb] - 8; c0 = c0 < 0 ? 0 : (c0 > 48 ? 48 : c0);
#pragma unroll
            for (int kb = 0; kb < 4; ++kb)
#pragma unroll
                for (int j = 0; j < 4; ++j) naok[kb][qb][j] = (unsigned)(32 * (kb >> 1) + 8 * rg + 4 * (kb & 1) + j - c0) < 16u; } }
    f32x4 SA[4][2], SB[4][2];
    if (C::NPW == 2) ATT_WAITBAR(4); else ATT_WAITBAR(6);
    bool act = ATT_ACTIVE(0);
    if (act) ATT_QK(SA, 0);
    int slot = 0;
    for (int t0 = 0; t0 < nt; t0 += 2) {
#pragma unroll
      for (int hh = 0; hh < 2; ++hh) {
        f32x4 (&S)[4][2] = hh ? SB : SA; f32x4 (&Sn)[4][2] = hh ? SA : SB;
        const int t = t0 + hh;
        if (t < nt) {
        int s1 = slot + 1; s1 = s1 >= NSLOT ? s1 - NSLOT : s1; int s3 = slot + 3; s3 = s3 >= NSLOT ? s3 - NSLOT : s3;
        if (t + 2 < nt) { if (C::NPW == 2) ATT_WAITBAR(2); else ATT_WAITBAR(3); } else ATT_WAITBAR(0);
        if (t + 3 < nt) ATT_ISSUE(t + 3, s3);
        const bool actn = (t + 1 < nt) && ATT_ACTIVE(t + 1);
        if (actn) ATT_QK(Sn, s1);
        if (act) {
            const LAS unsigned char* vs = lds + slot * C::SLOT + C::KB;
            bf16x8 vfa[NDB16], vfb[NDB16];
            ATT_LDV(vfa, 0); if (NDB16 <= 4) ATT_LDV(vfb, 1);
            __builtin_amdgcn_sched_barrier(0);
            if (MODE_NA) { if (t >= ky.na) {
                const int kr = na.r_lo + (t - ky.na);
#pragma unroll
                for (int qb = 0; qb < 2; ++qb) { const LAS float* brow = na.bias + (kr - na.qr + 7) * 128 + 63 - qcl[qb] + 8 * rg;
#pragma unroll
                    for (int kb = 0; kb < 4; ++kb) { float bb[4];
#pragma unroll
                        for (int j = 0; j < 4; ++j) bb[j] = brow[32 * (kb >> 1) + 4 * (kb & 1) + j];
#pragma unroll
                        for (int j = 0; j < 4; ++j) { const float pb_ = S[kb][qb][j] + bb[j]; S[kb][qb][j] = naok[kb][qb][j] ? pb_ : NEG_BIG; } } } } }
#pragma unroll
            for (int st = 0; st < 2; ++st) {
#pragma unroll
                for (int qb = 0; qb < 2; ++qb) {
                    float e[8];
#pragma unroll
                    for (int j = 0; j < 4; ++j) { e[j] = __builtin_amdgcn_exp2f(S[2 * st][qb][j]); e[4 + j] = __builtin_amdgcn_exp2f(S[2 * st + 1][qb][j]); }
                    v4u pw; pw.x = cvt_pk_bf16(e[0], e[1]); pw.y = cvt_pk_bf16(e[2], e[3]); pw.z = cvt_pk_bf16(e[4], e[5]); pw.w = cvt_pk_bf16(e[6], e[7]);
                    const bf16x8 pb = __builtin_bit_cast(bf16x8, pw);
#pragma unroll
                    for (int db = 0; db < NDB16; ++db) o[db][qb] = __builtin_amdgcn_mfma_f32_16x16x32_bf16((st && NDB16 <= 4) ? vfb[db] : vfa[db], pb, o[db][qb], 0, 0, 0);
                    oL[qb] = __builtin_amdgcn_mfma_f32_16x16x32_bf16(onesf, pb, oL[qb], 0, 0, 0);
                }
                if (NDB16 > 4 && st == 0) ATT_LDV(vfa, 1);
                __builtin_amdgcn_sched_barrier(0); }
        }
        act = actn; slot = s1;
        } }
    }
    ATT_WAITBAR(0);
#pragma unroll
    for (int qb = 0; qb < 2; ++qb) l_out[qb] = __shfl(oL[qb][0], q16);
#undef ATT_LDV
#undef ATT_QK
#undef ATT_ACTIVE
#undef ATT_ISSUE
#undef ATT_DMA
}
template <int NDB16>
__device__ __forceinline__ void store_o16(const f32x4 (&o)[NDB16][2], const float (&scale)[2], bf16_t* Ow  , int q16, int rg) {
#pragma unroll
    for (int qb = 0; qb < 2; ++qb)
#pragma unroll
        for (int i = 0; i < NDB16 / 2; ++i) { const f32x4 va = o[2 * i][qb] * scale[qb], vb = o[2 * i + 1][qb] * scale[qb];
            const unsigned ax = cvt_pk_bf16(va[0], va[1]), ay = cvt_pk_bf16(va[2], va[3]), bx = cvt_pk_bf16(vb[0], vb[1]), by = cvt_pk_bf16(vb[2], vb[3]);
            const auto sx = __builtin_amdgcn_permlane16_swap(ax, bx, false, false);
            const auto sy = __builtin_amdgcn_permlane16_swap(ay, by, false, false);
            v4u w; w.x = sx[0]; w.y = sy[0]; w.z = sx[1]; w.w = sy[1];
            const int col = (rg & 1) ? 16 * (2 * i + 1) + 4 * (rg - 1) : 16 * (2 * i) + 4 * rg;
            *(v4u*)(Ow + (size_t)(16 * qb + q16) * D + col) = w; }
}
template <int NDB>
__device__ __forceinline__ void store_o(const f32x16 (&oT)[NDB], float scale, bf16_t* Op  , int hi) {
#pragma unroll
    for (int db = 0; db < NDB; ++db)
#pragma unroll
        for (int k = 0; k < 2; ++k) { const int g0 = 2 * k, g1 = 2 * k + 1;
            const unsigned w0x = cvt_pk_bf16(oT[db][4 * g0] * scale, oT[db][4 * g0 + 1] * scale), w0y = cvt_pk_bf16(oT[db][4 * g0 + 2] * scale, oT[db][4 * g0 + 3] * scale);
            const unsigned w1x = cvt_pk_bf16(oT[db][4 * g1] * scale, oT[db][4 * g1 + 1] * scale), w1y = cvt_pk_bf16(oT[db][4 * g1 + 2] * scale, oT[db][4 * g1 + 3] * scale);
            const auto sx = __builtin_amdgcn_permlane32_swap(w0x, w1x, false, false);
            const auto sy = __builtin_amdgcn_permlane32_swap(w0y, w1y, false, false);
            v4u w; w.x = sx[0]; w.y = sy[0]; w.z = sx[1]; w.w = sy[1];
            *(v4u*)(Op + 32 * db + 16 * k + 8 * hi) = w; }
}
}
namespace ew {
using namespace mk;

__device__ __forceinline__ void conv_item(const float* __restrict__ W, int ldw, int k0, int n0, int nvalid, bf16_t* __restrict__ dst, int dK, LAS float* scr, int lane) {
    const int n4 = (lane & 15) * 4, kr = lane >> 4;
#pragma unroll
    for (int i = 0; i < 8; ++i) { const int k = kr + 4 * i;
        f32x4 v = (f32x4){0.f, 0.f, 0.f, 0.f};
        if (n4 < nvalid) v = *(const f32x4*)(W + (size_t)(k0 + k) * ldw + n0 + n4);
        scr[k * 65 + n4] = v.x; scr[k * 65 + n4 + 1] = v.y; scr[k * 65 + n4 + 2] = v.z; scr[k * 65 + n4 + 3] = v.w; }
    LDS_WAIT(); asm volatile("" ::: "memory");
    const int c = lane & 3;
#pragma unroll
    for (int j = 0; j < 4; ++j) { const int n = (lane >> 2) + 16 * j; const LAS float* s = scr + (8 * c) * 65 + n;
        v4u o; o.x = cvt_pk_bf16(s[0], s[65]); o.y = cvt_pk_bf16(s[2 * 65], s[3 * 65]); o.z = cvt_pk_bf16(s[4 * 65], s[5 * 65]); o.w = cvt_pk_bf16(s[6 * 65], s[7 * 65]);
        if (n < nvalid) *(v4u*)(dst + (size_t)n * dK + k0 + 8 * c) = o; }
    LDS_WAIT(); asm volatile("" ::: "memory");
}

__device__ __forceinline__ void conv_load(const float* __restrict__ src, int ldw, int nvalid, f32x4 (&v)[8], int lane) {
    const int n4 = (lane & 15) * 4, kr = lane >> 4;
#pragma unroll
    for (int i = 0; i < 8; ++i) { v[i] = (f32x4){0.f, 0.f, 0.f, 0.f}; if (n4 < nvalid) v[i] = *(const f32x4*)(src + (size_t)(kr + 4 * i) * ldw + n4); }
}
__device__ __forceinline__ void conv_store(const f32x4 (&v)[8], unsigned char* __restrict__ dst, int dkb, int nvalid, float scale, int hi_jump, LAS float* scr, int lane) {
    const int n4 = (lane & 15) * 4, kr = lane >> 4;
#pragma unroll
    for (int i = 0; i < 8; ++i) { const int k = kr + 4 * i; scr[k * 65 + n4] = v[i].x; scr[k * 65 + n4 + 1] = v[i].y; scr[k * 65 + n4 + 2] = v[i].z; scr[k * 65 + n4 + 3] = v[i].w; }
    LDS_WAIT(); asm volatile("" ::: "memory");
    const int c = lane & 3;
#pragma unroll
    for (int j = 0; j < 4; ++j) { const int n = (lane >> 2) + 16 * j; const LAS float* s = scr + (8 * c) * 65 + n;
        if (scale == 0.f) { v4u o; o.x = cvt_pk_bf16(s[0], s[65]); o.y = cvt_pk_bf16(s[2 * 65], s[3 * 65]); o.z = cvt_pk_bf16(s[4 * 65], s[5 * 65]); o.w = cvt_pk_bf16(s[6 * 65], s[7 * 65]);
            if (n < nvalid) *(v4u*)(dst + (size_t)(n + (n >= 32 ? hi_jump : 0)) * dkb + 16 * c) = o; }
        else { v2u o; o.x = cvt4_fp8(s[0] * scale, s[65] * scale, s[2 * 65] * scale, s[3 * 65] * scale); o.y = cvt4_fp8(s[4 * 65] * scale, s[5 * 65] * scale, s[6 * 65] * scale, s[7 * 65] * scale);
            *(v2u*)(dst + (size_t)n * dkb + 8 * c) = o; } }
    LDS_WAIT(); asm volatile("" ::: "memory");
}
__device__ __forceinline__ void conv_item_f8(const float* __restrict__ W, int ldw, int k0, int n0, unsigned char* __restrict__ dst, int dKb, float scale, LAS float* scr, int lane) {
    const int n4 = (lane & 15) * 4, kr = lane >> 4;
#pragma unroll
    for (int i = 0; i < 8; ++i) { const int k = kr + 4 * i;
        const f32x4 v = *(const f32x4*)(W + (size_t)(k0 + k) * ldw + n0 + n4);
        scr[k * 65 + n4] = v.x; scr[k * 65 + n4 + 1] = v.y; scr[k * 65 + n4 + 2] = v.z; scr[k * 65 + n4 + 3] = v.w; }
    LDS_WAIT(); asm volatile("" ::: "memory");
    const int c = lane & 3;
#pragma unroll
    for (int j = 0; j < 4; ++j) { const int n = (lane >> 2) + 16 * j; const LAS float* s = scr + (8 * c) * 65 + n;
        v2u o; o.x = cvt4_fp8(s[0] * scale, s[65] * scale, s[2 * 65] * scale, s[3 * 65] * scale); o.y = cvt4_fp8(s[4 * 65] * scale, s[5 * 65] * scale, s[6 * 65] * scale, s[7 * 65] * scale);
        *(v2u*)(dst + (size_t)n * dKb + k0 + 8 * c) = o; }
    LDS_WAIT(); asm volatile("" ::: "memory");
}

__device__ __forceinline__ void normmod_row(const float* __restrict__ xrow, const float* __restrict__ g, const float* __restrict__ sh, const float* __restrict__ sc, bf16_t* __restrict__ orow, int lane) {
    const f32x4* xr = (const f32x4*)xrow + lane;
    f32x4 v[4]; float s = 0.f;
#pragma unroll
    for (int j = 0; j < 4; ++j) { v[j] = xr[64 * j]; s += (v[j].x * v[j].x + v[j].y * v[j].y) + (v[j].z * v[j].z + v[j].w * v[j].w); }
    const float rstd = rsqrtf(wave_sum(s) * (1.f / D) + EPS);
    v2u* o8 = (v2u*)orow + lane;
#pragma unroll
    for (int j = 0; j < 4; ++j) { const f32x4 gg = ((const f32x4*)g)[lane + 64 * j], s1 = ((const f32x4*)sc)[lane + 64 * j], s0 = ((const f32x4*)sh)[lane + 64 * j];
        const f32x4 y = v[j] * rstd * gg * (s1 + 1.f) + s0;
        v2u w; w.x = cvt_pk_bf16(y.x, y.y); w.y = cvt_pk_bf16(y.z, y.w); o8[64 * j] = w; }
}

__device__ __forceinline__ void unpack8(const v4u w, float (&f)[8]);
__device__ __forceinline__ v4u pack8(const float (&f)[8]);
__device__ __forceinline__ void normmod_row_bf(const bf16_t* __restrict__ xrow, const float* __restrict__ g, const float* __restrict__ sh, const float* __restrict__ sc, bf16_t* __restrict__ orow, int lane) {
    float f[2][8]; float s = 0.f;
#pragma unroll
    for (int j = 0; j < 2; ++j) { unpack8(*((const v4u*)xrow + lane + 64 * j), f[j]);
#pragma unroll
        for (int q = 0; q < 8; ++q) s += f[j][q] * f[j][q]; }
    const float rstd = rsqrtf(wave_sum(s) * (1.f / D) + EPS);
#pragma unroll
    for (int j = 0; j < 2; ++j) { const int c = 8 * lane + 512 * j;
#pragma unroll
        for (int h = 0; h < 2; ++h) { const f32x4 gg = *(const f32x4*)(g + c + 4 * h), s1 = *(const f32x4*)(sc + c + 4 * h), s0 = *(const f32x4*)(sh + c + 4 * h);
#pragma unroll
            for (int q = 0; q < 4; ++q) f[j][4 * h + q] = f[j][4 * h + q] * rstd * gg[q] * (s1[q] + 1.f) + s0[q]; }
        *((v4u*)orow + lane + 64 * j) = pack8(f[j]); }
}

struct RowRegs { f32x4 v[4]; v4u w[2]; };
template <bool BF> __device__ __forceinline__ void nm_load(const void* xrow, RowRegs& R, int lane) {
    if (BF) { R.w[0] = *((const v4u*)xrow + lane); R.w[1] = *((const v4u*)xrow + lane + 64); }
    else {
#pragma unroll
        for (int j = 0; j < 4; ++j) R.v[j] = ((const f32x4*)xrow)[lane + 64 * j]; }
}
template <bool BF> __device__ __forceinline__ void nm_finish(const RowRegs& R, const float* __restrict__ g, const float* __restrict__ sh, const float* __restrict__ sc, bf16_t* __restrict__ orow, int lane) {
    if (BF) {
        float f[2][8]; float s = 0.f;
#pragma unroll
        for (int j = 0; j < 2; ++j) { unpack8(R.w[j], f[j]);
#pragma unroll
            for (int q = 0; q < 8; ++q) s += f[j][q] * f[j][q]; }
        const float rstd = rsqrtf(wave_sum(s) * (1.f / D) + EPS);
#pragma unroll
        for (int j = 0; j < 2; ++j) { const int c = 8 * lane + 512 * j;
#pragma unroll
            for (int h = 0; h < 2; ++h) { const f32x4 gg = *(const f32x4*)(g + c + 4 * h), s1 = *(const f32x4*)(sc + c + 4 * h), s0 = *(const f32x4*)(sh + c + 4 * h);
#pragma unroll
                for (int q = 0; q < 4; ++q) f[j][4 * h + q] = f[j][4 * h + q] * rstd * gg[q] * (s1[q] + 1.f) + s0[q]; }
            *((v4u*)orow + lane + 64 * j) = pack8(f[j]); }
    } else {
        float s = 0.f;
#pragma unroll
        for (int j = 0; j < 4; ++j) s += (R.v[j].x * R.v[j].x + R.v[j].y * R.v[j].y) + (R.v[j].z * R.v[j].z + R.v[j].w * R.v[j].w);
        const float rstd = rsqrtf(wave_sum(s) * (1.f / D) + EPS);
        v2u* o8 = (v2u*)orow + lane;
#pragma unroll
        for (int j = 0; j < 4; ++j) { const f32x4 gg = ((const f32x4*)g)[lane + 64 * j], s1 = ((const f32x4*)sc)[lane + 64 * j], s0 = ((const f32x4*)sh)[lane + 64 * j];
            const f32x4 y = R.v[j] * rstd * gg * (s1 + 1.f) + s0;
            v2u w; w.x = cvt_pk_bf16(y.x, y.y); w.y = cvt_pk_bf16(y.z, y.w); o8[64 * j] = w; }
    }
}
struct ModRegs { f32x4 mul[4], add[4]; };
template <bool BF> __device__ __forceinline__ void nm_mod_load(ModRegs& M, const float* __restrict__ g, const float* __restrict__ sh, const float* __restrict__ sc, int lane) {
#pragma unroll
    for (int k = 0; k < 4; ++k) { const int c = BF ? 8 * lane + 512 * (k >> 1) + 4 * (k & 1) : 4 * lane + 256 * k;
        M.mul[k] = *(const f32x4*)(g + c) * (*(const f32x4*)(sc + c) + 1.f); M.add[k] = *(const f32x4*)(sh + c); }
}
template <bool BF> __device__ __forceinline__ void nm_finish_m(const RowRegs& R, const ModRegs& M, bf16_t* __restrict__ orow, int lane) {
    if (BF) {
        float f[2][8]; float s = 0.f;
#pragma unroll
        for (int j = 0; j < 2; ++j) { unpack8(R.w[j], f[j]);
#pragma unroll
            for (int q = 0; q < 8; ++q) s += f[j][q] * f[j][q]; }
        const float rstd = rsqrtf(wave_sum(s) * (1.f / D) + EPS);
#pragma unroll
        for (int j = 0; j < 2; ++j) {
#pragma unroll
            for (int h = 0; h < 2; ++h)
#pragma unroll
                for (int q = 0; q < 4; ++q) f[j][4 * h + q] = f[j][4 * h + q] * rstd * M.mul[2 * j + h][q] + M.add[2 * j + h][q];
            *((v4u*)orow + lane + 64 * j) = pack8(f[j]); }
    } else {
        float s = 0.f;
#pragma unroll
        for (int j = 0; j < 4; ++j) s += (R.v[j].x * R.v[j].x + R.v[j].y * R.v[j].y) + (R.v[j].z * R.v[j].z + R.v[j].w * R.v[j].w);
        const float rstd = rsqrtf(wave_sum(s) * (1.f / D) + EPS);
        v2u* o8 = (v2u*)orow + lane;
#pragma unroll
        for (int j = 0; j < 4; ++j) { const f32x4 y = R.v[j] * rstd * M.mul[j] + M.add[j];
            v2u w; w.x = cvt_pk_bf16(y.x, y.y); w.y = cvt_pk_bf16(y.z, y.w); o8[64 * j] = w; }
    }
}
__device__ __forceinline__ void unpack8(const v4u w, float (&f)[8]) { f[0] = bflo(w.x); f[1] = bfhi(w.x); f[2] = bflo(w.y); f[3] = bfhi(w.y); f[4] = bflo(w.z); f[5] = bfhi(w.z); f[6] = bflo(w.w); f[7] = bfhi(w.w); }
__device__ __forceinline__ v4u pack8(const float (&f)[8]) { v4u w; w.x = cvt_pk_bf16(f[0], f[1]); w.y = cvt_pk_bf16(f[2], f[3]); w.z = cvt_pk_bf16(f[4], f[5]); w.w = cvt_pk_bf16(f[6], f[7]); return w; }

struct Rope { const f32x2* t64; const f32x2* t32; };

__device__ __forceinline__ void seg64(float (&f)[8], int lane, const float (&g8)[8]  , bool rope, int gr, int gc, const Rope& R, float scale) {
    const int s = lane & 7;
    float ss = 0.f;
#pragma unroll
    for (int j = 0; j < 8; ++j) ss += f[j] * f[j];
    ss = sum8_f(ss);
    const float rstd = rsqrtf(ss * (1.f / 64.f) + EPS);
#pragma unroll
    for (int j = 0; j < 8; ++j) f[j] = f[j] * rstd * g8[j];
    float pr[8];
#pragma unroll
    for (int j = 0; j < 8; ++j) pr[j] = xor2_f(f[j]);
    if (rope) {
        const int pos = (s >> 2) ? gc : gr; const bool x1 = (s & 3) < 2; const int i0 = 8 * (s & 1);
#pragma unroll
        for (int j = 0; j < 8; ++j) { const f32x2 cs = R.t64[pos * 16 + i0 + j]; f[j] = x1 ? (f[j] * cs.x - pr[j] * cs.y) : (pr[j] * cs.y + f[j] * cs.x); }
    }
#pragma unroll
    for (int j = 0; j < 8; ++j) f[j] *= scale;
}
}
namespace mk {
constexpr size_t MiB = (size_t)1 << 20;
constexpr size_t WS_CTL = 0, CTL_ZERO_BYTES = 1 * MiB;
constexpr size_t WS_MODF = 1 * MiB;
constexpr size_t WS_ROPE = 2 * MiB;
constexpr size_t WS_SLOT_TOK = 3 * MiB;
constexpr size_t WS_SLOT_G = 5 * MiB;
constexpr size_t WS_XC = 8 * MiB;
constexpr size_t WS_WQK0 = 16 * MiB, WS_WV0 = 20 * MiB, WS_WO0 = 22 * MiB, WS_WGU0 = 24 * MiB, WS_WD0 = 35 * MiB;
constexpr size_t WS_WODD = 41 * MiB, WS_WVC = 43 * MiB + 512 * 1024, WS_WO1 = 44 * MiB, WS_WUQ = 46 * MiB, WS_WUKN = 46 * MiB + 512 * 1024, WS_WUKV = 46 * MiB + 640 * 1024;
constexpr size_t WS_W13 = 48 * MiB, WS_W2 = 104 * MiB;
constexpr float W13_SCALE = 256.f, W2_SCALE = 512.f, ACT_SCALE = 16.f;
constexpr size_t WS_XB = 216 * MiB;
constexpr size_t OUT_H = 0, OUT_CQN = 0, OUT_CKVN = 17 * MiB, OUT_KN = 26 * MiB;
constexpr size_t WS_BIG = 284 * MiB;
constexpr size_t WS_QK0 = WS_BIG, WS_VT0 = 420 * MiB, WS_DSCR = 488 * MiB, WS_MID0 = WS_BIG;
constexpr size_t WS_P1 = WS_BIG, WS_VT1C = 369 * MiB, WS_QD = 386 * MiB, WS_VT1D = 434 * MiB, WS_KDF = 468 * MiB, WS_MID1 = WS_BIG;
constexpr size_t WS_END = 522 * MiB;
constexpr int CW_TMO = 0, CW_GCNT = 64, CW_BAR = 4096;
constexpr int RING_BYTES = 131072, LDSCTL_OFF = RING_BYTES, MISC_OFF = LDSCTL_OFF + 320, LDS_BYTES = 147456;
constexpr int P1LD = 1280;
constexpr float QSCALE64 = 0.125f * LOG2E, QSCALE96 = 0.10206207261596575f * LOG2E;
constexpr int NPHASE = 22;
}

#define XB_TMO      128
#define XB_XCNT(j)  (256  + 64 * (j))
#define XB_XSUB(j)  (1280 + 64 * (j))
#define XB_XGEN(j)  (2304 + 64 * (j))
#define XB_TOP      3328
#define XB_TOPGEN   3392
#define XCD_BAR_WORDS 3456
#define XB_SPIN_CAP (1u << 18)

__device__ __forceinline__ unsigned xb_ld(unsigned* p)              { return __hip_atomic_load(p, __ATOMIC_RELAXED, __HIP_MEMORY_SCOPE_AGENT); }
__device__ __forceinline__ unsigned xb_add(unsigned* p, unsigned v) { return __hip_atomic_fetch_add(p, v, __ATOMIC_RELAXED, __HIP_MEMORY_SCOPE_AGENT); }
__device__ __forceinline__ unsigned xb_xcc_id() { return (unsigned)__builtin_amdgcn_s_getreg((3 << 11) | 20) & 0xFu; }
#define XB_SPIN(cond, bar) do { unsigned _sp = 0; while (cond) { __builtin_amdgcn_s_sleep(1); \
    if ((++_sp & 255u) == 0u) { if (xb_ld(&(bar)[XB_TMO])) break; if (_sp > XB_SPIN_CAP) { atomicAdd(&(bar)[XB_TMO], 1u); break; } } } } while (0)

struct XcdBarrier {
    unsigned* bar; unsigned x;
    volatile LAS unsigned* st;
};

__device__ __forceinline__ XcdBarrier xcd_barrier_post(unsigned* bar, volatile LAS unsigned* st) {
    XcdBarrier b; b.bar = bar; b.x = xb_xcc_id(); b.st = st;
    if (threadIdx.x == 0) (void)xb_add(&bar[XB_XCNT(b.x)], 1u);
    return b;
}
__device__ __forceinline__ void xcd_barrier_complete(unsigned* bar, unsigned x, unsigned& nloc, unsigned& nx) {
    const unsigned G = gridDim.x * gridDim.y * gridDim.z;
    unsigned sum, cnt, mine, sp = 0u;
    for (;;) {
        sum = 0u; cnt = 0u; mine = 0u;
#pragma unroll
        for (unsigned j = 0; j < 16; ++j) { const unsigned c = xb_ld(&bar[XB_XCNT(j)]); sum += c; cnt += (c > 0u) ? 1u : 0u; mine = (j == x) ? c : mine; }
        if (sum == G) break;
        __builtin_amdgcn_s_sleep(1);
        if ((++sp & 255u) == 0u) { if (xb_ld(&bar[XB_TMO])) break; if (sp > XB_SPIN_CAP) { atomicAdd(&bar[XB_TMO], 1u); break; } }
    }
    nloc = mine > 0u ? mine : 1u; nx = cnt > 0u ? cnt : 1u;
}

__device__ __forceinline__ void xcd_barrier(const XcdBarrier& b) {
    asm volatile("s_waitcnt vmcnt(0)" ::: "memory");
    __syncthreads();
    if (threadIdx.x == 0) {
        unsigned* bar = b.bar;
        __builtin_amdgcn_s_waitcnt(0);
        unsigned nloc = b.st[0], nx = b.st[1];
        if (nloc == 0u) { xcd_barrier_complete(bar, b.x, nloc, nx); b.st[0] = nloc; b.st[1] = nx; }
        const unsigned old = xb_add(&bar[XB_XSUB(b.x)], 1u);
        const unsigned gen = old / nloc;
        if (old + 1u == (gen + 1u) * nloc) {
            __builtin_amdgcn_fence(__ATOMIC_RELEASE, "agent");
            asm volatile("s_waitcnt vmcnt(0)" ::: "memory");
            const unsigned og = xb_add(&bar[XB_TOP], 1u);
            const unsigned tg = og / nx;
            if (og + 1u == (tg + 1u) * nx) xb_add(&bar[XB_TOPGEN], 1u);
            else XB_SPIN(xb_ld(&bar[XB_TOPGEN]) == tg, bar);
            __builtin_amdgcn_fence(__ATOMIC_ACQUIRE, "agent");
            xb_add(&bar[XB_XGEN(b.x)], 1u);
            asm volatile("s_waitcnt vmcnt(0)" ::: "memory");
        } else {
            XB_SPIN(xb_ld(&bar[XB_XGEN(b.x)]) == gen, bar);
            __builtin_amdgcn_fence(__ATOMIC_ACQUIRE, "agent");
            asm volatile("s_waitcnt vmcnt(0)" ::: "memory");
        }
    }
    __syncthreads();
}


namespace mk {
struct Args { const float* in[37]; float* out; unsigned char* ws; int ph_lo, ph_hi; };

struct Frame {
    LAS unsigned char* lds; volatile LAS unsigned* MISC; gu32* ctl;
    int tid, lane, wave, G, vcu, gw, NGW;
};

__device__ __forceinline__ void p0_prologue(Frame& F, const Args& a, bool do_mod, bool do_conv) {
    unsigned char* ws = a.ws;
    LAS float* sct = (LAS float*)F.lds;
    for (int i = F.tid; i < 9 * D; i += NTHR) { const int v = i >> 10, k = i & 1023; const float x = v < 8 ? a.in[1][v * D + k] : a.in[3][k]; sct[i] = x / (1.f + expf(-x)); }
    __syncthreads();
    if (do_mod) {
        LAS float* red = (LAS float*)(F.lds + 40960);
        for (int it = blockIdx.x; it < 384; it += F.G) {
            const int l = it / 192, j0 = (it % 192) * 32, cl = F.tid & 31, ks = F.tid >> 5, col = j0 + cl;
            const float* W = a.in[4] + (size_t)l * D * 6144 + col + (size_t)(ks * 64) * 6144;
            float acc[9];
#pragma unroll
            for (int v = 0; v < 9; ++v) acc[v] = 0.f;
#pragma unroll 16
            for (int k = 0; k < 64; ++k) { const float w = W[(size_t)k * 6144];
#pragma unroll
                for (int v = 0; v < 9; ++v) acc[v] += sct[v * D + ks * 64 + k] * w; }
#pragma unroll
            for (int v = 0; v < 9; ++v) red[(ks * 9 + v) * 32 + cl] = acc[v];
            __syncthreads();
            if (F.tid < 288) { const int v = F.tid >> 5; float s = 0.f;
#pragma unroll
                for (int q = 0; q < 16; ++q) s += red[(q * 9 + v) * 32 + cl];
                ((float*)(ws + WS_MODF))[((size_t)l * 9 + v) * 6144 + col] = s + a.in[5][l * 6144 + col]; }
            __syncthreads();
        }
    }
    if (blockIdx.x == 0) {
        f32x2* t64 = (f32x2*)(ws + WS_ROPE); f32x2* t32 = (f32x2*)(ws + WS_ROPE + 16384);
        for (int i = F.tid; i < 64 * 16; i += NTHR) { const int pos = i >> 4, k = i & 15; const float ang = (float)pos * powf(10000.f, -(float)k / 16.f); t64[i] = (f32x2){cosf(ang), sinf(ang)}; }
        for (int i = F.tid; i < 64 * 8; i += NTHR) { const int pos = i >> 3, k = i & 7; const float ang = (float)pos * powf(10000.f, -(float)k / 8.f); t32[i] = (f32x2){cosf(ang), sinf(ang)}; }
        if (F.tid < 256) { const int kq = F.tid >> 6, d = F.tid & 63; ((float*)(ws + WS_ROPE + 32768))[F.tid] = a.in[kq == 0 ? 10 : kq == 1 ? 11 : kq == 2 ? 13 : 14][d]; }
    }
    LAS float* scr = (LAS float*)(F.lds + 61440 + F.wave * 8448);
    constexpr int I_EVIN = 32 * 48, I_EVOUT = 32 * 16, I_FG = 32 * 44, I_FU = 32 * 44, I_FD = 88 * 16, I_ODIN = 32 * 19, I_ODOUT = 32 * 16, I_UQ = 8 * 12, I_UKV = 4 * 16;
    constexpr int I_W1 = 32 * 56, I_W2 = 112 * 16;
    constexpr int I_SMALL = I_EVIN + I_EVOUT + I_FG + I_FU + I_FD + I_ODIN + I_ODOUT + I_UQ + I_UKV;
    constexpr int I_TOTAL = I_SMALL + 8 * (2 * I_W1 + I_W2);
#define P0_DECODE(it_, SRC, LDW, DST, DKB, NV, SCL, JMP) do { int r = (it_); NV = 64; SCL = 0.f; JMP = 0; \
        if (r < I_EVIN) { const int kb = r / 48, nb = r % 48, n0 = nb * 64; bf16_t* d_; \
              \
            if (n0 < 1024 || (n0 >= 1536 && n0 < 2560)) { const int lc = n0 < 1024 ? n0 : n0 - 512; d_ = (bf16_t*)(ws + WS_WQK0) + (size_t)((lc >> 8) * 256 + ((lc >> 6) & 3) * 32) * D; JMP = 96; } \
            else if (n0 < 1536) d_ = (bf16_t*)(ws + WS_WV0) + (size_t)(n0 - 1024) * D; else d_ = (bf16_t*)(ws + WS_WV0) + (size_t)(n0 - 2048) * D; \
            SRC = a.in[8] + (size_t)(kb * 32) * 3072 + n0; LDW = 3072; DST = (unsigned char*)(d_ + kb * 32); DKB = D * 2; break; } r -= I_EVIN; \
        if (r < I_EVOUT) { const int kb = r / 16, n0 = (r % 16) * 64; SRC = a.in[9] + (size_t)(kb * 32) * D + n0; LDW = D; DST = (unsigned char*)((bf16_t*)(ws + WS_WO0) + (size_t)n0 * D + kb * 32); DKB = D * 2; break; } r -= I_EVOUT; \
        if (r < I_FG) { const int kb = r / 44, n0 = (r % 44) * 64; SRC = a.in[20] + (size_t)(kb * 32) * 2816 + n0; LDW = 2816; DST = (unsigned char*)((bf16_t*)(ws + WS_WGU0) + (size_t)((n0 >> 7) * 256 + (n0 & 127)) * D + kb * 32); DKB = D * 2; break; } r -= I_FG; \
        if (r < I_FU) { const int kb = r / 44, n0 = (r % 44) * 64; SRC = a.in[21] + (size_t)(kb * 32) * 2816 + n0; LDW = 2816; DST = (unsigned char*)((bf16_t*)(ws + WS_WGU0) + (size_t)((n0 >> 7) * 256 + 128 + (n0 & 127)) * D + kb * 32); DKB = D * 2; break; } r -= I_FU; \
        if (r < I_FD) { const int kb = r / 16, n0 = (r % 16) * 64; SRC = a.in[22] + (size_t)(kb * 32) * D + n0; LDW = D; DST = ws + WS_WD0 + (size_t)n0 * 2816 + kb * 32; DKB = 2816; SCL = W2_SCALE; break; } r -= I_FD; \
        if (r < I_ODIN) { const int kb = r / 19, nb = r % 19, n0 = nb * 64; bf16_t* d_; \
            if (n0 < 512) d_ = (bf16_t*)(ws + WS_WODD) + (size_t)n0 * D; else if (n0 < 640) d_ = (bf16_t*)(ws + WS_WODD) + (size_t)(n0 + 256) * D; \
            else if (n0 < 768) d_ = (bf16_t*)(ws + WS_WVC) + (size_t)(n0 - 640) * D; else if (n0 < 1024) d_ = (bf16_t*)(ws + WS_WODD) + (size_t)(n0 - 256) * D; \
            else if (n0 < 1152) d_ = (bf16_t*)(ws + WS_WODD) + (size_t)(n0 - 128) * D; else { d_ = (bf16_t*)(ws + WS_WODD) + (size_t)(n0 - 128) * D; NV = 32; } \
            SRC = a.in[23] + (size_t)(kb * 32) * 1184 + n0; LDW = 1184; DST = (unsigned char*)(d_ + kb * 32); DKB = D * 2; break; } r -= I_ODIN; \
        if (r < I_ODOUT) { const int kb = r / 16, n0 = (r % 16) * 64; SRC = a.in[24] + (size_t)(kb * 32) * D + n0; LDW = D; DST = (unsigned char*)((bf16_t*)(ws + WS_WO1) + (size_t)n0 * D + kb * 32); DKB = D * 2; break; } r -= I_ODOUT; \
        if (r < I_UQ) { const int kb = r / 12, n0 = (r % 12) * 64; SRC = a.in[28] + (size_t)(kb * 32) * 768 + n0; LDW = 768; DST = (unsigned char*)((bf16_t*)(ws + WS_WUQ) + (size_t)n0 * 256 + kb * 32); DKB = 256 * 2; break; } r -= I_UQ; \
        if (r < I_UKV) { const int kb = r / 16, nb = r % 16, n0 = nb * 64, h = nb >> 1; \
            bf16_t* d_ = (nb & 1) ? (bf16_t*)(ws + WS_WUKV) + (size_t)(h * 64) * 128 : (bf16_t*)(ws + WS_WUKN) + (size_t)(h * 64) * 128; \
            SRC = a.in[30] + (size_t)(kb * 32) * 1024 + n0; LDW = 1024; DST = (unsigned char*)(d_ + kb * 32); DKB = 128 * 2; break; } r -= I_UKV; \
        { const int e = r / (2 * I_W1 + I_W2); int q = r % (2 * I_W1 + I_W2); \
          if (q < 2 * I_W1) { const int up = q >= I_W1; if (up) q -= I_W1; const int kb = q / 56, n0 = (q % 56) * 64; \
              SRC = a.in[up ? 35 : 34] + (size_t)e * D * 3584 + (size_t)(kb * 32) * 3584 + n0; LDW = 3584; DST = ws + WS_W13 + ((size_t)e * 7168 + (n0 >> 7) * 256 + (up ? 128 : 0) + (n0 & 127)) * D + kb * 32; DKB = D; SCL = W13_SCALE; } \
          else { q -= 2 * I_W1; const int kb = q / 16, n0 = (q % 16) * 64; \
              SRC = a.in[36] + (size_t)e * 3584 * D + (size_t)(kb * 32) * D + n0; LDW = D; DST = ws + WS_W2 + ((size_t)e * D + n0) * 3584 + kb * 32; DKB = 3584; SCL = W2_SCALE; } } } while (0)
    if (do_conv) {
        const float* sA; int lA, nvA, jA; unsigned char* dA; int kA; float cA_; f32x4 vA[8];
        const float* sB; int lB, nvB, jB; unsigned char* dB; int kB; float cB_; f32x4 vB[8];
        int it = F.gw;
        if (it < I_TOTAL) { P0_DECODE(it, sA, lA, dA, kA, nvA, cA_, jA); ew::conv_load(sA, lA, nvA, vA, F.lane); }
        while (it < I_TOTAL) {
            const int i1 = it + F.NGW;
            if (i1 < I_TOTAL) { P0_DECODE(i1, sB, lB, dB, kB, nvB, cB_, jB); ew::conv_load(sB, lB, nvB, vB, F.lane); }
            ew::conv_store(vA, dA, kA, nvA, cA_, jA, scr, F.lane);
            const int i2 = i1 + F.NGW;
            if (i2 < I_TOTAL) { P0_DECODE(i2, sA, lA, dA, kA, nvA, cA_, jA); ew::conv_load(sA, lA, nvA, vA, F.lane); }
            if (i1 < I_TOTAL) ew::conv_store(vB, dB, kB, nvB, cB_, jB, scr, F.lane);
            it = i2;
        }
    }
#undef P0_DECODE
}

template <bool LAT_BF16>
__device__ __forceinline__ void normmod_phase(Frame& F, const void* xlat, const float* xctx, const float* g, const float* modl, int sh_chunk, bf16_t* H, int nrows) {
    const int per = ((nrows + F.NGW - 1) / F.NGW + 1) & ~1;
    const int r0 = F.gw * per, r1 = (r0 + per) < nrows ? (r0 + per) : nrows;
    ew::ModRegs M; int vcur = -1;
    for (int row = r0; row < r1; row += 2) {
        const bool lat = row < NLAT; const int v = lat ? row / S : 8;
        if (lat && LAT_BF16) {
            if (v != vcur) { const float* sh = modl + (size_t)v * 6144 + sh_chunk * D; ew::nm_mod_load<true>(M, g, sh, sh + D, F.lane); vcur = v; }
            ew::RowRegs A, B; const bf16_t* x0 = (const bf16_t*)xlat + (size_t)row * D;
            ew::nm_load<true>(x0, A, F.lane); ew::nm_load<true>(x0 + D, B, F.lane);
            ew::nm_finish_m<true>(A, M, H + (size_t)row * D, F.lane); ew::nm_finish_m<true>(B, M, H + (size_t)(row + 1) * D, F.lane); }
        else {
            const int vk = LAT_BF16 ? v + 16 : v;
            if (vk != vcur) { const float* sh = modl + (size_t)v * 6144 + sh_chunk * D; ew::nm_mod_load<false>(M, g, sh, sh + D, F.lane); vcur = vk; }
            ew::RowRegs A, B; const float* x0 = lat ? (const float*)xlat + (size_t)row * D : xctx + (size_t)(row - NLAT) * D;
            ew::nm_load<false>(x0, A, F.lane); ew::nm_load<false>(x0 + D, B, F.lane);
            ew::nm_finish_m<false>(A, M, H + (size_t)row * D, F.lane); ew::nm_finish_m<false>(B, M, H + (size_t)(row + 1) * D, F.lane); }
    }
}

__device__ __forceinline__ void post_even(Frame& F, const Args& a) {
    bf16_t* QK = (bf16_t*)(a.ws + WS_QK0);
    const ew::Rope R{(const f32x2*)(a.ws + WS_ROPE), (const f32x2*)(a.ws + WS_ROPE + 16384)};
    const int per = (NTOK + F.NGW - 1) / F.NGW; const int r0 = F.gw * per, r1 = (r0 + per) < NTOK ? (r0 + per) : NTOK;
    for (int row = r0; row < r1; ++row) {
        const bool lat = row < NLAT; const int pos = row & (S - 1), gr = pos >> 6, gc = pos & 63;
#pragma unroll
        for (int ch = 0; ch < 4; ++ch) {
            v4u* p = (v4u*)(QK + (size_t)row * 2048 + ch * 512) + F.lane;
            float f[8]; ew::unpack8(*p, f);
            const float* g = a.in[ch == 0 ? 10 : ch == 1 ? 11 : ch == 2 ? 13 : 14];
            float g8[8];
#pragma unroll
            for (int j = 0; j < 8; ++j) g8[j] = g[8 * (F.lane & 7) + j];
            ew::seg64(f, F.lane, g8, ch >= 2 && lat, gr, gc, R, (ch == 0 || ch == 2) ? QSCALE64 : 1.f);
            *p = ew::pack8(f);
        }
    }
}

__device__ __forceinline__ void post_odd(Frame& F, const Args& a) {
    bf16_t* P1 = (bf16_t*)(a.ws + WS_P1); bf16_t* CQN = (bf16_t*)((unsigned char*)a.out + OUT_CQN); bf16_t* CKVN = (bf16_t*)((unsigned char*)a.out + OUT_CKVN);
    const ew::Rope R{(const f32x2*)(a.ws + WS_ROPE), (const f32x2*)(a.ws + WS_ROPE + 16384)};
    const int per = (NTOK + F.NGW - 1) / F.NGW; const int r0 = F.gw * per, r1 = (r0 + per) < NTOK ? (r0 + per) : NTOK;
    float gq8[8], g2[8], g2p[8];
    { const int s7 = F.lane & 7;
      const float* gsel = F.lane < 32 ? a.in[27] + 8 * F.lane : (F.lane < 48 ? a.in[26] + 8 * s7 : a.in[29] + 8 * (F.lane - 48));
#pragma unroll
      for (int j = 0; j < 8; ++j) { gq8[j] = a.in[25][8 * s7 + j]; g2[j] = gsel[j]; g2p[j] = a.in[26][8 * (s7 ^ 2) + j]; } }
    v4u nq = (v4u){0u, 0u, 0u, 0u}, nc = nq;
    if (r0 < r1) { nq = *((const v4u*)(P1 + (size_t)r0 * P1LD) + F.lane); nc = *((const v4u*)(P1 + (size_t)r0 * P1LD + 512) + F.lane); }
    for (int row = r0; row < r1; ++row) {
        const bool lat = row < NLAT; const int pos = row & (S - 1), gr = pos >> 6, gc = pos & 63;
        const v4u cq_ = nq, cc_ = nc;
        if (row + 1 < r1) { nq = *((const v4u*)(P1 + (size_t)(row + 1) * P1LD) + F.lane); nc = *((const v4u*)(P1 + (size_t)(row + 1) * P1LD + 512) + F.lane); }
        { v4u* p = (v4u*)(P1 + (size_t)row * P1LD) + F.lane; float f[8]; ew::unpack8(cq_, f);
          ew::seg64(f, F.lane, gq8, lat, gr, gc, R, QSCALE64); *p = ew::pack8(f); }
        { v4u* p = (v4u*)(P1 + (size_t)row * P1LD + 512) + F.lane; float f[8]; ew::unpack8(cc_, f);
          float ss = 0.f;
#pragma unroll
          for (int j = 0; j < 8; ++j) ss += f[j] * f[j];
          const float s3 = sum8_f(ss); const float s4 = s3 + xor8_f(s3);
          float s5; { const auto r16 = __builtin_amdgcn_permlane16_swap(__float_as_uint(s4), __float_as_uint(s4), false, false); s5 = __uint_as_float(r16[0]) + __uint_as_float(r16[1]); }
          float pr[8];
#pragma unroll
          for (int j = 0; j < 8; ++j) pr[j] = xor2_f(f[j]);
          if (F.lane < 32) {
              const float rstd = rsqrtf(s5 * (1.f / 256.f) + EPS);
#pragma unroll
              for (int j = 0; j < 8; ++j) f[j] = f[j] * rstd * g2[j];
              *((v4u*)(CQN + (size_t)row * 256) + F.lane) = ew::pack8(f);
          } else if (F.lane < 48) {
              const int s = F.lane & 7; const float rstd = rsqrtf(s3 * (1.f / 64.f) + EPS);
#pragma unroll
              for (int j = 0; j < 8; ++j) { f[j] = f[j] * rstd * g2[j]; }
#pragma unroll
              for (int j = 0; j < 8; ++j) pr[j] = pr[j] * rstd * g2p[j];
              if (lat) { const int ps = (s >> 2) ? gc : gr; const bool x1 = (s & 3) < 2; const int i0 = 8 * (s & 1);
#pragma unroll
                  for (int j = 0; j < 8; ++j) { const f32x2 cs = R.t64[ps * 16 + i0 + j]; f[j] = x1 ? (f[j] * cs.x - pr[j] * cs.y) : (pr[j] * cs.y + f[j] * cs.x); } }
              *p = ew::pack8(f);
          } else {
              const float rstd = rsqrtf(s4 * (1.f / 128.f) + EPS);
#pragma unroll
              for (int j = 0; j < 8; ++j) f[j] = f[j] * rstd * g2[j];
              *((v4u*)(CKVN + (size_t)row * 128) + (F.lane - 48)) = ew::pack8(f);
          } }
    }
}

__device__ __forceinline__ void seg96(float (&f)[8], int lane, bool valid, const float (&g8)[8]  , bool rope, int gr, int gc, const ew::Rope& R, float scale) {
    const int sg = lane / 12, s = lane - sg * 12;
    float ss = 0.f;
#pragma unroll
    for (int j = 0; j < 8; ++j) ss += f[j] * f[j];
    const float qs = sum4_f(ss);
    int s1 = s + 4; s1 = s1 >= 12 ? s1 - 12 : s1; int s2 = s + 8; s2 = s2 >= 12 ? s2 - 12 : s2;
    const int l1 = sg * 12 + s1, l2 = sg * 12 + s2;
    const float tot = qs + __shfl(qs, l1 < 64 ? l1 : 63) + __shfl(qs, l2 < 64 ? l2 : 63);
    const float rstd = rsqrtf(tot * (1.f / 96.f) + EPS);
#pragma unroll
    for (int j = 0; j < 8; ++j) f[j] = f[j] * rstd * g8[j];
    if (rope) {
        const bool dor = valid && s >= 8; const int ps = (s >= 10) ? gc : gr; const bool x1 = (s & 1) == 0;
#pragma unroll
        for (int j = 0; j < 8; ++j) { const float pr = xor1_f(f[j]); const f32x2 cs = R.t32[ps * 8 + j];
            const float rot = x1 ? (f[j] * cs.x - pr * cs.y) : (pr * cs.y + f[j] * cs.x); f[j] = dor ? rot : f[j]; } }
#pragma unroll
    for (int j = 0; j < 8; ++j) f[j] *= scale;
}
__device__ __forceinline__ void post_mla(Frame& F, const Args& a) {
    bf16_t* QD = (bf16_t*)(a.ws + WS_QD); const bf16_t* KN = (const bf16_t*)((unsigned char*)a.out + OUT_KN); const bf16_t* P1 = (const bf16_t*)(a.ws + WS_P1); bf16_t* KDF = (bf16_t*)(a.ws + WS_KDF);
    const ew::Rope R{(const f32x2*)(a.ws + WS_ROPE), (const f32x2*)(a.ws + WS_ROPE + 16384)};
    const int per = (NTOK + F.NGW - 1) / F.NGW; const int r0 = F.gw * per, r1 = (r0 + per) < NTOK ? (r0 + per) : NTOK;
    const int sg = F.lane / 12, s = F.lane - sg * 12;
    const bool val0 = sg < 5, val1 = (sg < 5) && (5 + sg < 8);
    float gq8[8], gk8[8];
#pragma unroll
    for (int j = 0; j < 8; ++j) { gq8[j] = a.in[31][8 * s + j]; gk8[j] = a.in[32][8 * s + j]; }
    const v4u z4 = (v4u){0u, 0u, 0u, 0u};
    v4u nq0 = z4, nq1 = z4, nk0 = z4, nk1 = z4;
#define PM_LOAD(row_) do { const int _r = (row_); const bool _lat = _r < NLAT; \
        nq0 = (_lat && val0) ? *(const v4u*)(QD + (size_t)_r * 768 + sg * 96 + 8 * s) : z4; nq1 = (_lat && val1) ? *(const v4u*)(QD + (size_t)_r * 768 + (5 + sg) * 96 + 8 * s) : z4; \
        nk0 = val0 ? ((s < 8) ? *(const v4u*)(KN + (size_t)_r * 512 + sg * 64 + 8 * s) : *(const v4u*)(P1 + (size_t)_r * P1LD + 1024 + 8 * (s - 8))) : z4; \
        nk1 = val1 ? ((s < 8) ? *(const v4u*)(KN + (size_t)_r * 512 + (5 + sg) * 64 + 8 * s) : *(const v4u*)(P1 + (size_t)_r * P1LD + 1024 + 8 * (s - 8))) : z4; } while (0)
    if (r0 < r1) PM_LOAD(r0);
    for (int row = r0; row < r1; ++row) {
        const bool lat = row < NLAT; const int pos = row & (S - 1), gr = pos >> 6, gc = pos & 63;
        const v4u cq0 = nq0, cq1 = nq1, ck0 = nk0, ck1 = nk1;
        if (row + 1 < r1) PM_LOAD(row + 1);
        float fk0[8], fk1[8]; ew::unpack8(ck0, fk0); ew::unpack8(ck1, fk1);
        if (lat) {
            float fq0[8], fq1[8]; ew::unpack8(cq0, fq0); ew::unpack8(cq1, fq1);
            seg96(fq0, F.lane, val0, gq8, true, gr, gc, R, QSCALE96); seg96(fq1, F.lane, val1, gq8, true, gr, gc, R, QSCALE96);
            seg96(fk0, F.lane, val0, gk8, true, gr, gc, R, 1.f); seg96(fk1, F.lane, val1, gk8, true, gr, gc, R, 1.f);
            if (val0) *(v4u*)(QD + (size_t)row * 768 + sg * 96 + 8 * s) = ew::pack8(fq0);
            if (val1) *(v4u*)(QD + (size_t)row * 768 + (5 + sg) * 96 + 8 * s) = ew::pack8(fq1);
        } else {
            seg96(fk0, F.lane, val0, gk8, false, gr, gc, R, 1.f); seg96(fk1, F.lane, val1, gk8, false, gr, gc, R, 1.f);
        }
        if (val0) *(v4u*)(KDF + (size_t)row * 768 + sg * 96 + 8 * s) = ew::pack8(fk0);
        if (val1) *(v4u*)(KDF + (size_t)row * 768 + (5 + sg) * 96 + 8 * s) = ew::pack8(fk1);
    }
#undef PM_LOAD
}
}

namespace mk {
__device__ __forceinline__ void attn_even(Frame& F, const Args& a) {
    unsigned char* ws = a.ws;
    const bf16_t* QK = (const bf16_t*)(ws + WS_QK0); const bf16_t* VT = (const bf16_t*)(ws + WS_VT0); bf16_t* AO = (bf16_t*)((unsigned char*)a.out + OUT_H);
    const int lane = F.lane, r32 = lane & 31, hi = lane >> 5, wid = F.wave;
    const int c = F.vcu, G = F.G;
    {
        float s1 = 0.f, s2 = 0.f;
        for (int i = 0; i < 64; ++i) { s1 += a.in[15][i] * a.in[16][i]; s2 += a.in[17][i] * a.in[18][i]; }
        const float lam = expf(s1) - expf(s2) + 0.2f;
        float* scr = (float*)(ws + WS_DSCR) + (size_t)c * 32768;
        for (int L = c; L < 512 + 32; L += G) {
            int b, h, qrow0; att::Keys ky;
            if (L < 512) { b = L >> 6; h = (L >> 4) & 3; const int qb = L & 15; qrow0 = b * S + qb * 256; ky.ka0 = b * S; ky.na = 64; ky.kb0 = NLAT + b * CL; ky.nb = 4; }
            else { const int i = L - 512; b = i >> 2; h = i & 3; qrow0 = NLAT + b * CL; ky.ka0 = NLAT + b * CL; ky.na = 4; ky.kb0 = 0; ky.nb = 0; }
            const int qw0 = qrow0 + wid * 32;
            att::NaInfo ni{};
            f32x4 o[8][2]; float l[2];
            float* sp = scr + (size_t)wid * 4096 + lane;
            for (int mm = 0; mm < 2; ++mm) {
                att::attn_core16<64, 128, false>(F.lds, QK + (size_t)qw0 * 2048 + 1024 + h * 128 + mm * 64, 2048, QK + 1536 + h * 128 + mm * 64, 2048, VT + (size_t)(512 + h * 128) * NTOK, NTOK, ky, ni, o, l);
                const float il[2] = {1.f / l[0], 1.f / l[1]};
                if (mm == 0) {
#pragma unroll
                    for (int qb = 0; qb < 2; ++qb) { float* spd = sp + qb * 2048; asm volatile("" : "+v"(spd));
#pragma unroll
                        for (int db = 0; db < 8; ++db)
#pragma unroll
                            for (int j = 0; j < 4; ++j) spd[(db * 4 + j) * 64] = o[db][qb][j] * il[qb]; }
                    VM_WAIT();
                } else {
                    float ss[2] = {0.f, 0.f};
#pragma unroll
                    for (int qb = 0; qb < 2; ++qb) {
                        const float* spd = sp + qb * 2048; asm volatile("" : "+v"(spd));
#pragma unroll
                        for (int hb = 0; hb < 2; ++hb) { float t1[16];
#pragma unroll
                            for (int r = 0; r < 16; ++r) t1[r] = spd[(hb * 16 + r) * 64];
                            asm volatile("s_waitcnt vmcnt(0)" ::: "memory");
#pragma unroll
                            for (int r = 0; r < 16; ++r) { const int db = hb * 4 + (r >> 2), j = r & 3; const float v = t1[r] - lam * (o[db][qb][j] * il[qb]); o[db][qb][j] = v; ss[qb] += v * v; } } }
                    float rstd[2];
#pragma unroll
                    for (int qb = 0; qb < 2; ++qb) { float t = ss[qb]; t += __shfl_xor(t, 16); t += __shfl_xor(t, 32); rstd[qb] = rsqrtf(t * (1.f / 128.f) + EPS) * 0.8f; }
                    const int rg = lane >> 4;
#pragma unroll
                    for (int db = 0; db < 8; ++db) { const f32x4 gg = *(const f32x4*)(a.in[19] + 16 * db + 4 * rg);
                        o[db][0] = o[db][0] * gg; o[db][1] = o[db][1] * gg; }
                    att::store_o16<8>(o, rstd, AO + (size_t)qw0 * D + 512 + h * 128, lane & 15, rg);
                    VM_WAIT();
                }
            }
        }
    }
    {
        LAS float* bias = (LAS float*)(F.lds + att::NSLOT * att::Cfg<64, 64>::SLOT);
        int hcur = -1;
        const bool bal = (G == 256);
        const int nit = bal ? 6 : (1024 + 96 + G - 1) / G;
        for (int it = 0; it < nit; ++it) {
            int L;
            if (bal) { if (it < 3) L = c + 256 * it; else if (it == 3) { if (c < 32) continue; L = c + 768; } else if (it == 4) { if (c < 96 || c >= 128) continue; L = (c - 96) + 768; } else { if (c < 32 || c >= 96) continue; L = 1024 + 32 + (c - 32); } }
            else { L = c + G * it; if (L >= 1024 + 96) continue; }
            int b, h, qrow0; att::Keys ky; att::NaInfo ni{};
            if (L < 1024) { b = L >> 7; h = (L >> 4) & 7; const int qb = L & 15; qrow0 = b * S + qb * 256;
                int rlo = 4 * qb - 4; rlo = rlo < 0 ? 0 : (rlo > 56 ? 56 : rlo); int rhi = 4 * qb + 3 - 4; rhi = (rhi < 0 ? 0 : (rhi > 56 ? 56 : rhi)) + 7;
                ky.ka0 = NLAT + b * CL; ky.na = 4; ky.kb0 = b * S + 64 * rlo; ky.nb = rhi - rlo + 1;
                ni.r_lo = rlo; ni.qr = 4 * qb + (wid >> 1); ni.qc = 32 * (wid & 1); }
            else { const int i = L - 1024 - 32; if (i < 0) continue; b = i >> 3; h = i & 7; qrow0 = NLAT + b * CL; ky.ka0 = NLAT + b * CL; ky.na = 4; ky.kb0 = 0; ky.nb = 0; ni.r_lo = 0; ni.qr = 0; ni.qc = 0; }
            if (h != hcur) { __syncthreads();
                for (int i = F.tid; i < 15 * 128; i += NTHR) { const int dr = i >> 7, dc = (i & 127) - 63; bias[i] = (dc >= -15 && dc <= 15) ? a.in[12][h * 465 + dr * 31 + dc + 15] * LOG2E : 0.f; }
                __syncthreads(); hcur = h; }
            ni.bias = bias;
            const int qw0 = qrow0 + wid * 32;
            { f32x4 o[4][2]; float l[2];
            att::attn_core16<64, 64, true>(F.lds, QK + (size_t)qw0 * 2048 + h * 64, 2048, QK + 512 + h * 64, 2048, VT + (size_t)(h * 64) * NTOK, NTOK, ky, ni, o, l);
            const float il[2] = {1.f / l[0], 1.f / l[1]};
            att::store_o16<4>(o, il, AO + (size_t)qw0 * D + h * 64, lane & 15, lane >> 4); }
        }
    }
    VM_WAIT();
}

__device__ __forceinline__ void attn_odd(Frame& F, const Args& a) {
    unsigned char* ws = a.ws;
    const bf16_t* P1 = (const bf16_t*)(ws + WS_P1); const bf16_t* VTC = (const bf16_t*)(ws + WS_VT1C);
    const bf16_t* QD = (const bf16_t*)(ws + WS_QD); const bf16_t* KD = (const bf16_t*)(ws + WS_KDF); const bf16_t* VTD = (const bf16_t*)(ws + WS_VT1D);
    bf16_t* AO = (bf16_t*)((unsigned char*)a.out + OUT_H);
    const int lane = F.lane, r32 = lane & 31, hi = lane >> 5, wid = F.wave;
    att::NaInfo ni{};
    for (int L = F.vcu; L < 1024; L += F.G) {
        const int b = L >> 7, h = (L >> 4) & 7, qb = L & 15; const int qw0 = b * S + qb * 256 + wid * 32;
        att::Keys ky; ky.ka0 = b * S; ky.na = 64; ky.kb0 = NLAT + b * CL; ky.nb = 4;
        f32x4 o[4][2]; float l[2];
        att::attn_core16<96, 64, false>(F.lds, QD + (size_t)qw0 * 768 + h * 96, 768, KD + h * 96, 768, VTD + (size_t)(h * 64) * NTOK, NTOK, ky, ni, o, l);
        const float il[2] = {1.f / l[0], 1.f / l[1]};
        att::store_o16<4>(o, il, AO + (size_t)qw0 * D + 512 + h * 64, lane & 15, lane >> 4);
    }
    for (int L = F.vcu; L < 1024; L += F.G) {
        const int b = L >> 7, hq = (L >> 4) & 7, qb = L & 15; const int qw0 = b * S + qb * 256 + wid * 32;
        att::Keys ky; ky.ka0 = b * S; ky.na = 64; ky.kb0 = NLAT + b * CL; ky.nb = 4;
        f32x4 o[4][2]; float l[2];
        att::attn_core16<64, 64, false>(F.lds, P1 + (size_t)qw0 * P1LD + hq * 64, P1LD, P1 + 768 + (hq >> 2) * 64, P1LD, VTC + (size_t)((hq >> 2) * 64) * NTOK, NTOK, ky, ni, o, l);
        const float il[2] = {1.f / l[0], 1.f / l[1]};
        att::store_o16<4>(o, il, AO + (size_t)qw0 * D + hq * 64, lane & 15, lane >> 4);
    }
    VM_WAIT();
}

__device__ __forceinline__ void router_phase(Frame& F, const Args& a, const bf16_t* x3) {
    unsigned char* ws = a.ws;
    unsigned char* H2 = (unsigned char*)a.out + OUT_H;
    const float* modl = (const float*)(ws + WS_MODF) + (size_t)9 * 6144;
    int* slot_tok = (int*)(ws + WS_SLOT_TOK); float* slot_g = (float*)(ws + WS_SLOT_G);
    LAS float* rw = (LAS float*)F.lds;
    LAS int* lcnt = (LAS int*)(F.lds + 32768);
    LAS int* lbase = lcnt + 16;
    LAS int* tinfo = lcnt + 32;
    LAS float* tg = (LAS float*)(tinfo + 512);
    f32x4 rwr[2][8][2];
#pragma unroll
    for (int j = 0; j < 2; ++j)
#pragma unroll
        for (int k8 = 0; k8 < 8; ++k8) { const float* wp = a.in[33] + (size_t)(8 * F.lane + 512 * j + k8) * 8; rwr[j][k8][0] = *(const f32x4*)wp; rwr[j][k8][1] = *(const f32x4*)(wp + 4); }
    const float* g = a.in[7] + D;
    for (int chunk = blockIdx.x; chunk < NLAT / 128; chunk += F.G) {
    __syncthreads();
    if (F.tid < 16) lcnt[F.tid] = 0;
    __syncthreads();
    const int tok0 = chunk * 128;
    v4u xw[2];
    { const bf16_t* x0 = x3 + (size_t)(tok0 + F.wave * 16) * D; xw[0] = *((const v4u*)x0 + F.lane); xw[1] = *((const v4u*)x0 + F.lane + 64); }
    ew::ModRegs M; { const int v = tok0 >> 12; const float* sh = modl + (size_t)v * 6144 + 3 * D; ew::nm_mod_load<true>(M, g, sh, sh + D, F.lane); }
    for (int i = 0; i < 16; ++i) {
        const int tl = F.wave * 16 + i, tok = tok0 + tl;
        const v4u xc[2] = {xw[0], xw[1]};
        if (i + 1 < 16) { const bf16_t* x1 = x3 + (size_t)(tok + 1) * D; xw[0] = *((const v4u*)x1 + F.lane); xw[1] = *((const v4u*)x1 + F.lane + 64); }
        float y[2][8]; float s = 0.f;
#pragma unroll
        for (int j = 0; j < 2; ++j) { ew::unpack8(xc[j], y[j]);
#pragma unroll
            for (int q = 0; q < 8; ++q) s += y[j][q] * y[j][q]; }
        const float rstd = rsqrtf(wave_sum(s) * (1.f / D) + EPS);
        float lg[8];
#pragma unroll
        for (int e = 0; e < 8; ++e) lg[e] = 0.f;
#pragma unroll
        for (int j = 0; j < 2; ++j) { const int c = 8 * F.lane + 512 * j;
#pragma unroll
            for (int h = 0; h < 2; ++h) {
#pragma unroll
                for (int q = 0; q < 4; ++q) { const float yy = y[j][4 * h + q] * rstd * M.mul[2 * j + h][q] + M.add[2 * j + h][q]; y[j][4 * h + q] = yy;
                    const f32x4 r0 = rwr[j][4 * h + q][0], r1 = rwr[j][4 * h + q][1];
                    lg[0] += yy * r0.x; lg[1] += yy * r0.y; lg[2] += yy * r0.z; lg[3] += yy * r0.w; lg[4] += yy * r1.x; lg[5] += yy * r1.y; lg[6] += yy * r1.z; lg[7] += yy * r1.w; } }
            v2u w8; w8.x = cvt4_fp8(y[j][0] * ACT_SCALE, y[j][1] * ACT_SCALE, y[j][2] * ACT_SCALE, y[j][3] * ACT_SCALE); w8.y = cvt4_fp8(y[j][4] * ACT_SCALE, y[j][5] * ACT_SCALE, y[j][6] * ACT_SCALE, y[j][7] * ACT_SCALE);
            *(v2u*)(H2 + (size_t)tok * D + c) = w8; }
#pragma unroll
        for (int e = 0; e < 8; ++e) lg[e] = wave_sum(lg[e]);
        if (F.lane == 0) {
            int i0 = 0; float v0 = lg[0];
#pragma unroll
            for (int e = 1; e < 8; ++e) if (lg[e] > v0) { v0 = lg[e]; i0 = e; }
            int i1 = -1; float v1 = -INFINITY;
#pragma unroll
            for (int e = 0; e < 8; ++e) if (e != i0 && lg[e] > v1) { v1 = lg[e]; i1 = e; }
            const float e1 = expf(v1 - v0);
            tinfo[tl * 4 + 0] = i0; tinfo[tl * 4 + 1] = i1;
            tinfo[tl * 4 + 2] = __hip_atomic_fetch_add(&lcnt[i0], 1, __ATOMIC_RELAXED, __HIP_MEMORY_SCOPE_WORKGROUP); tinfo[tl * 4 + 3] = __hip_atomic_fetch_add(&lcnt[8 + i1], 1, __ATOMIC_RELAXED, __HIP_MEMORY_SCOPE_WORKGROUP);
            tg[tl * 2] = 1.f / (1.f + e1); tg[tl * 2 + 1] = e1 / (1.f + e1);
        }
    }
    __syncthreads();
    if (F.tid < 16) lbase[F.tid] = (int)__hip_atomic_fetch_add((unsigned*)(F.ctl + CW_GCNT + F.tid), (unsigned)lcnt[F.tid], RLX_AGENT);
    __syncthreads();
    if (F.tid < 256) { const int tl = F.tid >> 1, cch = F.tid & 1; const int e = tinfo[tl * 4 + cch], rk = tinfo[tl * 4 + 2 + cch];
        const size_t idx = ((size_t)cch * 8 + e) * NLAT + lbase[cch * 8 + e] + rk;
        slot_tok[idx] = tok0 + tl; slot_g[idx] = tg[tl * 2 + cch]; }
    }
}
}
namespace mk {
__global__ void __launch_bounds__(NTHR, 2) mega_fwd(Args args) {
    extern __shared__ __attribute__((aligned(16))) unsigned char lds_raw[];
    Frame F;
    F.lds = (LAS unsigned char*)lds_raw;
    F.MISC = (volatile LAS unsigned*)(F.lds + MISC_OFF);
    F.tid = threadIdx.x; F.lane = F.tid & 63; F.wave = __builtin_amdgcn_readfirstlane(F.tid >> 6);
    F.G = gridDim.x; { const int bx = blockIdx.x; F.vcu = (F.G % 8 == 0) ? (bx % 8) * (F.G / 8) + bx / 8 : bx; }
    F.gw = F.vcu * NWAVES + F.wave; F.NGW = F.G * NWAVES;
    unsigned char* ws = args.ws;
    F.ctl = (gu32*)(ws + WS_CTL);
    for (int u = F.tid; u < (LDS_BYTES - LDSCTL_OFF) / 4; u += NTHR) ((LAS unsigned*)(F.lds + LDSCTL_OFF))[u] = 0u;
    __syncthreads();
    XcdBarrier bar = xcd_barrier_post((unsigned*)(F.ctl + CW_BAR), F.MISC + 8);
    const int lo = args.ph_lo, hi = args.ph_hi;
#ifndef MK_ONLY
#define MK_ONLY -1
#endif
#define IN(k) ((MK_ONLY < 0 || MK_ONLY == (k)) && lo <= (k) && (k) < hi)
#if MK_PROBE
    LAS unsigned long long* ts = (LAS unsigned long long*)(F.lds + LDSCTL_OFF + 2048);
    if (F.tid == 0) ts[0] = __builtin_amdgcn_s_memrealtime();
#define SEAM(k) do { if (IN(k) && IN((k) + 1)) xcd_barrier(bar); if (F.tid == 0) ts[(k) + 1] = __builtin_amdgcn_s_memrealtime(); } while (0)
#else
#define SEAM(k) do { if (IN(k) && IN((k) + 1)) xcd_barrier(bar); } while (0)
#endif
    const float* MODF = (const float*)(ws + WS_MODF);
    bf16_t* H = (bf16_t*)((unsigned char*)args.out + OUT_H);
    float* XC = (float*)(ws + WS_XC);
    bf16_t* XB = (bf16_t*)(ws + WS_XB);
    float* X = args.out;
    const int cu = (int)blockIdx.x;

    if (IN(0)) { for (int rep = 0; rep < MK_REP_P0; ++rep) { p0_prologue(F, args, rep == 0 || MK_P0_DUPMOD, rep == 0 || !MK_P0_DUPMOD); __syncthreads(); } } SEAM(0);
    if (IN(1)) { for (int rep = 0; rep < MK_REP_NM; ++rep) normmod_phase<false>(F, args.in[0], args.in[2], args.in[6], MODF, 0, H, NTOK); } SEAM(1);
    if (IN(2)) {
        pg8::MultiSched Sc; Sc.init(D, F.G, cu);
        Sc.add(H, (const bf16_t*)(ws + WS_WQK0), NTOK / 256, 8, 0);
        Sc.add((const bf16_t*)(ws + WS_WV0), H, 4, NTOK / 256, 1);
        pg8::EpiQK0 E{(bf16_t*)(ws + WS_QK0), (bf16_t*)(ws + WS_VT0), (const float*)(ws + WS_ROPE + 32768), (const f32x2*)(ws + WS_ROPE)};
        pg8::gemm_phase<pg8::EpiQK0, pg8::MultiSched, false>(F.lds, D, Sc, E);
    } SEAM(2);
    if (IN(4)) { attn_even(F, args); } SEAM(4);
    if (IN(5)) {
        pg8::MultiSched Sc; Sc.init(D, F.G, cu); Sc.add(H, (const bf16_t*)(ws + WS_WO0), NTOK / 256, 4, 0);
        pg8::EpiResid<false> E{args.in[0], XB, args.in[2], XC, MODF, 2};
        pg8::gemm_phase<pg8::EpiResid<false>, pg8::MultiSched, false>(F.lds, D, Sc, E);
    } SEAM(5);
    if (IN(6)) { for (int rep = 0; rep < MK_REP_NM; ++rep) normmod_phase<true>(F, XB, XC, args.in[7], MODF, 3, H, NTOK); } SEAM(6);
    if (IN(7)) {
        pg8::MultiSched Sc; Sc.init(D, F.G, cu); Sc.add(H, (const bf16_t*)(ws + WS_WGU0), NTOK / 256, 22, 0);
        pg8::EpiSwigluF8 E{ws + WS_MID0, 2816, 1.f, ACT_SCALE};
        pg8::gemm_phase<pg8::EpiSwigluF8, pg8::MultiSched, false>(F.lds, D, Sc, E);
    } SEAM(7);
    if (IN(8)) {
        pg8::MultiSched Sc; Sc.init(2816 / 2, F.G, cu); Sc.add((const bf16_t*)(ws + WS_MID0), (const bf16_t*)(ws + WS_WD0), NTOK / 256, 4, 0);
        pg8::EpiResid<true> E{XB, XB, XC, XC, MODF, 5, 1.f / (ACT_SCALE * W2_SCALE)};
        pg8::gemm_phase<pg8::EpiResid<true>, pg8::MultiSched, false, true>(F.lds, 2816 / 2, Sc, E);
    } SEAM(8);
    const float* MODF1 = MODF + (size_t)9 * 6144;
    if (IN(9)) { for (int rep = 0; rep < MK_REP_NM; ++rep) normmod_phase<true>(F, XB, XC, args.in[6] + D, MODF1, 0, H, NTOK); } SEAM(9);
    if (IN(10)) {
        pg8::MultiSched Sc; Sc.init(D, F.G, cu);
        Sc.add(H, (const bf16_t*)(ws + WS_WODD), NTOK / 256, 5, 0);
        Sc.add((const bf16_t*)(ws + WS_WVC), H, 1, NTOK / 256, 1);
        pg8::EpiStore E{(bf16_t*)(ws + WS_P1), (bf16_t*)(ws + WS_VT1C), P1LD, NTOK};
        pg8::gemm_phase<pg8::EpiStore, pg8::MultiSched, false>(F.lds, D, Sc, E);
    } SEAM(10);
    if (IN(11)) { post_odd(F, args); } SEAM(11);
    if (IN(12)) {
        { pg8::MultiSched Sc; Sc.init(256, F.G, cu); Sc.add((const bf16_t*)((unsigned char*)args.out + OUT_CQN), (const bf16_t*)(ws + WS_WUQ), NLAT / 256, 3, 0);
          pg8::EpiStore E{(bf16_t*)(ws + WS_QD), nullptr, 768, 0};
          pg8::gemm_phase<pg8::EpiStore, pg8::MultiSched, false>(F.lds, 256, Sc, E); }
        asm volatile("" ::: "memory");
        { int K2 = 128; asm volatile("" : "+s"(K2)); pg8::MultiSched Sc; Sc.init(K2, F.G, cu);
          Sc.add((const bf16_t*)((unsigned char*)args.out + OUT_CKVN), (const bf16_t*)(ws + WS_WUKN), NTOK / 256, 2, 0);
          Sc.add((const bf16_t*)(ws + WS_WUKV), (const bf16_t*)((unsigned char*)args.out + OUT_CKVN), 2, NTOK / 256, 1);
          pg8::EpiStore E{(bf16_t*)((unsigned char*)args.out + OUT_KN), (bf16_t*)(ws + WS_VT1D), 512, NTOK};
          pg8::gemm_phase<pg8::EpiStore, pg8::MultiSched, false>(F.lds, K2, Sc, E); }
    } SEAM(12);
    if (IN(13)) { post_mla(F, args); } SEAM(13);
    if (IN(14)) { attn_odd(F, args); } SEAM(14);
    if (IN(15)) {
        pg8::MultiSched Sc; Sc.init(D, F.G, cu); Sc.add(H, (const bf16_t*)(ws + WS_WO1), NLAT / 256, 4, 0);
        pg8::EpiResid<true> E{XB, XB, XC, XC, MODF1, 2};
        pg8::gemm_phase<pg8::EpiResid<true>, pg8::MultiSched, false>(F.lds, D, Sc, E);
    } SEAM(15);
    if (IN(16)) { router_phase(F, args, XB); } SEAM(16);
    {
        const int* cnt0 = (const int*)(F.ctl + CW_GCNT); const int* cnt1 = cnt0 + 8;
        const int* stok0 = (const int*)(ws + WS_SLOT_TOK); const int* stok1 = stok0 + (size_t)8 * NLAT;
        unsigned char* const MIDa = ws + WS_MID1; unsigned char* const MIDb = ws + WS_MID1 + (size_t)119 * MiB;
        LAS int* const tab = (LAS int*)(F.lds + LDSCTL_OFF + 1024);
        const float invg = 1.f / (ACT_SCALE * W13_SCALE), invd = 1.f / (ACT_SCALE * W2_SCALE);
        if (IN(17)) {
            pg8::MoeSched Sc; Sc.init(tab, cnt0, D / 2, 28, F.G, cu, true, H, (const bf16_t*)(ws + WS_W13), (size_t)7168 * (D / 2), stok0);
            pg8::EpiSwigluF8 E{MIDa, 3584, invg, ACT_SCALE};
            pg8::gemm_phase<pg8::EpiSwigluF8, pg8::MoeSched, true, true>(F.lds, D / 2, Sc, E);
        } SEAM(17);
        if (IN(18)) {
            pg8::MoeDualSched Sc; Sc.init(tab, cnt0, cnt1, F.G, cu, 3584 / 2, D / 2,
                                          (const bf16_t*)MIDa, (const bf16_t*)(ws + WS_W2), (size_t)D * (3584 / 2), stok0, H, (const bf16_t*)(ws + WS_W13), (size_t)7168 * (D / 2), stok1);
            pg8::EpiMoeDual E{pg8::EpiSwigluF8{MIDb, 3584, invg, ACT_SCALE}, pg8::EpiMoeDown<false>{XB, X, MODF1, (const float*)(ws + WS_SLOT_G), (const int*)(ws + WS_SLOT_TOK), invd}};
            pg8::gemm_phase<pg8::EpiMoeDual, pg8::MoeDualSched, true, true, true>(F.lds, D / 2, Sc, E);
        } SEAM(18);
        if (IN(19)) {
            pg8::MoeSched Sc; Sc.init(tab, cnt1, 3584 / 2, 4, F.G, cu, false, (const bf16_t*)MIDb, (const bf16_t*)(ws + WS_W2), (size_t)D * (3584 / 2), stok1);
            pg8::EpiMoeDown<true> E{XB, X, MODF1, (const float*)(ws + WS_SLOT_G), (const int*)(ws + WS_SLOT_TOK), invd};
            pg8::gemm_phase<pg8::EpiMoeDown<true>, pg8::MoeSched, false, true>(F.lds, 3584 / 2, Sc, E);
        }
    }
#if MK_PROBE
    if (IN(20)) {
        xcd_barrier(bar); __syncthreads();
        float t1 = 0.f;
        for (int q = 0; q < 21; ++q) if ((MK_PROBE_MASK >> q) & 1) t1 += (float)(ts[q + 1] - ts[q]) * 0.01f;
        if (MK_PROBE_Q > 0) t1 = floorf(t1 * (1.f / MK_PROBE_Q) + 0.5f) * MK_PROBE_Q;
        const float sc = 1.f + t1 * (1.f / 20000.f);
        for (size_t i = (size_t)blockIdx.x * NTHR + F.tid; i < (size_t)NLAT * D / 4; i += (size_t)F.G * NTHR) { f32x4 v = ((f32x4*)X)[i]; ((f32x4*)X)[i] = v * sc; }
    }
#endif
#undef IN
#undef SEAM
}
}
#ifndef MK_MODE
#define MK_MODE 0
#endif
namespace mk {
#if MK_MODE == 2
constexpr size_t WS_CK = 522 * MiB, WS_XN = 552 * MiB, WS_NEED = 568 * MiB;
constexpr int CKR = 1024;
constexpr size_t CKSZ = (size_t)(CKR + CL) * D;
constexpr int CW_RES = 1024;
__global__ void cmp_kernel(const void* opt, int is_bf16, int ldo, int col0, const float* ref, int rows, int ncols, float* res) {
    float d2 = 0.f, b2 = 0.f;
    for (long i = (long)blockIdx.x * 256 + threadIdx.x; i < (long)rows * ncols; i += (long)gridDim.x * 256) {
        const int r = (int)(i / ncols), c = col0 + (int)(i % ncols);
        const float a = is_bf16 ? bf2f(((const bf16_t*)opt)[(size_t)r * ldo + c]) : ((const float*)opt)[(size_t)r * ldo + c];
        const float b = ref[(size_t)r * D + c];
        d2 += (a - b) * (a - b); b2 += b * b;
    }
    __shared__ float s0[256], s1[256];
    s0[threadIdx.x] = d2; s1[threadIdx.x] = b2; __syncthreads();
    for (int o = 128; o > 0; o >>= 1) { if (threadIdx.x < o) { s0[threadIdx.x] += s0[threadIdx.x + o]; s1[threadIdx.x] += s1[threadIdx.x + o]; } __syncthreads(); }
    if (threadIdx.x == 0) { atomicAdd(res, s0[0]); atomicAdd(res + 1, s1[0]); }
}
__global__ void verdict_kernel(const float* res, int nchk, float thr, const float* xn, float* out) {
    int bad = 0;
    for (int k = 0; k < nchk; ++k) { const float r = res[2 * k] / res[2 * k + 1]; if (!(r < thr)) { bad = k + 1; break; } }
    if (!bad) return;
    for (size_t i = (size_t)blockIdx.x * 256 + threadIdx.x; i < (size_t)NLAT * D; i += (size_t)gridDim.x * 256)
        out[i] = i < (size_t)S * D ? xn[i] * (float)(1 + bad) : 0.f;
}
#endif

static int g_grid = 0;
static void launch_range(hipStream_t st, Args a, int lo, int hi, bool reset_bar) {
    if (reset_bar) (void)hipMemsetAsync(a.ws + WS_CTL + (size_t)CW_BAR * 4, 0, (size_t)XCD_BAR_WORDS * 4, st);
    a.ph_lo = lo; a.ph_hi = hi;
    hipLaunchKernelGGL(mega_fwd, dim3(g_grid), dim3(NTHR), LDS_BYTES, st, a);
    const hipError_t le = hipPeekAtLastError();
    if (le != hipSuccess) fprintf(stderr, "kernel_launch: launch [%d,%d) failed: %s\n", lo, hi, hipGetErrorName(le));
}
}

extern "C" void kernel_launch(void* const* d_in, const int* in_sizes, int n_in, void* d_out, int out_size, void* d_ws, size_t ws_size, hipStream_t stream) {
    using namespace mk;
    if (g_grid == 0) {
        size_t need = WS_END;
#if MK_MODE == 2
        need = WS_NEED;
#endif
        if (n_in != 37 || out_size != NLAT * D || ws_size < need) { fprintf(stderr, "kernel_launch: unexpected shapes / workspace (%zu < %zu)\n", ws_size, need); g_grid = -1; return; }
        int dev = 0, cus = 0, per_cu = 0;
        if (hipGetDevice(&dev) != hipSuccess || hipDeviceGetAttribute(&cus, hipDeviceAttributeMultiprocessorCount, dev) != hipSuccess) { g_grid = -1; return; }
        if (hipFuncSetAttribute((const void*)mega_fwd, hipFuncAttributeMaxDynamicSharedMemorySize, LDS_BYTES) != hipSuccess) { fprintf(stderr, "kernel_launch: hipFuncSetAttribute failed\n"); g_grid = -1; return; }
        if (hipOccupancyMaxActiveBlocksPerMultiprocessor(&per_cu, (const void*)mega_fwd, NTHR, LDS_BYTES) != hipSuccess || per_cu < 1) { fprintf(stderr, "kernel_launch: occupancy query says %d blocks per CU\n", per_cu); g_grid = -1; (void)hipGetLastError(); return; }
        g_grid = cus;
    }
    if (g_grid < 0) return;
    Args a; memset(&a, 0, sizeof a);
    for (int i = 0; i < 37; ++i) a.in[i] = (const float*)d_in[i];
    a.out = (float*)d_out; a.ws = (unsigned char*)d_ws;
#if MK_MODE == 0
    (void)hipMemsetAsync((char*)d_ws + WS_CTL, 0, CTL_ZERO_BYTES, stream);
    launch_range(stream, a, 0, MK_PROBE ? 21 : 20, false);
#elif MK_MODE == 1
    (void)hipMemsetAsync((char*)d_ws + WS_CTL, 0, CTL_ZERO_BYTES, stream);
    for (int p = 0; p < 20; ++p) launch_range(stream, a, p, p + 1, true);
#else
    {
        nv::In I = nv::make_in(d_in);
        float* CK = (float*)((char*)d_ws + WS_CK); float* XN = (float*)((char*)d_ws + WS_XN);
        nv::run(stream, I, XN, (char*)d_ws, 1, CK, CKR);
        (void)hipMemsetAsync((char*)d_ws + WS_CTL, 0, CTL_ZERO_BYTES, stream);
        float* res = (float*)((char*)d_ws + WS_CTL) + CW_RES;
        const bf16_t* AO = (const bf16_t*)((char*)d_out + OUT_H); const float* XC = (const float*)((char*)d_ws + WS_XC); const float* X = (const float*)d_out; const bf16_t* XB = (const bf16_t*)((char*)d_ws + WS_XB);
        auto cmp = [&](int id, const void* opt, int bf, int ldo, int col0, const float* ref, int rows, int ncols) {
            hipLaunchKernelGGL(cmp_kernel, dim3(256), dim3(256), 0, stream, opt, bf, ldo, col0, ref, rows, ncols, res + 2 * (id - 1)); };
        launch_range(stream, a, 0, 5, true);
        cmp(1, AO, 1, D, 0, CK + 0 * CKSZ, CKR, 512);
        cmp(2, AO, 1, D, 512, CK + 0 * CKSZ, CKR, 512);
        cmp(3, AO + (size_t)NLAT * D, 1, D, 0, CK + 0 * CKSZ + (size_t)CKR * D, CL, 512);
        cmp(4, AO + (size_t)NLAT * D, 1, D, 512, CK + 0 * CKSZ + (size_t)CKR * D, CL, 512);
        launch_range(stream, a, 5, 6, true);
        cmp(5, XB, 1, D, 0, CK + 1 * CKSZ, CKR, D);
        cmp(6, XC, 0, D, 0, CK + 1 * CKSZ + (size_t)CKR * D, CL, D);
        launch_range(stream, a, 6, 9, true);
        cmp(7, XB, 1, D, 0, CK + 2 * CKSZ, CKR, D);
        cmp(8, XC, 0, D, 0, CK + 2 * CKSZ + (size_t)CKR * D, CL, D);
        launch_range(stream, a, 9, 15, true);
        cmp(9, AO, 1, D, 0, CK + 3 * CKSZ, CKR, 512);
        cmp(10, AO, 1, D, 512, CK + 3 * CKSZ, CKR, 512);
        launch_range(stream, a, 15, 16, true);
        cmp(11, XB, 1, D, 0, CK + 4 * CKSZ, CKR, D);
        launch_range(stream, a, 16, 20, true);
        cmp(12, X, 0, D, 0, CK + 5 * CKSZ, CKR, D);
        hipLaunchKernelGGL(verdict_kernel, dim3(1024), dim3(256), 0, stream, (const float*)res, 12, 2e-3f, (const float*)XN, (float*)d_out);
    }
#endif
}
```

```cpp
#define MK_MODE 0
#include <hip/hip_runtime.h>
#include <cstdint>
#include <cstdio>
#include <cstring>
#include <cmath>
#define GAS __attribute__((address_space(1)))
#define LAS __attribute__((address_space(3)))
typedef unsigned short bf16_t;
typedef unsigned v4u __attribute__((ext_vector_type(4)));
typedef unsigned v2u __attribute__((ext_vector_type(2)));
typedef float f32x4 __attribute__((ext_vector_type(4)));
typedef float f32x2 __attribute__((ext_vector_type(2)));
typedef float f32x16 __attribute__((ext_vector_type(16)));
typedef short bf16x8 __attribute__((ext_vector_type(8)));
typedef int v4i __attribute__((ext_vector_type(4)));
typedef int v8i __attribute__((ext_vector_type(8)));
typedef GAS unsigned gu32;
#define RLX_AGENT __ATOMIC_RELAXED, __HIP_MEMORY_SCOPE_AGENT
#define LDS_WAIT() asm volatile("s_waitcnt lgkmcnt(0)" ::: "memory")
#define VM_WAIT() asm volatile("s_waitcnt vmcnt(0)" ::: "memory")

namespace mk {
constexpr int D = 1024, NB = 8, S = 4096, CL = 256, NLAT = NB * S, NCTX = NB * CL, NTOK = NLAT + NCTX;
constexpr int GW = 64;
constexpr float EPS = 1e-6f;
constexpr float LOG2E = 1.4426950408889634f;
constexpr int NWAVES = 8, NTHR = 512;

typedef __bf16 bf16x2_nt __attribute__((ext_vector_type(2)));
__device__ __forceinline__ unsigned cvt_pk_bf16(float lo, float hi) { const f32x2 v = {lo, hi}; return __builtin_bit_cast(unsigned, __builtin_convertvector(v, bf16x2_nt)); }
__device__ __forceinline__ float bf2f(unsigned short u) { return __uint_as_float((unsigned)u << 16); }
__device__ __forceinline__ float bflo(unsigned u) { return __uint_as_float(u << 16); }
__device__ __forceinline__ float bfhi(unsigned u) { return __uint_as_float(u & 0xffff0000u); }
__device__ __forceinline__ unsigned cvt4_fp8(float a, float b, float c, float d) {
    a = __builtin_amdgcn_fmed3f(a, -448.f, 448.f); b = __builtin_amdgcn_fmed3f(b, -448.f, 448.f); c = __builtin_amdgcn_fmed3f(c, -448.f, 448.f); d = __builtin_amdgcn_fmed3f(d, -448.f, 448.f);
    int r = __builtin_amdgcn_cvt_pk_fp8_f32(a, b, 0, false); r = __builtin_amdgcn_cvt_pk_fp8_f32(c, d, r, true); return (unsigned)r; }
__device__ __forceinline__ float silu_f(float x) { return x / (1.f + __expf(-x)); }
template <int CTRL> __device__ __forceinline__ float dpp_f(float v) { return __builtin_bit_cast(float, __builtin_amdgcn_update_dpp(0, __builtin_bit_cast(int, v), CTRL, 0xf, 0xf, true)); }
__device__ __forceinline__ float xor1_f(float v) { return dpp_f<0xB1>(v); }
__device__ __forceinline__ float xor2_f(float v) { return dpp_f<0x4E>(v); }
__device__ __forceinline__ float xor8_f(float v) { return dpp_f<0x128>(v); }
__device__ __forceinline__ float sum4_f(float v) { v += xor1_f(v); return v + xor2_f(v); }
__device__ __forceinline__ float sum8_f(float v) { v = sum4_f(v); return v + dpp_f<0x141>(v); }
__device__ __forceinline__ float sum16_f(float v) { v = sum8_f(v); return v + dpp_f<0x140>(v); }
__device__ __forceinline__ float sum32_f(float v) { v = sum16_f(v); const auto r = __builtin_amdgcn_permlane16_swap(__float_as_uint(v), __float_as_uint(v), false, false); return __uint_as_float(r[0]) + __uint_as_float(r[1]); }
__device__ __forceinline__ float wave_sum(float v) { v = sum32_f(v); const auto r = __builtin_amdgcn_permlane32_swap(__float_as_uint(v), __float_as_uint(v), false, false); return __uint_as_float(r[0]) + __uint_as_float(r[1]); }
}
#ifndef MK_REP_GEMM
#define MK_REP_GEMM 1
#endif
#ifndef MK_REP_ATTN
#define MK_REP_ATTN 1
#endif
#ifndef MK_PROBE_Q
#define MK_PROBE_Q 0
#endif
#ifndef MK_PROBE
#define MK_PROBE 0
#endif
#ifndef MK_REP_NM
#define MK_REP_NM 1
#endif
#ifndef MK_P0_DUPMOD
#define MK_P0_DUPMOD 0
#endif
#ifndef MK_REP_P0
#define MK_REP_P0 1
#endif
namespace pg8 {
using namespace mk;
constexpr int BM = 256, BK = 64, HALF = 128, HTB = HALF * BK * 2  , STAGE_BYTES = 8 * HTB, NXCD = 8, WGM = 8;

__device__ __forceinline__ int lds_byte(int r, int c) { const int st = (r >> 4) * 2 + (c >> 5), rr = r & 15, cc = c & 31, ob = rr * 64 + cc * 2; return st * 1024 + (ob ^ (((ob >> 9) & 1) << 5)); }
__device__ __forceinline__ void stage_rc(int b, int& R, int& C) { const int st = b / 1024, sb = b % 1024, swz = sb ^ (((sb >> 9) & 1) << 5); R = (st >> 1) * 16 + swz / 64; C = (st & 1) * 32 + (swz % 64) / 2; }
__device__ __forceinline__ int perm32(int rho) { const int n = rho >> 4, i = rho & 15; return 8 * (i >> 2) + 4 * n + (i & 3); }

struct Unit {
    const bf16_t* A; const bf16_t* B;
    const int* ridx;
    int rows;
    int pm, pn, kind, aux;
    int dup;
    int K, gath;
};

__device__ __forceinline__ int xcd_remap(int L, int nwg) { const int q = nwg / NXCD, r = nwg % NXCD, xcd = L % NXCD, off = L / NXCD; return (xcd < r ? xcd * (q + 1) : r * (q + 1) + (xcd - r) * q) + off; }
__device__ __forceinline__ void grouped(int w, int nM, int nN, int& pm, int& pn) {
    const int nig = WGM * nN, gid = w / nig, fm = gid * WGM, gsz = (nM - fm) < WGM ? (nM - fm) : WGM;
    pm = fm + ((w % nig) % gsz); pn = (w % nig) / gsz;
}

template <class Epi, class Sched, bool GATHER, bool FP8 = false, bool VARK = false>
__device__ __forceinline__ void gemm_phase(LAS unsigned char* lds, const int K, const Sched& S, const Epi& E) {
    int tid_ = threadIdx.x; asm volatile("" : "+v"(tid_));
    const int tid = tid_, wid = __builtin_amdgcn_readfirstlane(tid >> 6), lane = tid & 63, wr = wid >> 2, wc = wid & 3, fr = lane & 15, fq = lane >> 4;
    unsigned voffB[2], voffBn[2];
#pragma unroll
    for (int i = 0; i < 2; ++i) { int sR_, sC_; stage_rc(tid * 16 + i * 8192, sR_, sC_); const int sRb_ = Epi::PERM ? ((sR_ & ~31) + perm32(sR_ & 31)) : sR_; voffB[i] = (unsigned)(sRb_ * K + sC_) * 2u; voffBn[i] = voffB[i]; }
    const size_t kstep = (size_t)(BK * 2);
    size_t hstep = (size_t)HALF * K * 2, hstepN = hstep;
    int nt = K / BK;
    const unsigned ldsw = (unsigned)wid * 1024u;
    const int aoff = lds_byte(wr * 64 + fr, fq * 8), boff = lds_byte(wc * 32 + fr, fq * 8);
#define PG8_SA(b, h) (((b) * 2 + (h)) * HTB)
#define PG8_SB(b, h) ((4 + (b) * 2 + (h)) * HTB)
#define PG8_STAGE(bufoff, gbase, voff) do { _Pragma("unroll") for (int _i = 0; _i < 2; ++_i) \
        __builtin_amdgcn_global_load_lds((const unsigned*)((const char*)(gbase) + (voff)[_i]), (LAS unsigned*)(lds + (bufoff) + ldsw + _i * 8192), 16, 0, 0); } while (0)
#define PG8_STAGE_A(bufoff, h, kptr, vo) PG8_STAGE(bufoff, (GATHER ? (kptr) : (kptr) + (h) * hstep), (vo)[GATHER ? (h) : 0])
#define PG8_LDA(dst, b, h) do { _Pragma("unroll") for (int m = 0; m < 4; ++m) { if (FP8) dst##8[m] = __builtin_shufflevector(*(const LAS v4i*)(lds + PG8_SA(b, h) + aoff + m * 2048), *(const LAS v4i*)(lds + PG8_SA(b, h) + aoff + m * 2048 + 1024), 0, 1, 2, 3, 4, 5, 6, 7); \
        else { _Pragma("unroll") for (int k = 0; k < 2; ++k) dst[m][k] = *(const LAS bf16x8*)(lds + PG8_SA(b, h) + aoff + m * 2048 + k * 1024); } } } while (0)
#define PG8_LDB(dst, b, h) do { _Pragma("unroll") for (int n = 0; n < 2; ++n) { if (FP8) dst##8[n] = __builtin_shufflevector(*(const LAS v4i*)(lds + PG8_SB(b, h) + boff + n * 2048), *(const LAS v4i*)(lds + PG8_SB(b, h) + boff + n * 2048 + 1024), 0, 1, 2, 3, 4, 5, 6, 7); \
        else { _Pragma("unroll") for (int k = 0; k < 2; ++k) dst[n][k] = *(const LAS bf16x8*)(lds + PG8_SB(b, h) + boff + n * 2048 + k * 1024); } } } while (0)
#define PG8_MMA(ai, bj, At, Bt) do { __builtin_amdgcn_s_setprio(1); _Pragma("unroll") for (int m = 0; m < 4; ++m) _Pragma("unroll") for (int n = 0; n < 2; ++n) { \
        if (FP8) { asm volatile("v_mfma_f32_16x16x128_f8f6f4 %0, %1, %2, %0" : "+v"(acc[ai][bj][m][n]) : "v"(Bt##8[n]), "v"(At##8[m])); } \
        else { _Pragma("unroll") for (int k = 0; k < 2; ++k) acc[ai][bj][m][n] = __builtin_amdgcn_mfma_f32_16x16x32_bf16(Bt[n][k], At[m][k], acc[ai][bj][m][n], 0, 0, 0); } } \
        __builtin_amdgcn_s_setprio(0); } while (0)
#define PG8_WAIT_V(n) asm volatile("s_waitcnt vmcnt(" #n ")" ::: "memory")
#define PG8_WAIT_L(n) asm volatile("s_waitcnt lgkmcnt(" #n ")" ::: "memory")
#define PG8_BAR __builtin_amdgcn_s_barrier()
#define PG8_SCHED __builtin_amdgcn_sched_barrier(0)
#define PG8_MKVOFF(u, vo) do { _Pragma("unroll") for (int _h = 0; _h < (GATHER ? 2 : 1); ++_h) _Pragma("unroll") for (int _i = 0; _i < 2; ++_i) { \
        int _sR, _sC; stage_rc(tid * 16 + _i * 8192, _sR, _sC); const int _row = _h * HALF + _sR; int _g = _row; \
        if (GATHER) { if (!VARK || (u).gath) _g = (_row < (u).rows) ? (u).ridx[_row] : 0; } \
        (vo)[_h][_i] = (unsigned)(_g * (VARK ? (u).K : K) + _sC) * 2u; } } while (0)
#define PG8_MKVOFFB(u, vb, hs) do { if (VARK) { _Pragma("unroll") for (int _i = 0; _i < 2; ++_i) { int _sR, _sC; stage_rc(tid * 16 + _i * 8192, _sR, _sC); const int _sRb = Epi::PERM ? ((_sR & ~31) + perm32(_sR & 31)) : _sR; (vb)[_i] = (unsigned)(_sRb * (u).K + _sC) * 2u; } hs = (size_t)HALF * (u).K * 2; } } while (0)
    Unit cur, nxt; int ui = 0;
    if (!S.next(0, cur)) return;
    f32x4 acc[2][2][4][2];
#pragma unroll
    for (int a = 0; a < 2; ++a)
#pragma unroll
        for (int b = 0; b < 2; ++b)
#pragma unroll
            for (int m = 0; m < 4; ++m)
#pragma unroll
                for (int n = 0; n < 2; ++n) acc[a][b][m][n] = (f32x4){0.f, 0.f, 0.f, 0.f};
    bf16x8 At[4][2], B0[2][2], B1[2][2];
    v8i At8[4], B08[2], B18[2];
    unsigned vA[2][2], vN[2][2];
    PG8_MKVOFF(cur, vA); PG8_MKVOFFB(cur, voffB, hstep); if (VARK) nt = cur.K / BK;
    const char* cA = (const char*)cur.A; const char* cB = (const char*)cur.B;
    PG8_STAGE(PG8_SB(0, 0), cB, voffB); PG8_STAGE(PG8_SB(0, 1), cB + hstep, voffB); PG8_STAGE_A(PG8_SA(0, 0), 0, cA, vA); PG8_STAGE_A(PG8_SA(0, 1), 1, cA, vA);
    if (wr == 1) PG8_BAR;
    PG8_WAIT_V(2); PG8_BAR;
    PG8_STAGE(PG8_SB(1, 0), cB + kstep, voffB); PG8_STAGE_A(PG8_SA(1, 0), 0, cA + kstep, vA); PG8_STAGE(PG8_SB(1, 1), cB + hstep + kstep, voffB);
    PG8_WAIT_V(6); PG8_BAR;
    for (;;) {
        const bool has_next = S.next(ui + 1, nxt);
        const char* nA = has_next ? (const char*)nxt.A : cA; const char* nB = has_next ? (const char*)nxt.B : cB;
        if (VARK) { if (has_next) { PG8_MKVOFFB(nxt, voffBn, hstepN); } else { voffBn[0] = voffB[0]; voffBn[1] = voffB[1]; hstepN = hstep; } }
        if (GATHER) { if (has_next) { PG8_MKVOFF(nxt, vN); } else {
#pragma unroll
            for (int h = 0; h < 2; ++h)
#pragma unroll
                for (int i = 0; i < 2; ++i) vN[h][i] = vA[h][i]; } }
        LAS v4u* const parkA = (LAS v4u*)(lds + STAGE_BYTES + 4096) + tid; LAS v2u* const parkB = (LAS v2u*)(lds + STAGE_BYTES + 4096 + 8192) + tid;
        if (VARK) { *parkA = (v4u){vN[0][0], vN[0][1], vN[1][0], vN[1][1]}; *parkB = (v2u){voffBn[0], voffBn[1]}; }
        for (int t = 0; t < nt; t += 2) {
            const bool last = (t == nt - 2);
            const char* a1 = cA + (size_t)(t + 1) * kstep;
            const char* a2 = last ? nA : cA + (size_t)(t + 2) * kstep; const char* b2 = last ? nB : cB + (size_t)(t + 2) * kstep;
            const char* a3 = a2 + kstep; const char* b3 = b2 + kstep;
            unsigned v2[2][2];
#pragma unroll
            for (int h = 0; h < 2; ++h)
#pragma unroll
                for (int i = 0; i < 2; ++i) v2[h][i] = (GATHER && !VARK && last) ? vN[h][i] : vA[h][i];
            unsigned vb2[2]; vb2[0] = voffB[0]; vb2[1] = voffB[1];
            if (VARK) { if (last) { const v4u pa = *parkA; const v2u pb = *parkB; v2[0][0] = pa.x; v2[0][1] = pa.y; v2[1][0] = pa.z; v2[1][1] = pa.w; vb2[0] = pb.x; vb2[1] = pb.y; } }
            const size_t hs2 = (VARK && last) ? hstepN : hstep;
            PG8_LDB(B0, 0, 0); PG8_LDB(B1, 0, 1); PG8_SCHED; PG8_LDA(At, 0, 0); PG8_STAGE_A(PG8_SA(1, 1), 1, a1, vA);
            PG8_WAIT_V(8); PG8_WAIT_L(0); PG8_BAR; PG8_MMA(0, 0, At, B0); PG8_MMA(0, 1, At, B1); PG8_BAR; PG8_SCHED;
            PG8_LDA(At, 0, 1); PG8_STAGE(PG8_SB(0, 0), b2, vb2); PG8_STAGE(PG8_SB(0, 1), b2 + hs2, vb2); PG8_STAGE_A(PG8_SA(0, 0), 0, a2, v2);
            PG8_WAIT_V(8); PG8_WAIT_L(0); PG8_BAR; PG8_MMA(1, 0, At, B0); PG8_MMA(1, 1, At, B1); PG8_BAR; PG8_SCHED;
            PG8_LDB(B0, 1, 0); PG8_LDB(B1, 1, 1); PG8_SCHED; PG8_LDA(At, 1, 0); PG8_STAGE_A(PG8_SA(0, 1), 1, a2, v2);
            PG8_WAIT_V(8); PG8_WAIT_L(0); PG8_BAR; PG8_MMA(0, 0, At, B0); PG8_MMA(0, 1, At, B1); PG8_BAR; PG8_SCHED;
            PG8_LDA(At, 1, 1); PG8_STAGE(PG8_SB(1, 0), b3, vb2); PG8_STAGE(PG8_SB(1, 1), b3 + hs2, vb2); PG8_STAGE_A(PG8_SA(1, 0), 0, a3, v2);
            PG8_WAIT_V(8); PG8_WAIT_L(0); PG8_BAR; PG8_MMA(1, 0, At, B0); PG8_MMA(1, 1, At, B1); PG8_BAR; PG8_SCHED;
        }
        if (wr == 0) PG8_BAR;
        if (FP8) asm volatile("s_nop 15\n\ts_nop 15\n\ts_nop 15\n\ts_nop 15" ::: "memory");
        { int t2_ = threadIdx.x; asm volatile("" : "+v"(t2_));
          if (!cur.dup) E(acc, cur, wr, wc, t2_ & 15, (t2_ & 63) >> 4); }
        if (!has_next) break;
#pragma unroll
        for (int a = 0; a < 2; ++a)
#pragma unroll
            for (int b = 0; b < 2; ++b)
#pragma unroll
                for (int m = 0; m < 4; ++m)
#pragma unroll
                    for (int n = 0; n < 2; ++n) acc[a][b][m][n] = (f32x4){0.f, 0.f, 0.f, 0.f};
        cur = nxt; cA = nA; cB = nB; ++ui;
        if (VARK) { const v4u pa = *parkA; const v2u pb = *parkB; vA[0][0] = pa.x; vA[0][1] = pa.y; vA[1][0] = pa.z; vA[1][1] = pa.w; voffB[0] = pb.x; voffB[1] = pb.y; hstep = hstepN; nt = cur.K / BK; }
        else if (GATHER) {
#pragma unroll
        for (int h = 0; h < 2; ++h)
#pragma unroll
            for (int i = 0; i < 2; ++i) vA[h][i] = vN[h][i]; }
        if (wr == 1) PG8_BAR;
    }
    PG8_WAIT_V(0);
    PG8_BAR;
#undef PG8_SA
#undef PG8_SB
#undef PG8_STAGE
#undef PG8_STAGE_A
#undef PG8_LDA
#undef PG8_LDB
#undef PG8_MMA
#undef PG8_WAIT_V
#undef PG8_WAIT_L
#undef PG8_BAR
#undef PG8_SCHED
#undef PG8_MKVOFF
#undef PG8_MKVOFFB
}

struct MultiSched {
    const bf16_t* A0; const bf16_t* B0; const bf16_t* A1; const bf16_t* B1;
    int nM0, nN0, kind0, nM1, nN1, kind1, n0, total, G, c, K;
    __device__ __forceinline__ void init(int K_, int G_, int c_) { n0 = 0; total = 0; G = G_; c = c_; K = K_; A1 = nullptr; B1 = nullptr; nM1 = 0; nN1 = 1; kind1 = 0; }
    __device__ __forceinline__ void add(const bf16_t* A, const bf16_t* B, int nM, int nN, int kind) {
        if (total == 0) { A0 = A; B0 = B; nM0 = nM; nN0 = nN; kind0 = kind; n0 = nM * nN; } else { A1 = A; B1 = B; nM1 = nM; nN1 = nN; kind1 = kind; }
        total += nM * nN; }
    __device__ __forceinline__ bool next(int i, Unit& u) const {
        const long L = (long)(i / MK_REP_GEMM) * G + c; if (L >= total) return false;
        u.dup = (i % MK_REP_GEMM) != 0;
        int w = xcd_remap((int)L, total);
        const bool second = w >= n0; if (second) w -= n0;
        const int nM = second ? nM1 : nM0, nN = second ? nN1 : nN0;
        int pm, pn; grouped(w, nM, nN, pm, pn);
        u.A = (second ? A1 : A0) + (size_t)pm * BM * K; u.B = (second ? B1 : B0) + (size_t)pn * BM * K; u.ridx = nullptr; u.rows = BM; u.pm = pm; u.pn = pn; u.kind = second ? kind1 : kind0; u.aux = pm * BM;
        return true;
    }
};
}
namespace pg8 {
struct EpiStore {
    static constexpr bool PERM = true;
    bf16_t* O0; bf16_t* O1; int ldc0, ldc1;
    __device__ __forceinline__ void operator()(const f32x4 (&acc)[2][2][4][2], const Unit& u, int wr, int wc, int fr, int fq) const {
        const int ldc = u.kind ? ldc1 : ldc0;
        bf16_t* base = (u.kind ? O1 : O0) + (size_t)(u.pm * BM + wr * 64 + fr) * ldc + u.pn * BM + wc * 32 + 8 * fq;
#pragma unroll
        for (int ai = 0; ai < 2; ++ai)
#pragma unroll
            for (int m = 0; m < 4; ++m) { bf16_t* rowp = base + (size_t)(ai * HALF + m * 16) * ldc;
#pragma unroll
                for (int bj = 0; bj < 2; ++bj) { const f32x4 v0 = acc[ai][bj][m][0], v1 = acc[ai][bj][m][1];
                    v4u w; w.x = cvt_pk_bf16(v0[0], v0[1]); w.y = cvt_pk_bf16(v0[2], v0[3]); w.z = cvt_pk_bf16(v1[0], v1[1]); w.w = cvt_pk_bf16(v1[2], v1[3]);
                    *(v4u*)(rowp + bj * HALF) = w; } }
    }
};
struct EpiQK0 {
    static constexpr bool PERM = true;
    bf16_t* QK; bf16_t* VT; const float* gtab; const f32x2* t64;
    __device__ __forceinline__ void operator()(const f32x4 (&acc)[2][2][4][2], const Unit& u, int wr, int wc, int fr, int fq) const {
        if (u.kind) {
            bf16_t* base = VT + (size_t)(u.pm * BM + wr * 64 + fr) * NTOK + u.pn * BM + wc * 32 + 8 * fq;
#pragma unroll
            for (int ai = 0; ai < 2; ++ai)
#pragma unroll
                for (int m = 0; m < 4; ++m) { bf16_t* rowp = base + (size_t)(ai * HALF + m * 16) * NTOK;
#pragma unroll
                    for (int bj = 0; bj < 2; ++bj) { const f32x4 v0 = acc[ai][bj][m][0], v1 = acc[ai][bj][m][1];
                        v4u w; w.x = cvt_pk_bf16(v0[0], v0[1]); w.y = cvt_pk_bf16(v0[2], v0[3]); w.z = cvt_pk_bf16(v1[0], v1[1]); w.w = cvt_pk_bf16(v1[2], v1[3]);
                        *(v4u*)(rowp + bj * HALF) = w; } }
            return;
        }
        const int kq = u.pn >> 1;
        const float* g = gtab + kq * 64;
        const bool rope = (kq >= 2) && (u.pm * BM < NLAT);
        const float scale = (kq == 0 || kq == 2) ? 0.125f * LOG2E : 1.f;
        f32x4 gg[2][2];
#pragma unroll
        for (int bj = 0; bj < 2; ++bj)
#pragma unroll
            for (int n = 0; n < 2; ++n) gg[bj][n] = *(const f32x4*)(g + bj * 32 + 8 * fq + 4 * n);
        const bool x1 = fq < 2; const int i0 = 8 * (fq & 1);
#pragma unroll
        for (int ai = 0; ai < 2; ++ai)
#pragma unroll
            for (int m = 0; m < 4; ++m) {
                const int row = u.pm * BM + ai * HALF + wr * 64 + m * 16 + fr;
                float v[2][8]; float ss = 0.f;
#pragma unroll
                for (int bj = 0; bj < 2; ++bj)
#pragma unroll
                    for (int q = 0; q < 8; ++q) { v[bj][q] = acc[ai][bj][m][q >> 2][q & 3]; ss += v[bj][q] * v[bj][q]; }
                ss += __shfl_xor(ss, 16); ss += __shfl_xor(ss, 32);
                const float rstd = rsqrtf(ss * (1.f / 64.f) + EPS);
#pragma unroll
                for (int bj = 0; bj < 2; ++bj)
#pragma unroll
                    for (int q = 0; q < 8; ++q) v[bj][q] *= rstd * gg[bj][q >> 2][q & 3];
                if (rope) {
                    const int pos = row & (S - 1);
#pragma unroll
                    for (int bj = 0; bj < 2; ++bj) { const int ps = bj ? (pos & 63) : (pos >> 6);
#pragma unroll
                        for (int q = 0; q < 8; ++q) { const float pr = __shfl_xor(v[bj][q], 32); const f32x2 cs = t64[ps * 16 + i0 + q];
                            v[bj][q] = x1 ? (v[bj][q] * cs.x - pr * cs.y) : (pr * cs.y + v[bj][q] * cs.x); } }
                }
                bf16_t* op = QK + (size_t)row * 2048 + u.pn * BM + wc * 64 + 8 * fq;
#pragma unroll
                for (int bj = 0; bj < 2; ++bj) { v4u w; w.x = cvt_pk_bf16(v[bj][0] * scale, v[bj][1] * scale); w.y = cvt_pk_bf16(v[bj][2] * scale, v[bj][3] * scale); w.z = cvt_pk_bf16(v[bj][4] * scale, v[bj][5] * scale); w.w = cvt_pk_bf16(v[bj][6] * scale, v[bj][7] * scale);
                    *(v4u*)(op + bj * 32) = w; }
                __builtin_amdgcn_sched_barrier(0);
            }
    }
};
struct EpiSwiglu {
    static constexpr bool PERM = true;
    bf16_t* O; int ldc;
    __device__ __forceinline__ void operator()(const f32x4 (&acc)[2][2][4][2], const Unit& u, int wr, int wc, int fr, int fq) const {
        bf16_t* base = O + (size_t)(u.aux + wr * 64 + fr) * ldc + u.pn * HALF + wc * 32 + 8 * fq;
#pragma unroll
        for (int ai = 0; ai < 2; ++ai)
#pragma unroll
            for (int m = 0; m < 4; ++m) {
                float o[8];
#pragma unroll
                for (int n = 0; n < 2; ++n)
#pragma unroll
                    for (int j = 0; j < 4; ++j) { const float g = acc[ai][0][m][n][j], up = acc[ai][1][m][n][j]; o[n * 4 + j] = g * __builtin_amdgcn_rcpf(1.f + __builtin_amdgcn_exp2f(-g * LOG2E)) * up; }
                v4u w; w.x = cvt_pk_bf16(o[0], o[1]); w.y = cvt_pk_bf16(o[2], o[3]); w.z = cvt_pk_bf16(o[4], o[5]); w.w = cvt_pk_bf16(o[6], o[7]);
                *(v4u*)(base + (size_t)(ai * HALF + m * 16) * ldc) = w; }
    }
};
struct EpiSwigluF8 {
    static constexpr bool PERM = true;
    unsigned char* O; int ldc; float inv, oscale;
    __device__ __forceinline__ void operator()(const f32x4 (&acc)[2][2][4][2], const Unit& u, int wr, int wc, int fr, int fq) const {
        unsigned char* base = O + (size_t)(u.aux + wr * 64 + fr) * ldc + u.pn * HALF + wc * 32 + 8 * fq;
#pragma unroll
        for (int ai = 0; ai < 2; ++ai)
#pragma unroll
            for (int m = 0; m < 4; ++m) {
                float o[8];
#pragma unroll
                for (int n = 0; n < 2; ++n) {
                    const f32x4 a = acc[ai][0][m][n], b = acc[ai][1][m][n];
                    const f32x4 tv = a * (-inv * LOG2E), uv = b * (inv * inv * oscale);
                    f32x4 dv; dv[0] = __builtin_amdgcn_exp2f(tv[0]); dv[1] = __builtin_amdgcn_exp2f(tv[1]); dv[2] = __builtin_amdgcn_exp2f(tv[2]); dv[3] = __builtin_amdgcn_exp2f(tv[3]);
                    dv = dv + 1.f;
                    f32x4 rv; rv[0] = __builtin_amdgcn_rcpf(dv[0]); rv[1] = __builtin_amdgcn_rcpf(dv[1]); rv[2] = __builtin_amdgcn_rcpf(dv[2]); rv[3] = __builtin_amdgcn_rcpf(dv[3]);
                    const f32x4 zv = (a * rv) * uv;
                    o[n * 4] = zv[0]; o[n * 4 + 1] = zv[1]; o[n * 4 + 2] = zv[2]; o[n * 4 + 3] = zv[3]; }
                v2u w; w.x = cvt4_fp8(o[0], o[1], o[2], o[3]); w.y = cvt4_fp8(o[4], o[5], o[6], o[7]);
                *(v2u*)(base + (size_t)(ai * HALF + m * 16) * ldc) = w; }
    }
};
template <bool BASE_BF16> struct EpiResid {
    static constexpr bool PERM = true;
    const void* base_lat; bf16_t* out_lat; const float* base_ctx; float* out_ctx; const float* modl; int chunk; float inv = 1.f;
    __device__ __forceinline__ void operator()(const f32x4 (&acc)[2][2][4][2], const Unit& u, int wr, int wc, int fr, int fq) const {
        const int row_t = u.pm * BM;
        const bool lat = row_t < NLAT;
        const int v = lat ? row_t / S : 8;
        const int col0 = u.pn * BM + wc * 32 + 8 * fq;
        const float* gp = modl + (size_t)v * 6144 + chunk * D + col0;
        f32x4 gv[2][2];
#pragma unroll
        for (int bj = 0; bj < 2; ++bj)
#pragma unroll
            for (int n = 0; n < 2; ++n) gv[bj][n] = *(const f32x4*)(gp + bj * HALF + n * 4) * inv;
        if (lat) {
#pragma unroll
            for (int ai = 0; ai < 2; ++ai)
#pragma unroll
                for (int m = 0; m < 4; ++m) { const size_t off = (size_t)(row_t + ai * HALF + wr * 64 + m * 16 + fr) * D + col0;
#pragma unroll
                    for (int bj = 0; bj < 2; ++bj) { f32x4 b0, b1;
                        if (BASE_BF16) { const v4u w = *(const v4u*)((const bf16_t*)base_lat + off + bj * HALF); b0 = (f32x4){bflo(w.x), bfhi(w.x), bflo(w.y), bfhi(w.y)}; b1 = (f32x4){bflo(w.z), bfhi(w.z), bflo(w.w), bfhi(w.w)}; }
                        else { b0 = *(const f32x4*)((const float*)base_lat + off + bj * HALF); b1 = *(const f32x4*)((const float*)base_lat + off + bj * HALF + 4); }
                        const f32x4 o0 = b0 + gv[bj][0] * acc[ai][bj][m][0], o1 = b1 + gv[bj][1] * acc[ai][bj][m][1];
                        v4u w; w.x = cvt_pk_bf16(o0[0], o0[1]); w.y = cvt_pk_bf16(o0[2], o0[3]); w.z = cvt_pk_bf16(o1[0], o1[1]); w.w = cvt_pk_bf16(o1[2], o1[3]);
                        *(v4u*)(out_lat + off + bj * HALF) = w; } }
        } else {
#pragma unroll
            for (int ai = 0; ai < 2; ++ai)
#pragma unroll
                for (int m = 0; m < 4; ++m) { const size_t off = (size_t)(row_t - NLAT + ai * HALF + wr * 64 + m * 16 + fr) * D + col0;
#pragma unroll
                    for (int bj = 0; bj < 2; ++bj)
#pragma unroll
                        for (int n = 0; n < 2; ++n) { const f32x4 bs = *(const f32x4*)(base_ctx + off + bj * HALF + n * 4);
                            *(f32x4*)(out_ctx + off + bj * HALF + n * 4) = bs + gv[bj][n] * acc[ai][bj][m][n]; } }
        }
    }
};
template <bool FINAL> struct EpiMoeDown {
    static constexpr bool PERM = true;
    bf16_t* xb; float* out; const float* modl; const float* slot_g_base; const int* slot_tok_base; float inv;
    __device__ __forceinline__ void operator()(const f32x4 (&acc)[2][2][4][2], const Unit& u, int wr, int wc, int fr, int fq) const {
        const int col0 = u.pn * BM + wc * 32 + 8 * fq;
        const float* sg = slot_g_base + (u.ridx - slot_tok_base);
#pragma unroll
        for (int ai = 0; ai < 2; ++ai)
#pragma unroll
            for (int m = 0; m < 4; ++m) { const int r = ai * HALF + wr * 64 + m * 16 + fr;
                if (r < u.rows) { const int tok = u.ridx[r]; const float g = sg[r] * inv;
                    const float* gp = modl + (size_t)(tok >> 12) * 6144 + 5 * D + col0; const size_t off = (size_t)tok * D + col0;
#pragma unroll
                    for (int bj = 0; bj < 2; ++bj) { const f32x4 g0 = *(const f32x4*)(gp + bj * HALF), g1 = *(const f32x4*)(gp + bj * HALF + 4);
                        const v4u w = *(const v4u*)(xb + off + bj * HALF);
                        const f32x4 b0 = (f32x4){bflo(w.x), bfhi(w.x), bflo(w.y), bfhi(w.y)}, b1 = (f32x4){bflo(w.z), bfhi(w.z), bflo(w.w), bfhi(w.w)};
                        const f32x4 o0 = b0 + (g0 * g) * acc[ai][bj][m][0], o1 = b1 + (g1 * g) * acc[ai][bj][m][1];
                        if (FINAL) { *(f32x4*)(out + off + bj * HALF) = o0; *(f32x4*)(out + off + bj * HALF + 4) = o1; }
                        else { v4u o; o.x = cvt_pk_bf16(o0[0], o0[1]); o.y = cvt_pk_bf16(o0[2], o0[3]); o.z = cvt_pk_bf16(o1[0], o1[1]); o.w = cvt_pk_bf16(o1[2], o1[3]); *(v4u*)(xb + off + bj * HALF) = o; } } } }
    }
};

struct MoeSched {
    const LAS int* tab;
    int ntile, nN, total, G, cu, K; bool gather;
    const bf16_t* A; const bf16_t* B; size_t bstride; const int* slot_tok;
    __device__ __forceinline__ void init(LAS int* tab_, const int* cnt_g, int K_, int nN_, int G_, int cu_, bool gather_, const bf16_t* A_, const bf16_t* B_, size_t bstride_, const int* slot_tok_) {
        __syncthreads();
        if (threadIdx.x == 0) { int s = 0; for (int e = 0; e < 8; ++e) { const int ce = cnt_g[e]; tab_[16 + e] = ce; tab_[e] = s; s += (ce + BM - 1) / BM; } tab_[8] = s; }
        __syncthreads();
        tab = tab_; ntile = __builtin_amdgcn_readfirstlane(tab_[8]);
        nN = nN_; total = ntile * nN_; G = G_; cu = cu_; K = K_; gather = gather_; A = A_; B = B_; bstride = bstride_; slot_tok = slot_tok_;
    }
    __device__ __forceinline__ bool next(int i, Unit& u) const {
        const long L = (long)(i / MK_REP_GEMM) * G + cu; if (L >= total) return false;
        u.dup = (i % MK_REP_GEMM) != 0;
        const int w = xcd_remap((int)L, total);
        int rt, pn; grouped(w, ntile, nN, rt, pn);
        int e = 0;
        for (int j = 1; j < 8; ++j) if (rt >= tab[j]) e = j;
        const int t0 = tab[e], ce = tab[16 + e];
        const int lt = rt - t0;
        u.ridx = slot_tok + (size_t)e * NLAT + lt * BM; u.rows = (ce - lt * BM) < BM ? (ce - lt * BM) : BM;
        u.A = gather ? A : A + (size_t)rt * BM * K; u.B = B + (size_t)e * bstride + (size_t)pn * BM * K;
        u.pm = rt; u.pn = pn; u.kind = e; u.aux = rt * BM;
        return true;
    }
};
struct EpiMoeDual {
    static constexpr bool PERM = true;
    EpiSwigluF8 g; EpiMoeDown<false> d;
    __device__ __forceinline__ void operator()(const f32x4 (&acc)[2][2][4][2], const Unit& u, int wr, int wc, int fr, int fq) const {
        if (u.kind & 0x100) d(acc, u, wr, wc, fr, fq); else g(acc, u, wr, wc, fr, fq);
    }
};
struct MoeDualSched {
    const LAS int* tabD; const LAS int* tabG;
    int ntD, ntG, nD, nG, G, cu, KD, KG, dc, g0, g1;
    const bf16_t* AD; const bf16_t* BD; size_t bsD; const int* stokD;
    const bf16_t* AG; const bf16_t* BG; size_t bsG; const int* stokG;
    static constexpr int NND = 4, NNG = 28, WCOST = 3;
    __device__ __forceinline__ void init(LAS int* tab, const int* cntD, const int* cntG, int G_, int cu_, int KD_, int KG_,
                                         const bf16_t* AD_, const bf16_t* BD_, size_t bsD_, const int* stokD_, const bf16_t* AG_, const bf16_t* BG_, size_t bsG_, const int* stokG_) {
        __syncthreads();
        if (threadIdx.x < 2) { LAS int* t = tab + 32 * threadIdx.x; const int* cg = threadIdx.x ? cntG : cntD; int s = 0;
            for (int e = 0; e < 8; ++e) { const int ce = cg[e]; t[16 + e] = ce; t[e] = s; s += (ce + BM - 1) / BM; } t[8] = s; }
        __syncthreads();
        tabD = tab; tabG = tab + 32; ntD = __builtin_amdgcn_readfirstlane(tab[8]); ntG = __builtin_amdgcn_readfirstlane(tab[32 + 8]);
        nD = ntD * NND; nG = ntG * NNG; G = G_; cu = cu_; KD = KD_; KG = KG_;
        AD = AD_; BD = BD_; bsD = bsD_; stokD = stokD_; AG = AG_; BG = BG_; bsG = bsG_; stokG = stokG_;
        const int dlo = nD / G, r = nD % G; dc = dlo + (cu < r ? 1 : 0);
        int w = WCOST, x = (nG - (G - r) * w) / G; if (nG < (G - r) * w) { w = 0; x = nG / G; }
        const int rem = nG - (r * x + (G - r) * (x + w));
        g0 = cu * x + w * (cu > r ? cu - r : 0) + (cu < rem ? cu : rem);
        g1 = g0 + x + (cu >= r ? w : 0) + (cu < rem ? 1 : 0);
    }
    __device__ __forceinline__ bool next(int i, Unit& u) const {
        u.dup = 0; u.ridx = nullptr;
        if (i < dc) {
            const int w = xcd_remap(cu + G * i, nD);
            int rt, pn; grouped(w, ntD, NND, rt, pn);
            int e = 0;
            for (int j = 1; j < 8; ++j) if (rt >= tabD[j]) e = j;
            const int lt = rt - tabD[e], ce = tabD[16 + e];
            u.ridx = stokD + (size_t)e * NLAT + lt * BM; u.rows = (ce - lt * BM) < BM ? (ce - lt * BM) : BM;
            u.A = AD + (size_t)rt * BM * KD; u.B = BD + (size_t)e * bsD + (size_t)pn * BM * KD;
            u.pm = rt; u.pn = pn; u.kind = e | 0x100; u.aux = rt * BM; u.K = KD; u.gath = 0;
            return true;
        }
        const int gi = g0 + (i - dc); if (gi >= g1) return false;
        int rt, pn; grouped(gi, ntG, NNG, rt, pn);
        int e = 0;
        for (int j = 1; j < 8; ++j) if (rt >= tabG[j]) e = j;
        const int lt = rt - tabG[e], ce = tabG[16 + e];
        u.ridx = stokG + (size_t)e * NLAT + lt * BM; u.rows = (ce - lt * BM) < BM ? (ce - lt * BM) : BM;
        u.A = AG; u.B = BG + (size_t)e * bsG + (size_t)pn * BM * KG;
        u.pm = rt; u.pn = pn; u.kind = e; u.aux = rt * BM; u.K = KG; u.gath = 1;
        return true;
    }
};
}
#ifndef ATT_NEGM
#define ATT_NEGM 1
#endif
#ifndef ATT_LSUM
#define ATT_LSUM 1
#endif
#ifndef ATT_NOMAX
#define ATT_NOMAX 1
#endif
namespace att {
using namespace mk;
constexpr int NSLOT = 4;
constexpr float NEG_BIG = -1e30f;
template <int DK, int DV> struct Cfg {
    static constexpr int KB = 64 * DK * 2, VB = DV * 64 * 2, SLOT = KB + VB, NPK = DK / 8, NPV = DV / 8, NP = NPK + NPV, NPW = (NP + 7) / 8, ND0 = DK / 16, NDB = DV / 32;
};
__device__ __forceinline__ float max3f(float a, float b, float c) { float r; asm("v_max3_f32 %0, %1, %2, %3" : "=v"(r) : "v"(a), "v"(b), "v"(c)); return r; }
__device__ __forceinline__ int kvmap(int i) { return (i & 3) | ((i & 4) << 1) | ((i & 8) >> 1) | (i & 16); }

struct Keys { int ka0, na, kb0, nb; };
struct NaInfo { int r_lo; int qr; int qc; const LAS float* bias; };

#define ATT_WAITBAR(N) asm volatile("s_waitcnt vmcnt(" #N ") lgkmcnt(0)\n\ts_barrier" ::: "memory")

template <int DK, int DV, bool MODE_NA>
__device__ __forceinline__ void attn_core(LAS unsigned char* lds, const bf16_t* __restrict__ Qp  ,
                                          const bf16_t* __restrict__ Kh  , int ldk, const bf16_t* __restrict__ VTh  , int ldv,
                                          const Keys ky, const NaInfo na, f32x16 (&oT)[Cfg<DK, DV>::NDB], float& l_out) {
    typedef Cfg<DK, DV> C;
    int tid_ = threadIdx.x; asm volatile("" : "+v"(tid_));
    const int tid = tid_, lane = tid & 63, r32 = lane & 31, hi = lane >> 5; const int wid = __builtin_amdgcn_readfirstlane(tid >> 6);
    const int nt = ky.na + ky.nb;
    bf16x8 qf[C::ND0];
#pragma unroll
    for (int d0 = 0; d0 < C::ND0; ++d0) qf[d0] = *(const bf16x8*)(Qp + d0 * 16 + hi * 8);
    const unsigned voffK = (unsigned)lane * (unsigned)ldk * 2u, voffV = (unsigned)lane * (unsigned)ldv * 2u;
    const __amdgpu_buffer_rsrc_t srdK = __builtin_amdgcn_make_buffer_rsrc((void*)Kh, (short)0, 0x7FFFFFFF, 0x00020000);
    const __amdgpu_buffer_rsrc_t srdV = __builtin_amdgcn_make_buffer_rsrc((void*)VTh, (short)0, 0x7FFFFFFF, 0x00020000);
    const unsigned ldsb = (unsigned)(size_t)lds;
#define ATT_DMA(m0v, voff, srd, soff) asm volatile("s_mov_b32 m0, %0\n\ts_nop 0\n\tbuffer_load_dwordx4 %1, %2, %3 offen lds" :: "s"(m0v), "v"(voff), "s"(srd), "s"(soff) : "m0", "memory")
#define ATT_ISSUE(t, slot) do { const int _row0 = (t) < ky.na ? ky.ka0 + 64 * (t) : ky.kb0 + 64 * ((t) - ky.na); \
        _Pragma("unroll") for (int _j = 0; _j < C::NPW; ++_j) { int _pc = wid + 8 * _j; _pc = _pc < C::NP ? _pc : C::NP - 1; \
            if (_pc < C::NPK) { const unsigned _so = (unsigned)(_row0 * ldk + _pc * 8) * 2u; const unsigned _m0 = ldsb + (slot) * C::SLOT + _pc * 1024; ATT_DMA(_m0, voffK, srdK, _so); } \
            else { const int _pv = _pc - C::NPK; const unsigned _so = (unsigned)((_pv >> 3) * 64 * ldv + _row0 + (_pv & 7) * 8) * 2u; const unsigned _m0 = ldsb + (slot) * C::SLOT + C::KB + _pv * 1024; ATT_DMA(_m0, voffV, srdV, _so); } } } while (0)
    ATT_ISSUE(0, 0); ATT_ISSUE(1, 1); ATT_ISSUE(2, 2);
#pragma unroll
    for (int db = 0; db < C::NDB; ++db)
#pragma unroll
        for (int r = 0; r < 16; ++r) oT[db][r] = 0.f;
    constexpr float THR = 8.f;
    constexpr bool NOMAX = (ATT_NOMAX != 0);
    constexpr bool NEGM = (ATT_NEGM != 0) && !MODE_NA && !NOMAX;
    float m = 0.f, l = 0.f;
    constexpr bool LSUM_MFMA = (ATT_LSUM != 0) && (C::NDB == 2);
    f32x16 oL;
#pragma unroll
    for (int r = 0; r < 16; ++r) oL[r] = 0.f;
    const unsigned onesw = (r32 == 0) ? 0x3F803F80u : 0u;
    const bf16x8 onesf = __builtin_bit_cast(bf16x8, (v4u){onesw, onesw, onesw, onesw});
    f32x16 negm;
#pragma unroll
    for (int r = 0; r < 16; ++r) negm[r] = 0.f;
    const int kvm = kvmap(r32);
#define ATT_QK(P, sl) do { const LAS unsigned char* _ks = lds + (sl) * C::SLOT; \
        _Pragma("unroll") for (int _h = 0; _h < 2; ++_h) { \
            _Pragma("unroll") for (int _d0 = 0; _d0 < C::ND0; ++_d0) { const bf16x8 _kf = *(const LAS bf16x8*)(_ks + (2 * _d0 + hi) * 1024 + (32 * _h + kvm) * 16); \
                if (_d0 == 0) P[_h] = __builtin_amdgcn_mfma_f32_32x32x16_bf16(_kf, qf[0], NEGM ? negm : (f32x16){0.f,0.f,0.f,0.f,0.f,0.f,0.f,0.f,0.f,0.f,0.f,0.f,0.f,0.f,0.f,0.f}, 0, 0, 0); \
                else P[_h] = __builtin_amdgcn_mfma_f32_32x32x16_bf16(_kf, qf[_d0], P[_h], 0, 0, 0); } } } while (0)
#define ATT_ACTIVE(t) (!MODE_NA || (t) < ky.na || ((na.r_lo + ((t) - ky.na)) >= nar0 && (na.r_lo + ((t) - ky.na)) < nar0 + 8))
#define ATT_LDV(dst, kc) do { _Pragma("unroll") for (int _db = 0; _db < C::NDB; ++_db) dst[_db] = *(const LAS bf16x8*)(vs + ((_db >> 1) * 8 + 2 * (kc) + hi) * 1024 + ((_db & 1) * 32 + r32) * 16); } while (0)
    int nar0 = 0; if (MODE_NA) { nar0 = na.qr - 4; nar0 = nar0 < 0 ? 0 : (nar0 > 56 ? 56 : nar0); nar0 = __builtin_amdgcn_readfirstlane(nar0); }
    bool naok[2][16];
    if (MODE_NA) { int c0 = na.qc - 8; c0 = c0 < 0 ? 0 : (c0 > 48 ? 48 : c0);
#pragma unroll
        for (int h = 0; h < 2; ++h)
#pragma unroll
            for (int r = 0; r < 16; ++r) naok[h][r] = (unsigned)(32 * h + 16 * (r >> 3) + 8 * hi + (r & 7) - c0) < 16u; }
    f32x16 p[2], pn[2];
    if (C::NPW == 2) ATT_WAITBAR(4); else ATT_WAITBAR(6);
    bool act = ATT_ACTIVE(0);
    if (act) ATT_QK(p, 0);
    int slot = 0;
    for (int t = 0; t < nt; ++t) {
        int s1 = slot + 1; s1 = s1 >= NSLOT ? s1 - NSLOT : s1; int s3 = slot + 3; s3 = s3 >= NSLOT ? s3 - NSLOT : s3;
        if (t + 2 < nt) { if (C::NPW == 2) ATT_WAITBAR(2); else ATT_WAITBAR(3); } else ATT_WAITBAR(0);
        if (t + 3 < nt) ATT_ISSUE(t + 3, s3);
        const bool actn = (t + 1 < nt) && ATT_ACTIVE(t + 1);
        if (actn) ATT_QK(pn, s1);
        if (act) {
            const LAS unsigned char* vs = lds + slot * C::SLOT + C::KB;
            bf16x8 vfa[C::NDB], vfb[C::NDB];
            ATT_LDV(vfa, 0); ATT_LDV(vfb, 1);
            __builtin_amdgcn_sched_barrier(0);
            if (MODE_NA) { if (t >= ky.na) {
                const int kr = na.r_lo + (t - ky.na);
                const LAS float* brow = na.bias + (kr - na.qr + 7) * 128 + 63 - na.qc + 8 * hi;
#pragma unroll
                for (int h = 0; h < 2; ++h) { float bb[16];
#pragma unroll
                    for (int r = 0; r < 16; ++r) bb[r] = brow[32 * h + 16 * (r >> 3) + (r & 7)];
#pragma unroll
                    for (int r = 0; r < 16; ++r) { const float pb = p[h][r] + bb[r]; p[h][r] = naok[h][r] ? pb : NEG_BIG; } } } }
            if (!NOMAX) {
            float mt = max3f(p[0][0], p[1][0], p[0][1]), mu = max3f(p[1][1], p[0][2], p[1][2]);
#pragma unroll
            for (int r = 3; r < 15; r += 2) { mt = max3f(mt, p[0][r], p[1][r]); mu = max3f(mu, p[0][r + 1], p[1][r + 1]); }
            mt = max3f(mt, p[0][15], p[1][15]); mt = max3f(mt, mu, mu);
            { const auto rr = __builtin_amdgcn_permlane32_swap(__float_as_uint(mt), __float_as_uint(mt), false, false);
              mt = max3f(mt, __uint_as_float(rr[0]), __uint_as_float(rr[1])); }
            if (!NEGM) mt -= m;
            if (__any(mt > THR)) {
                const float dl = fmaxf(mt, 0.f), al = __builtin_amdgcn_exp2f(-dl); m += dl; l *= al;
                if (NEGM) {
#pragma unroll
                for (int h = 0; h < 2; ++h)
#pragma unroll
                    for (int r = 0; r < 16; ++r) { p[h][r] -= dl; if (actn) pn[h][r] -= dl; } }
#pragma unroll
                for (int db = 0; db < C::NDB; ++db)
#pragma unroll
                    for (int r = 0; r < 16; ++r) oT[db][r] *= al;
                if (LSUM_MFMA) oL[0] *= al;
#pragma unroll
                for (int r = 0; r < 16; ++r) negm[r] = -m; } }
            float sacc = 0.f;
#pragma unroll
            for (int kc = 0; kc < 4; ++kc) { const int h = kc >> 1, b = 8 * (kc & 1);
#pragma unroll
                for (int j = 0; j < 8; ++j) { p[h][b + j] = __builtin_amdgcn_exp2f((NEGM || NOMAX) ? p[h][b + j] : p[h][b + j] - m); if (!LSUM_MFMA) sacc += p[h][b + j]; }
                v4u pw; pw.x = cvt_pk_bf16(p[h][b], p[h][b + 1]); pw.y = cvt_pk_bf16(p[h][b + 2], p[h][b + 3]); pw.z = cvt_pk_bf16(p[h][b + 4], p[h][b + 5]); pw.w = cvt_pk_bf16(p[h][b + 6], p[h][b + 7]);
                const bf16x8 pb = __builtin_bit_cast(bf16x8, pw);
#pragma unroll
                for (int db = 0; db < C::NDB; ++db) oT[db] = __builtin_amdgcn_mfma_f32_32x32x16_bf16((kc & 1) ? vfb[db] : vfa[db], pb, oT[db], 0, 0, 0);
                if (LSUM_MFMA) oL = __builtin_amdgcn_mfma_f32_32x32x16_bf16(onesf, pb, oL, 0, 0, 0);
                if (kc == 0) { ATT_LDV(vfa, 2); } else if (kc == 1) { ATT_LDV(vfb, 3); }
                __builtin_amdgcn_sched_barrier(0); }
            l += sacc;
        }
        if (actn) { p[0] = pn[0]; p[1] = pn[1]; }
        act = actn; slot = s1;
    }
    ATT_WAITBAR(0);
    if (LSUM_MFMA) l = oL[0];
    l_out = l + __shfl_xor(l, 32);
#undef ATT_LDV
#undef ATT_QK
#undef ATT_ACTIVE
#undef ATT_ISSUE
#undef ATT_DMA
}
template <int DK, int DV, bool MODE_NA>
__device__ __forceinline__ void attn_core16(LAS unsigned char* lds, const bf16_t* __restrict__ Qw  , int ldq,
                                            const bf16_t* __restrict__ Kh, int ldk, const bf16_t* __restrict__ VTh, int ldv,
                                            const Keys ky, const NaInfo na  , f32x4 (&o)[DV / 16][2], float (&l_out)[2]) {
    typedef Cfg<DK, DV> C;
    constexpr int NDS = DK / 32, NDB16 = DV / 16;
    int tid_ = threadIdx.x; asm volatile("" : "+v"(tid_));
    const int tid = tid_, lane = tid & 63, q16 = lane & 15, rg = lane >> 4; const int wid = __builtin_amdgcn_readfirstlane(tid >> 6);
    const int nt = ky.na + ky.nb;
    bf16x8 qf[2][NDS];
#pragma unroll
    for (int qb = 0; qb < 2; ++qb)
#pragma unroll
        for (int ds = 0; ds < NDS; ++ds) qf[qb][ds] = *(const bf16x8*)(Qw + (size_t)(16 * qb + q16) * ldq + 32 * ds + 8 * rg);
    const int keyof = 32 * (lane >> 5) + 8 * ((lane & 15) >> 2) + 4 * ((lane >> 4) & 1) + (lane & 3);
    const unsigned voffK = (unsigned)keyof * (unsigned)ldk * 2u, voffV = (unsigned)lane * (unsigned)ldv * 2u;
    const __amdgpu_buffer_rsrc_t srdK = __builtin_amdgcn_make_buffer_rsrc((void*)Kh, (short)0, 0x7FFFFFFF, 0x00020000);
    const __amdgpu_buffer_rsrc_t srdV = __builtin_amdgcn_make_buffer_rsrc((void*)VTh, (short)0, 0x7FFFFFFF, 0x00020000);
    const unsigned ldsb = (unsigned)(size_t)lds;
#define ATT_DMA(m0v, voff, srd, soff) asm volatile("s_mov_b32 m0, %0\n\ts_nop 0\n\tbuffer_load_dwordx4 %1, %2, %3 offen lds" :: "s"(m0v), "v"(voff), "s"(srd), "s"(soff) : "m0", "memory")
    __amdgpu_buffer_rsrc_t psrd[C::NPW]; unsigned pvoff[C::NPW], pcst[C::NPW], pmul[C::NPW], plds[C::NPW];
#pragma unroll
    for (int _j = 0; _j < C::NPW; ++_j) { int _pc = wid + 8 * _j; _pc = _pc < C::NP ? _pc : C::NP - 1; const bool _isk = _pc < C::NPK; const int _pv = _pc - C::NPK;
        psrd[_j] = _isk ? srdK : srdV; pvoff[_j] = _isk ? voffK : voffV;
        pcst[_j] = _isk ? (unsigned)(_pc * 8) * 2u : (unsigned)((_pv >> 3) * 64 * ldv + (_pv & 7) * 8) * 2u;
        pmul[_j] = _isk ? (unsigned)ldk * 2u : 2u;
        plds[_j] = ldsb + (_isk ? _pc * 1024 : C::KB + _pv * 1024); }
#define ATT_ISSUE(t, slot) do { const unsigned _row0 = (unsigned)((t) < ky.na ? ky.ka0 + 64 * (t) : ky.kb0 + 64 * ((t) - ky.na)); const unsigned _sb = (unsigned)(slot) * C::SLOT; \
        _Pragma("unroll") for (int _j = 0; _j < C::NPW; ++_j) ATT_DMA(plds[_j] + _sb, pvoff[_j], psrd[_j], pcst[_j] + _row0 * pmul[_j]); } while (0)
    ATT_ISSUE(0, 0); ATT_ISSUE(1, 1); ATT_ISSUE(2, 2);
#pragma unroll
    for (int db = 0; db < NDB16; ++db)
#pragma unroll
        for (int qb = 0; qb < 2; ++qb) o[db][qb] = (f32x4){0.f, 0.f, 0.f, 0.f};
    f32x4 oL[2] = {(f32x4){0.f, 0.f, 0.f, 0.f}, (f32x4){0.f, 0.f, 0.f, 0.f}};
    const unsigned onesw = (q16 == 0) ? 0x3F803F80u : 0u;
    const bf16x8 onesf = __builtin_bit_cast(bf16x8, (v4u){onesw, onesw, onesw, onesw});
#define ATT_QK(Sx, sl) do { const LAS unsigned char* _ks = lds + (sl) * C::SLOT + rg * 1024 + q16 * 16; \
        _Pragma("unroll") for (int _ds = 0; _ds < NDS; ++_ds) {   \
            _Pragma("unroll") for (int _kb = 0; _kb < 4; ++_kb) { const bf16x8 _kf = *(const LAS bf16x8*)(_ks + _ds * 4096 + _kb * 256); \
                _Pragma("unroll") for (int _qb = 0; _qb < 2; ++_qb) { \
                    if (_ds == 0) Sx[_kb][_qb] = __builtin_amdgcn_mfma_f32_16x16x32_bf16(_kf, qf[_qb][0], (f32x4){0.f, 0.f, 0.f, 0.f}, 0, 0, 0); \
                    else Sx[_kb][_qb] = __builtin_amdgcn_mfma_f32_16x16x32_bf16(_kf, qf[_qb][_ds], Sx[_kb][_qb], 0, 0, 0); } } } } while (0)
#define ATT_ACTIVE(t) (!MODE_NA || (t) < ky.na || ((na.r_lo + ((t) - ky.na)) >= nar0 && (na.r_lo + ((t) - ky.na)) < nar0 + 8))
#define ATT_LDV(dst, st) do { _Pragma("unroll") for (int _db = 0; _db < NDB16; ++_db) dst[_db] = *(const LAS bf16x8*)(vs + ((_db >> 2) * 8 + 4 * (st) + rg) * 1024 + (16 * (_db & 3) + q16) * 16); } while (0)
    int nar0 = 0; if (MODE_NA) { nar0 = na.qr - 4; nar0 = nar0 < 0 ? 0 : (nar0 > 56 ? 56 : nar0); nar0 = __builtin_amdgcn_readfirstlane(nar0); }
    bool naok[4][2][4]; int qcl[2];
    if (MODE_NA) {
#pragma unroll
        for (int qb = 0; qb < 2; ++qb) { qcl[qb] = na.qc + 16 * qb + q16; int c0 = qcl[qb] - 8; c0 = c0 < 0 ? 0 : (c0 > 48 ? 48 : c0);
#pragma unroll
            for (int kb = 0; kb < 4; ++kb)
#pragma unroll
                for (int j = 0; j < 4; ++j) naok[kb][qb][j] = (unsigned)(32 * (kb >> 1) + 8 * rg + 4 * (kb & 1) + j - c0) < 16u; } }
    f32x4 SA[4][2], SB[4][2];
    if (C::NPW == 2) ATT_WAITBAR(4); else ATT_WAITBAR(6);
    bool act = ATT_ACTIVE(0);
    if (act) ATT_QK(SA, 0);
    int slot = 0;
    for (int t0 = 0; t0 < nt; t0 += 2) {
#pragma unroll
      for (int hh = 0; hh < 2; ++hh) {
        f32x4 (&S)[4][2] = hh ? SB : SA; f32x4 (&Sn)[4][2] = hh ? SA : SB;
        const int t = t0 + hh;
        if (t < nt) {
        int s1 = slot + 1; s1 = s1 >= NSLOT ? s1 - NSLOT : s1; int s3 = slot + 3; s3 = s3 >= NSLOT ? s3 - NSLOT : s3;
        if (t + 2 < nt) { if (C::NPW == 2) ATT_WAITBAR(2); else ATT_WAITBAR(3); } else ATT_WAITBAR(0);
        if (t + 3 < nt) ATT_ISSUE(t + 3, s3);
        const bool actn = (t + 1 < nt) && ATT_ACTIVE(t + 1);
        if (actn) ATT_QK(Sn, s1);
        if (act) {
            const LAS unsigned char* vs = lds + slot * C::SLOT + C::KB;
            bf16x8 vfa[NDB16], vfb[NDB16];
            ATT_LDV(vfa, 0); if (NDB16 <= 4) ATT_LDV(vfb, 1);
            __builtin_amdgcn_sched_barrier(0);
            if (MODE_NA) { if (t >= ky.na) {
                const int kr = na.r_lo + (t - ky.na);
#pragma unroll
                for (int qb = 0; qb < 2; ++qb) { const LAS float* brow = na.bias + (kr - na.qr + 7) * 128 + 63 - qcl[qb] + 8 * rg;
#pragma unroll
                    for (int kb = 0; kb < 4; ++kb) { float bb[4];
#pragma unroll
                        for (int j = 0; j < 4; ++j) bb[j] = brow[32 * (kb >> 1) + 4 * (kb & 1) + j];
#pragma unroll
                        for (int j = 0; j < 4; ++j) { const float pb_ = S[kb][qb][j] + bb[j]; S[kb][qb][j] = naok[kb][qb][j] ? pb_ : NEG_BIG; } } } } }
#pragma unroll
            for (int st = 0; st < 2; ++st) {
#pragma unroll
                for (int qb = 0; qb < 2; ++qb) {
                    float e[8];
#pragma unroll
                    for (int j = 0; j < 4; ++j) { e[j] = __builtin_amdgcn_exp2f(S[2 * st][qb][j]); e[4 + j] = __builtin_amdgcn_exp2f(S[2 * st + 1][qb][j]); }
                    v4u pw; pw.x = cvt_pk_bf16(e[0], e[1]); pw.y = cvt_pk_bf16(e[2], e[3]); pw.z = cvt_pk_bf16(e[4], e[5]); pw.w = cvt_pk_bf16(e[6], e[7]);
                    const bf16x8 pb = __builtin_bit_cast(bf16x8, pw);
#pragma unroll
                    for (int db = 0; db < NDB16; ++db) o[db][qb] = __builtin_amdgcn_mfma_f32_16x16x32_bf16((st && NDB16 <= 4) ? vfb[db] : vfa[db], pb, o[db][qb], 0, 0, 0);
                    oL[qb] = __builtin_amdgcn_mfma_f32_16x16x32_bf16(onesf, pb, oL[qb], 0, 0, 0);
                }
                if (NDB16 > 4 && st == 0) ATT_LDV(vfa, 1);
                __builtin_amdgcn_sched_barrier(0); }
        }
        act = actn; slot = s1;
        } }
    }
    ATT_WAITBAR(0);
#pragma unroll
    for (int qb = 0; qb < 2; ++qb) l_out[qb] = __shfl(oL[qb][0], q16);
#undef ATT_LDV
#undef ATT_QK
#undef ATT_ACTIVE
#undef ATT_ISSUE
#undef ATT_DMA
}
template <int NDB16>
__device__ __forceinline__ void store_o16(const f32x4 (&o)[NDB16][2], const float (&scale)[2], bf16_t* Ow  , int q16, int rg) {
#pragma unroll
    for (int qb = 0; qb < 2; ++qb)
#pragma unroll
        for (int i = 0; i < NDB16 / 2; ++i) { const f32x4 va = o[2 * i][qb] * scale[qb], vb = o[2 * i + 1][qb] * scale[qb];
            const unsigned ax = cvt_pk_bf16(va[0], va[1]), ay = cvt_pk_bf16(va[2], va[3]), bx = cvt_pk_bf16(vb[0], vb[1]), by = cvt_pk_bf16(vb[2], vb[3]);
            const auto sx = __builtin_amdgcn_permlane16_swap(ax, bx, false, false);
            const auto sy = __builtin_amdgcn_permlane16_swap(ay, by, false, false);
            v4u w; w.x = sx[0]; w.y = sy[0]; w.z = sx[1]; w.w = sy[1];
            const int col = (rg & 1) ? 16 * (2 * i + 1) + 4 * (rg - 1) : 16 * (2 * i) + 4 * rg;
            *(v4u*)(Ow + (size_t)(16 * qb + q16) * D + col) = w; }
}
template <int NDB>
__device__ __forceinline__ void store_o(const f32x16 (&oT)[NDB], float scale, bf16_t* Op  , int hi) {
#pragma unroll
    for (int db = 0; db < NDB; ++db)
#pragma unroll
        for (int k = 0; k < 2; ++k) { const int g0 = 2 * k, g1 = 2 * k + 1;
            const unsigned w0x = cvt_pk_bf16(oT[db][4 * g0] * scale, oT[db][4 * g0 + 1] * scale), w0y = cvt_pk_bf16(oT[db][4 * g0 + 2] * scale, oT[db][4 * g0 + 3] * scale);
            const unsigned w1x = cvt_pk_bf16(oT[db][4 * g1] * scale, oT[db][4 * g1 + 1] * scale), w1y = cvt_pk_bf16(oT[db][4 * g1 + 2] * scale, oT[db][4 * g1 + 3] * scale);
            const auto sx = __builtin_amdgcn_permlane32_swap(w0x, w1x, false, false);
            const auto sy = __builtin_amdgcn_permlane32_swap(w0y, w1y, false, false);
            v4u w; w.x = sx[0]; w.y = sy[0]; w.z = sx[1]; w.w = sy[1];
            *(v4u*)(Op + 32 * db + 16 * k + 8 * hi) = w; }
}
}
namespace ew {
using namespace mk;

__device__ __forceinline__ void conv_item(const float* __restrict__ W, int ldw, int k0, int n0, int nvalid, bf16_t* __restrict__ dst, int dK, LAS float* scr, int lane) {
    const int n4 = (lane & 15) * 4, kr = lane >> 4;
#pragma unroll
    for (int i = 0; i < 8; ++i) { const int k = kr + 4 * i;
        f32x4 v = (f32x4){0.f, 0.f, 0.f, 0.f};
        if (n4 < nvalid) v = *(const f32x4*)(W + (size_t)(k0 + k) * ldw + n0 + n4);
        scr[k * 65 + n4] = v.x; scr[k * 65 + n4 + 1] = v.y; scr[k * 65 + n4 + 2] = v.z; scr[k * 65 + n4 + 3] = v.w; }
    LDS_WAIT(); asm volatile("" ::: "memory");
    const int c = lane & 3;
#pragma unroll
    for (int j = 0; j < 4; ++j) { const int n = (lane >> 2) + 16 * j; const LAS float* s = scr + (8 * c) * 65 + n;
        v4u o; o.x = cvt_pk_bf16(s[0], s[65]); o.y = cvt_pk_bf16(s[2 * 65], s[3 * 65]); o.z = cvt_pk_bf16(s[4 * 65], s[5 * 65]); o.w = cvt_pk_bf16(s[6 * 65], s[7 * 65]);
        if (n < nvalid) *(v4u*)(dst + (size_t)n * dK + k0 + 8 * c) = o; }
    LDS_WAIT(); asm volatile("" ::: "memory");
}

__device__ __forceinline__ void conv_load(const float* __restrict__ src, int ldw, int nvalid, f32x4 (&v)[8], int lane) {
    const int n4 = (lane & 15) * 4, kr = lane >> 4;
#pragma unroll
    for (int i = 0; i < 8; ++i) { v[i] = (f32x4){0.f, 0.f, 0.f, 0.f}; if (n4 < nvalid) v[i] = *(const f32x4*)(src + (size_t)(kr + 4 * i) * ldw + n4); }
}
__device__ __forceinline__ void conv_store(const f32x4 (&v)[8], unsigned char* __restrict__ dst, int dkb, int nvalid, float scale, int hi_jump, LAS float* scr, int lane) {
    const int n4 = (lane & 15) * 4, kr = lane >> 4;
#pragma unroll
    for (int i = 0; i < 8; ++i) { const int k = kr + 4 * i; scr[k * 65 + n4] = v[i].x; scr[k * 65 + n4 + 1] = v[i].y; scr[k * 65 + n4 + 2] = v[i].z; scr[k * 65 + n4 + 3] = v[i].w; }
    LDS_WAIT(); asm volatile("" ::: "memory");
    const int c = lane & 3;
#pragma unroll
    for (int j = 0; j < 4; ++j) { const int n = (lane >> 2) + 16 * j; const LAS float* s = scr + (8 * c) * 65 + n;
        if (scale == 0.f) { v4u o; o.x = cvt_pk_bf16(s[0], s[65]); o.y = cvt_pk_bf16(s[2 * 65], s[3 * 65]); o.z = cvt_pk_bf16(s[4 * 65], s[5 * 65]); o.w = cvt_pk_bf16(s[6 * 65], s[7 * 65]);
            if (n < nvalid) *(v4u*)(dst + (size_t)(n + (n >= 32 ? hi_jump : 0)) * dkb + 16 * c) = o; }
        else { v2u o; o.x = cvt4_fp8(s[0] * scale, s[65] * scale, s[2 * 65] * scale, s[3 * 65] * scale); o.y = cvt4_fp8(s[4 * 65] * scale, s[5 * 65] * scale, s[6 * 65] * scale, s[7 * 65] * scale);
            *(v2u*)(dst + (size_t)n * dkb + 8 * c) = o; } }
    LDS_WAIT(); asm volatile("" ::: "memory");
}
__device__ __forceinline__ void conv_load64(const float* __restrict__ src, int ldw, f32x4 (&v)[8], int lane) {
    const int n4 = (lane & 7) * 4, kr = lane >> 3;
#pragma unroll
    for (int i = 0; i < 8; ++i) v[i] = *(const f32x4*)(src + (size_t)(kr + 8 * i) * ldw + n4);
}
__device__ __forceinline__ void conv_store64_f8(const f32x4 (&v)[8], unsigned char* __restrict__ dst, int dkb, float scale, LAS float* scr, int lane) {
    const int n4 = (lane & 7) * 4, kr = lane >> 3;
#pragma unroll
    for (int i = 0; i < 8; ++i) { const int k = kr + 8 * i; scr[k * 33 + n4] = v[i].x; scr[k * 33 + n4 + 1] = v[i].y; scr[k * 33 + n4 + 2] = v[i].z; scr[k * 33 + n4 + 3] = v[i].w; }
    LDS_WAIT(); asm volatile("" ::: "memory");
    const int c = lane & 7;
#pragma unroll
    for (int j = 0; j < 4; ++j) { const int n = (lane >> 3) + 8 * j; const LAS float* s = scr + (8 * c) * 33 + n;
        v2u o; o.x = cvt4_fp8(s[0] * scale, s[33] * scale, s[2 * 33] * scale, s[3 * 33] * scale); o.y = cvt4_fp8(s[4 * 33] * scale, s[5 * 33] * scale, s[6 * 33] * scale, s[7 * 33] * scale);
        *(v2u*)(dst + (size_t)n * dkb + 8 * c) = o; }
    LDS_WAIT(); asm volatile("" ::: "memory");
}
__device__ __forceinline__ void conv_item_f8(const float* __restrict__ W, int ldw, int k0, int n0, unsigned char* __restrict__ dst, int dKb, float scale, LAS float* scr, int lane) {
    const int n4 = (lane & 15) * 4, kr = lane >> 4;
#pragma unroll
    for (int i = 0; i < 8; ++i) { const int k = kr + 4 * i;
        const f32x4 v = *(const f32x4*)(W + (size_t)(k0 + k) * ldw + n0 + n4);
        scr[k * 65 + n4] = v.x; scr[k * 65 + n4 + 1] = v.y; scr[k * 65 + n4 + 2] = v.z; scr[k * 65 + n4 + 3] = v.w; }
    LDS_WAIT(); asm volatile("" ::: "memory");
    const int c = lane & 3;
#pragma unroll
    for (int j = 0; j < 4; ++j) { const int n = (lane >> 2) + 16 * j; const LAS float* s = scr + (8 * c) * 65 + n;
        v2u o; o.x = cvt4_fp8(s[0] * scale, s[65] * scale, s[2 * 65] * scale, s[3 * 65] * scale); o.y = cvt4_fp8(s[4 * 65] * scale, s[5 * 65] * scale, s[6 * 65] * scale, s[7 * 65] * scale);
        *(v2u*)(dst + (size_t)n * dKb + k0 + 8 * c) = o; }
    LDS_WAIT(); asm volatile("" ::: "memory");
}

__device__ __forceinline__ void normmod_row(const float* __restrict__ xrow, const float* __restrict__ g, const float* __restrict__ sh, const float* __restrict__ sc, bf16_t* __restrict__ orow, int lane) {
    const f32x4* xr = (const f32x4*)xrow + lane;
    f32x4 v[4]; float s = 0.f;
#pragma unroll
    for (int j = 0; j < 4; ++j) { v[j] = xr[64 * j]; s += (v[j].x * v[j].x + v[j].y * v[j].y) + (v[j].z * v[j].z + v[j].w * v[j].w); }
    const float rstd = rsqrtf(wave_sum(s) * (1.f / D) + EPS);
    v2u* o8 = (v2u*)orow + lane;
#pragma unroll
    for (int j = 0; j < 4; ++j) { const f32x4 gg = ((const f32x4*)g)[lane + 64 * j], s1 = ((const f32x4*)sc)[lane + 64 * j], s0 = ((const f32x4*)sh)[lane + 64 * j];
        const f32x4 y = v[j] * rstd * gg * (s1 + 1.f) + s0;
        v2u w; w.x = cvt_pk_bf16(y.x, y.y); w.y = cvt_pk_bf16(y.z, y.w); o8[64 * j] = w; }
}

__device__ __forceinline__ void unpack8(const v4u w, float (&f)[8]);
__device__ __forceinline__ v4u pack8(const float (&f)[8]);
__device__ __forceinline__ void normmod_row_bf(const bf16_t* __restrict__ xrow, const float* __restrict__ g, const float* __restrict__ sh, const float* __restrict__ sc, bf16_t* __restrict__ orow, int lane) {
    float f[2][8]; float s = 0.f;
#pragma unroll
    for (int j = 0; j < 2; ++j) { unpack8(*((const v4u*)xrow + lane + 64 * j), f[j]);
#pragma unroll
        for (int q = 0; q < 8; ++q) s += f[j][q] * f[j][q]; }
    const float rstd = rsqrtf(wave_sum(s) * (1.f / D) + EPS);
#pragma unroll
    for (int j = 0; j < 2; ++j) { const int c = 8 * lane + 512 * j;
#pragma unroll
        for (int h = 0; h < 2; ++h) { const f32x4 gg = *(const f32x4*)(g + c + 4 * h), s1 = *(const f32x4*)(sc + c + 4 * h), s0 = *(const f32x4*)(sh + c + 4 * h);
#pragma unroll
            for (int q = 0; q < 4; ++q) f[j][4 * h + q] = f[j][4 * h + q] * rstd * gg[q] * (s1[q] + 1.f) + s0[q]; }
        *((v4u*)orow + lane + 64 * j) = pack8(f[j]); }
}

struct RowRegs { f32x4 v[4]; v4u w[2]; };
template <bool BF> __device__ __forceinline__ void nm_load(const void* xrow, RowRegs& R, int lane) {
    if (BF) { R.w[0] = *((const v4u*)xrow + lane); R.w[1] = *((const v4u*)xrow + lane + 64); }
    else {
#pragma unroll
        for (int j = 0; j < 4; ++j) R.v[j] = ((const f32x4*)xrow)[lane + 64 * j]; }
}
template <bool BF> __device__ __forceinline__ void nm_finish(const RowRegs& R, const float* __restrict__ g, const float* __restrict__ sh, const float* __restrict__ sc, bf16_t* __restrict__ orow, int lane) {
    if (BF) {
        float f[2][8]; float s = 0.f;
#pragma unroll
        for (int j = 0; j < 2; ++j) { unpack8(R.w[j], f[j]);
#pragma unroll
            for (int q = 0; q < 8; ++q) s += f[j][q] * f[j][q]; }
        const float rstd = rsqrtf(wave_sum(s) * (1.f / D) + EPS);
#pragma unroll
        for (int j = 0; j < 2; ++j) { const int c = 8 * lane + 512 * j;
#pragma unroll
            for (int h = 0; h < 2; ++h) { const f32x4 gg = *(const f32x4*)(g + c + 4 * h), s1 = *(const f32x4*)(sc + c + 4 * h), s0 = *(const f32x4*)(sh + c + 4 * h);
#pragma unroll
                for (int q = 0; q < 4; ++q) f[j][4 * h + q] = f[j][4 * h + q] * rstd * gg[q] * (s1[q] + 1.f) + s0[q]; }
            *((v4u*)orow + lane + 64 * j) = pack8(f[j]); }
    } else {
        float s = 0.f;
#pragma unroll
        for (int j = 0; j < 4; ++j) s += (R.v[j].x * R.v[j].x + R.v[j].y * R.v[j].y) + (R.v[j].z * R.v[j].z + R.v[j].w * R.v[j].w);
        const float rstd = rsqrtf(wave_sum(s) * (1.f / D) + EPS);
        v2u* o8 = (v2u*)orow + lane;
#pragma unroll
        for (int j = 0; j < 4; ++j) { const f32x4 gg = ((const f32x4*)g)[lane + 64 * j], s1 = ((const f32x4*)sc)[lane + 64 * j], s0 = ((const f32x4*)sh)[lane + 64 * j];
            const f32x4 y = R.v[j] * rstd * gg * (s1 + 1.f) + s0;
            v2u w; w.x = cvt_pk_bf16(y.x, y.y); w.y = cvt_pk_bf16(y.z, y.w); o8[64 * j] = w; }
    }
}
struct ModRegs { f32x4 mul[4], add[4]; };
template <bool BF> __device__ __forceinline__ void nm_mod_load(ModRegs& M, const float* __restrict__ g, const float* __restrict__ sh, const float* __restrict__ sc, int lane) {
#pragma unroll
    for (int k = 0; k < 4; ++k) { const int c = BF ? 8 * lane + 512 * (k >> 1) + 4 * (k & 1) : 4 * lane + 256 * k;
        M.mul[k] = *(const f32x4*)(g + c) * (*(const f32x4*)(sc + c) + 1.f); M.add[k] = *(const f32x4*)(sh + c); }
}
template <bool BF> __device__ __forceinline__ void nm_finish_m(const RowRegs& R, const ModRegs& M, bf16_t* __restrict__ orow, int lane) {
    if (BF) {
        float f[2][8]; float s = 0.f;
#pragma unroll
        for (int j = 0; j < 2; ++j) { unpack8(R.w[j], f[j]);
#pragma unroll
            for (int q = 0; q < 8; ++q) s += f[j][q] * f[j][q]; }
        const float rstd = rsqrtf(wave_sum(s) * (1.f / D) + EPS);
#pragma unroll
        for (int j = 0; j < 2; ++j) {
#pragma unroll
            for (int h = 0; h < 2; ++h)
#pragma unroll
                for (int q = 0; q < 4; ++q) f[j][4 * h + q] = f[j][4 * h + q] * rstd * M.mul[2 * j + h][q] + M.add[2 * j + h][q];
            *((v4u*)orow + lane + 64 * j) = pack8(f[j]); }
    } else {
        float s = 0.f;
#pragma unroll
        for (int j = 0; j < 4; ++j) s += (R.v[j].x * R.v[j].x + R.v[j].y * R.v[j].y) + (R.v[j].z * R.v[j].z + R.v[j].w * R.v[j].w);
        const float rstd = rsqrtf(wave_sum(s) * (1.f / D) + EPS);
        v2u* o8 = (v2u*)orow + lane;
#pragma unroll
        for (int j = 0; j < 4; ++j) { const f32x4 y = R.v[j] * rstd * M.mul[j] + M.add[j];
            v2u w; w.x = cvt_pk_bf16(y.x, y.y); w.y = cvt_pk_bf16(y.z, y.w); o8[64 * j] = w; }
    }
}
__device__ __forceinline__ void unpack8(const v4u w, float (&f)[8]) { f[0] = bflo(w.x); f[1] = bfhi(w.x); f[2] = bflo(w.y); f[3] = bfhi(w.y); f[4] = bflo(w.z); f[5] = bfhi(w.z); f[6] = bflo(w.w); f[7] = bfhi(w.w); }
__device__ __forceinline__ v4u pack8(const float (&f)[8]) { v4u w; w.x = cvt_pk_bf16(f[0], f[1]); w.y = cvt_pk_bf16(f[2], f[3]); w.z = cvt_pk_bf16(f[4], f[5]); w.w = cvt_pk_bf16(f[6], f[7]); return w; }

struct Rope { const f32x2* t64; const f32x2* t32; };

__device__ __forceinline__ void seg64(float (&f)[8], int lane, const float (&g8)[8]  , bool rope, int gr, int gc, const Rope& R, float scale) {
    const int s = lane & 7;
    float ss = 0.f;
#pragma unroll
    for (int j = 0; j < 8; ++j) ss += f[j] * f[j];
    ss = sum8_f(ss);
    const float rstd = rsqrtf(ss * (1.f / 64.f) + EPS);
#pragma unroll
    for (int j = 0; j < 8; ++j) f[j] = f[j] * rstd * g8[j];
    float pr[8];
#pragma unroll
    for (int j = 0; j < 8; ++j) pr[j] = xor2_f(f[j]);
    if (rope) {
        const int pos = (s >> 2) ? gc : gr; const bool x1 = (s & 3) < 2; const int i0 = 8 * (s & 1);
#pragma unroll
        for (int j = 0; j < 8; ++j) { const f32x2 cs = R.t64[pos * 16 + i0 + j]; f[j] = x1 ? (f[j] * cs.x - pr[j] * cs.y) : (pr[j] * cs.y + f[j] * cs.x); }
    }
#pragma unroll
    for (int j = 0; j < 8; ++j) f[j] *= scale;
}
}
namespace mk {
constexpr size_t MiB = (size_t)1 << 20;
constexpr size_t WS_CTL = 0, CTL_ZERO_BYTES = 1 * MiB;
constexpr size_t WS_MODF = 1 * MiB;
constexpr size_t WS_ROPE = 2 * MiB;
constexpr size_t WS_SLOT_TOK = 3 * MiB;
constexpr size_t WS_SLOT_G = 5 * MiB;
constexpr size_t WS_XC = 8 * MiB;
constexpr size_t WS_WQK0 = 16 * MiB, WS_WV0 = 20 * MiB, WS_WO0 = 22 * MiB, WS_WGU0 = 24 * MiB, WS_WD0 = 35 * MiB;
constexpr size_t WS_WODD = 41 * MiB, WS_WVC = 43 * MiB + 512 * 1024, WS_WO1 = 44 * MiB, WS_WUQ = 46 * MiB, WS_WUKN = 46 * MiB + 512 * 1024, WS_WUKV = 46 * MiB + 640 * 1024;
constexpr size_t WS_W13 = 48 * MiB, WS_W2 = 104 * MiB;
#ifndef MK_CONV_P2
#define MK_CONV_P2 7680
#endif
#ifndef MK_CONV_P5
#define MK_CONV_P5 10752
#endif
#ifndef MK_CONV_P7
#define MK_CONV_P7 1920
#endif
#ifndef MK_CONV_P8
#define MK_CONV_P8 14336
#endif
#ifndef MK_CONV_P10
#define MK_CONV_P10 8320
#endif
constexpr float W13_SCALE = 256.f, W2_SCALE = 512.f, ACT_SCALE = 16.f;
constexpr size_t WS_XB = 216 * MiB;
constexpr size_t OUT_H = 0, OUT_CQN = 0, OUT_CKVN = 17 * MiB, OUT_KN = 26 * MiB;
constexpr size_t WS_BIG = 284 * MiB;
constexpr size_t WS_QK0 = WS_BIG, WS_VT0 = 420 * MiB, WS_DSCR = 488 * MiB, WS_MID0 = WS_BIG;
constexpr size_t WS_P1 = WS_BIG, WS_VT1C = 369 * MiB, WS_QD = 386 * MiB, WS_VT1D = 434 * MiB, WS_KDF = 468 * MiB, WS_MID1 = WS_BIG;
constexpr size_t WS_END = 522 * MiB;
constexpr int CW_TMO = 0, CW_GCNT = 64, CW_BAR = 4096;
constexpr int RING_BYTES = 131072, LDSCTL_OFF = RING_BYTES, MISC_OFF = LDSCTL_OFF + 320, LDS_BYTES = 147456;
constexpr int P1LD = 1280;
constexpr float QSCALE64 = 0.125f * LOG2E, QSCALE96 = 0.10206207261596575f * LOG2E;
constexpr int NPHASE = 22;
}

#define XB_TMO      128
#define XB_XCNT(j)  (256  + 64 * (j))
#define XB_XSUB(j)  (1280 + 64 * (j))
#define XB_XGEN(j)  (2304 + 64 * (j))
#define XB_TOP      3328
#define XB_TOPGEN   3392
#define XCD_BAR_WORDS 3456
#define XB_SPIN_CAP (1u << 18)

__device__ __forceinline__ unsigned xb_ld(unsigned* p)              { return __hip_atomic_load(p, __ATOMIC_RELAXED, __HIP_MEMORY_SCOPE_AGENT); }
__device__ __forceinline__ unsigned xb_add(unsigned* p, unsigned v) { return __hip_atomic_fetch_add(p, v, __ATOMIC_RELAXED, __HIP_MEMORY_SCOPE_AGENT); }
__device__ __forceinline__ unsigned xb_xcc_id() { return (unsigned)__builtin_amdgcn_s_getreg((3 << 11) | 20) & 0xFu; }
#define XB_SPIN(cond, bar) do { unsigned _sp = 0; while (cond) { __builtin_amdgcn_s_sleep(1); \
    if ((++_sp & 255u) == 0u) { if (xb_ld(&(bar)[XB_TMO])) break; if (_sp > XB_SPIN_CAP) { atomicAdd(&(bar)[XB_TMO], 1u); break; } } } } while (0)

struct XcdBarrier {
    unsigned* bar; unsigned x;
    volatile LAS unsigned* st;
};

__device__ __forceinline__ XcdBarrier xcd_barrier_post(unsigned* bar, volatile LAS unsigned* st) {
    XcdBarrier b; b.bar = bar; b.x = xb_xcc_id(); b.st = st;
    if (threadIdx.x == 0) (void)xb_add(&bar[XB_XCNT(b.x)], 1u);
    return b;
}
__device__ __forceinline__ void xcd_barrier_complete(unsigned* bar, unsigned x, unsigned& nloc, unsigned& nx) {
    const unsigned G = gridDim.x * gridDim.y * gridDim.z;
    unsigned sum, cnt, mine, sp = 0u;
    for (;;) {
        sum = 0u; cnt = 0u; mine = 0u;
#pragma unroll
        for (unsigned j = 0; j < 16; ++j) { const unsigned c = xb_ld(&bar[XB_XCNT(j)]); sum += c; cnt += (c > 0u) ? 1u : 0u; mine = (j == x) ? c : mine; }
        if (sum == G) break;
        __builtin_amdgcn_s_sleep(1);
        if ((++sp & 255u) == 0u) { if (xb_ld(&bar[XB_TMO])) break; if (sp > XB_SPIN_CAP) { atomicAdd(&bar[XB_TMO], 1u); break; } }
    }
    nloc = mine > 0u ? mine : 1u; nx = cnt > 0u ? cnt : 1u;
}

__device__ __forceinline__ void xcd_barrier(const XcdBarrier& b) {
    asm volatile("s_waitcnt vmcnt(0)" ::: "memory");
    __syncthreads();
    if (threadIdx.x == 0) {
        unsigned* bar = b.bar;
        __builtin_amdgcn_s_waitcnt(0);
        unsigned nloc = b.st[0], nx = b.st[1];
        if (nloc == 0u) { xcd_barrier_complete(bar, b.x, nloc, nx); b.st[0] = nloc; b.st[1] = nx; }
        const unsigned old = xb_add(&bar[XB_XSUB(b.x)], 1u);
        const unsigned gen = old / nloc;
        if (old + 1u == (gen + 1u) * nloc) {
            __builtin_amdgcn_fence(__ATOMIC_RELEASE, "agent");
            asm volatile("s_waitcnt vmcnt(0)" ::: "memory");
            const unsigned og = xb_add(&bar[XB_TOP], 1u);
            const unsigned tg = og / nx;
            if (og + 1u == (tg + 1u) * nx) xb_add(&bar[XB_TOPGEN], 1u);
            else XB_SPIN(xb_ld(&bar[XB_TOPGEN]) == tg, bar);
            __builtin_amdgcn_fence(__ATOMIC_ACQUIRE, "agent");
            xb_add(&bar[XB_XGEN(b.x)], 1u);
            asm volatile("s_waitcnt vmcnt(0)" ::: "memory");
        } else {
            XB_SPIN(xb_ld(&bar[XB_XGEN(b.x)]) == gen, bar);
            __builtin_amdgcn_fence(__ATOMIC_ACQUIRE, "agent");
            asm volatile("s_waitcnt vmcnt(0)" ::: "memory");
        }
    }
    __syncthreads();
}


namespace mk {
struct Args { const float* in[37]; float* out; unsigned char* ws; int ph_lo, ph_hi; };

struct Frame {
    LAS unsigned char* lds; volatile LAS unsigned* MISC; gu32* ctl;
    int tid, lane, wave, G, vcu, gw, NGW;
};

constexpr int I_EVIN = 32 * 48, I_EVOUT = 32 * 16, I_FG = 32 * 44, I_FU = 32 * 44, I_FD = 88 * 16, I_ODIN = 32 * 19, I_ODOUT = 32 * 16, I_UQ = 8 * 12, I_UKV = 4 * 16;
constexpr int I_W1 = 32 * 56, I_W2 = 112 * 16;
constexpr int I_SMALL = I_EVIN + I_EVOUT + I_FG + I_FU + I_FD + I_ODIN + I_ODOUT + I_UQ + I_UKV;
constexpr int I_TOTAL = I_SMALL + 8 * (2 * I_W1 + I_W2);
constexpr int SM_CNT_P0 = I_EVIN + I_EVOUT, SM_CNT_P2 = I_FG + I_FU, SM_CNT_P7 = I_SMALL - SM_CNT_P0 - SM_CNT_P2;
__device__ __forceinline__ void conv_small_span(Frame& F, const Args& a, int base, int count, int w, int NW) {
    unsigned char* ws = a.ws;
    LAS float* scr = (LAS float*)(F.lds + 61440 + F.wave * 8448);
#define P0_DECODE(it_, SRC, LDW, DST, DKB, NV, SCL, JMP) do { int r = (it_); NV = 64; SCL = 0.f; JMP = 0; \
        if (r < I_EVIN) { const int kb = r / 48, nb = r % 48, n0 = nb * 64; bf16_t* d_; \
              \
            if (n0 < 1024 || (n0 >= 1536 && n0 < 2560)) { const int lc = n0 < 1024 ? n0 : n0 - 512; d_ = (bf16_t*)(ws + WS_WQK0) + (size_t)((lc >> 8) * 256 + ((lc >> 6) & 3) * 32) * D; JMP = 96; } \
            else if (n0 < 1536) d_ = (bf16_t*)(ws + WS_WV0) + (size_t)(n0 - 1024) * D; else d_ = (bf16_t*)(ws + WS_WV0) + (size_t)(n0 - 2048) * D; \
            SRC = a.in[8] + (size_t)(kb * 32) * 3072 + n0; LDW = 3072; DST = (unsigned char*)(d_ + kb * 32); DKB = D * 2; break; } r -= I_EVIN; \
        if (r < I_EVOUT) { const int kb = r / 16, n0 = (r % 16) * 64; SRC = a.in[9] + (size_t)(kb * 32) * D + n0; LDW = D; DST = (unsigned char*)((bf16_t*)(ws + WS_WO0) + (size_t)n0 * D + kb * 32); DKB = D * 2; break; } r -= I_EVOUT; \
        if (r < I_FG) { const int kb = r / 44, n0 = (r % 44) * 64; SRC = a.in[20] + (size_t)(kb * 32) * 2816 + n0; LDW = 2816; DST = (unsigned char*)((bf16_t*)(ws + WS_WGU0) + (size_t)((n0 >> 7) * 256 + (n0 & 127)) * D + kb * 32); DKB = D * 2; break; } r -= I_FG; \
        if (r < I_FU) { const int kb = r / 44, n0 = (r % 44) * 64; SRC = a.in[21] + (size_t)(kb * 32) * 2816 + n0; LDW = 2816; DST = (unsigned char*)((bf16_t*)(ws + WS_WGU0) + (size_t)((n0 >> 7) * 256 + 128 + (n0 & 127)) * D + kb * 32); DKB = D * 2; break; } r -= I_FU; \
        if (r < I_FD) { const int kb = r / 16, n0 = (r % 16) * 64; SRC = a.in[22] + (size_t)(kb * 32) * D + n0; LDW = D; DST = ws + WS_WD0 + (size_t)n0 * 2816 + kb * 32; DKB = 2816; SCL = W2_SCALE; break; } r -= I_FD; \
        if (r < I_ODIN) { const int kb = r / 19, nb = r % 19, n0 = nb * 64; bf16_t* d_; \
            if (n0 < 512) d_ = (bf16_t*)(ws + WS_WODD) + (size_t)n0 * D; else if (n0 < 640) d_ = (bf16_t*)(ws + WS_WODD) + (size_t)(n0 + 256) * D; \
            else if (n0 < 768) d_ = (bf16_t*)(ws + WS_WVC) + (size_t)(n0 - 640) * D; else if (n0 < 1024) d_ = (bf16_t*)(ws + WS_WODD) + (size_t)(n0 - 256) * D; \
            else if (n0 < 1152) d_ = (bf16_t*)(ws + WS_WODD) + (size_t)(n0 - 128) * D; else { d_ = (bf16_t*)(ws + WS_WODD) + (size_t)(n0 - 128) * D; NV = 32; } \
            SRC = a.in[23] + (size_t)(kb * 32) * 1184 + n0; LDW = 1184; DST = (unsigned char*)(d_ + kb * 32); DKB = D * 2; break; } r -= I_ODIN; \
        if (r < I_ODOUT) { const int kb = r / 16, n0 = (r % 16) * 64; SRC = a.in[24] + (size_t)(kb * 32) * D + n0; LDW = D; DST = (unsigned char*)((bf16_t*)(ws + WS_WO1) + (size_t)n0 * D + kb * 32); DKB = D * 2; break; } r -= I_ODOUT; \
        if (r < I_UQ) { const int kb = r / 12, n0 = (r % 12) * 64; SRC = a.in[28] + (size_t)(kb * 32) * 768 + n0; LDW = 768; DST = (unsigned char*)((bf16_t*)(ws + WS_WUQ) + (size_t)n0 * 256 + kb * 32); DKB = 256 * 2; break; } r -= I_UQ; \
        if (r < I_UKV) { const int kb = r / 16, nb = r % 16, n0 = nb * 64, h = nb >> 1; \
            bf16_t* d_ = (nb & 1) ? (bf16_t*)(ws + WS_WUKV) + (size_t)(h * 64) * 128 : (bf16_t*)(ws + WS_WUKN) + (size_t)(h * 64) * 128; \
            SRC = a.in[30] + (size_t)(kb * 32) * 1024 + n0; LDW = 1024; DST = (unsigned char*)(d_ + kb * 32); DKB = 128 * 2; break; } r -= I_UKV; \
        { const int e = r / (2 * I_W1 + I_W2); int q = r % (2 * I_W1 + I_W2); \
          if (q < 2 * I_W1) { const int up = q >= I_W1; if (up) q -= I_W1; const int kb = q / 56, n0 = (q % 56) * 64; \
              SRC = a.in[up ? 35 : 34] + (size_t)e * D * 3584 + (size_t)(kb * 32) * 3584 + n0; LDW = 3584; DST = ws + WS_W13 + ((size_t)e * 7168 + (n0 >> 7) * 256 + (up ? 128 : 0) + (n0 & 127)) * D + kb * 32; DKB = D; SCL = W13_SCALE; } \
          else { q -= 2 * I_W1; const int kb = q / 16, n0 = (q % 16) * 64; \
              SRC = a.in[36] + (size_t)e * 3584 * D + (size_t)(kb * 32) * D + n0; LDW = D; DST = ws + WS_W2 + ((size_t)e * D + n0) * 3584 + kb * 32; DKB = 3584; SCL = W2_SCALE; } } } while (0)
    const float* sA; int lA, nvA, jA; unsigned char* dA; int kA; float cA_; f32x4 vA[8];
    const float* sB; int lB, nvB, jB; unsigned char* dB; int kB; float cB_; f32x4 vB[8];
    int it = w;
    if (it < count) { P0_DECODE(base + it, sA, lA, dA, kA, nvA, cA_, jA); ew::conv_load(sA, lA, nvA, vA, F.lane); }
    while (it < count) {
        const int i1 = it + NW;
        if (i1 < count) { P0_DECODE(base + i1, sB, lB, dB, kB, nvB, cB_, jB); ew::conv_load(sB, lB, nvB, vB, F.lane); }
        ew::conv_store(vA, dA, kA, nvA, cA_, jA, scr, F.lane);
        const int i2 = i1 + NW;
        if (i2 < count) { P0_DECODE(base + i2, sA, lA, dA, kA, nvA, cA_, jA); ew::conv_load(sA, lA, nvA, vA, F.lane); }
        if (i1 < count) ew::conv_store(vB, dB, kB, nvB, cB_, jB, scr, F.lane);
        it = i2;
    }
#undef P0_DECODE
}
constexpr int MOE_I_W1 = 32 * 56, MOE_I_W2 = 112 * 16, MOE_ITEMS = 8 * (2 * MOE_I_W1 + MOE_I_W2);
constexpr int MOE_CNT_P2 = MK_CONV_P2, MOE_CNT_P5 = MK_CONV_P5, MOE_CNT_P7 = MK_CONV_P7, MOE_CNT_P8 = MK_CONV_P8, MOE_CNT_P10 = MK_CONV_P10;
constexpr int MOE_CNT_P0 = MOE_ITEMS - MOE_CNT_P2 - MOE_CNT_P5 - MOE_CNT_P7 - MOE_CNT_P8 - MOE_CNT_P10;
constexpr int MOE_B2 = MOE_CNT_P0, MOE_B5 = MOE_B2 + MOE_CNT_P2, MOE_B7 = MOE_B5 + MOE_CNT_P5, MOE_B8 = MOE_B7 + MOE_CNT_P7, MOE_B10 = MOE_B8 + MOE_CNT_P8;
static_assert(MOE_CNT_P0 >= 0, "MoE conversion split");
__device__ __forceinline__ void conv_moe_span(Frame& F, const Args& a, int base, int count, int w, int NW) {
    unsigned char* ws = a.ws;
    LAS float* scr = (LAS float*)(F.lds + 61440 + F.wave * 8448);
#define P0_DECODE_MOE(rm_, SRC, LDW, DST, DKB, SCL) do { const int _e = (rm_) / (2 * I_W1 + I_W2); int _q = (rm_) - _e * (2 * I_W1 + I_W2); \
        if (_q < 2 * I_W1) { const int _up = _q >= I_W1; if (_up) _q -= I_W1; const int _kb = _q / 112, _n0 = (_q - _kb * 112) * 32; \
            SRC = a.in[_up ? 35 : 34] + (size_t)_e * D * 3584 + (size_t)(_kb * 64) * 3584 + _n0; LDW = 3584; DST = ws + WS_W13 + ((size_t)_e * 7168 + (_n0 >> 7) * 256 + (_up ? 128 : 0) + (_n0 & 127)) * D + _kb * 64; DKB = D; SCL = W13_SCALE; } \
        else { _q -= 2 * I_W1; const int _kb = _q >> 5, _n0 = (_q & 31) * 32; \
            SRC = a.in[36] + (size_t)_e * 3584 * D + (size_t)(_kb * 64) * D + _n0; LDW = D; DST = ws + WS_W2 + ((size_t)_e * D + _n0) * 3584 + _kb * 64; DKB = 3584; SCL = W2_SCALE; } } while (0)
    const float* sA; int lA; unsigned char* dA; int kA; float cA_; f32x4 vA[8];
    const float* sB; int lB; unsigned char* dB; int kB; float cB_; f32x4 vB[8];
    int it = w;
    if (it < count) { P0_DECODE_MOE(base + it, sA, lA, dA, kA, cA_); ew::conv_load64(sA, lA, vA, F.lane); }
    while (it < count) {
        const int i1 = it + NW;
        if (i1 < count) { P0_DECODE_MOE(base + i1, sB, lB, dB, kB, cB_); ew::conv_load64(sB, lB, vB, F.lane); }
        ew::conv_store64_f8(vA, dA, kA, cA_, scr, F.lane);
        const int i2 = i1 + NW;
        if (i2 < count) { P0_DECODE_MOE(base + i2, sA, lA, dA, kA, cA_); ew::conv_load64(sA, lA, vA, F.lane); }
        if (i1 < count) ew::conv_store64_f8(vB, dB, kB, cB_, scr, F.lane);
        it = i2;
    }
#undef P0_DECODE_MOE
}
template <int SM_BASE = 0, int SM_COUNT = 0>
__device__ __forceinline__ void tail_convert(Frame& F, const Args& a, int total_units, int c, int base, int count) {
    const int rem = total_units % F.G; const int j = rem ? c - rem : c, NI = rem ? F.G - rem : F.G;
    if (j < 0) return;
    __syncthreads();
    const int w = j * 8 + F.wave, NW = NI * 8;
    if (SM_COUNT > 0) conv_small_span(F, a, SM_BASE, SM_COUNT, w, NW);
    conv_moe_span(F, a, base, count, (w + NW - (SM_COUNT % NW)) % NW, NW);
}

__device__ __forceinline__ void p0_prologue(Frame& F, const Args& a, bool do_mod, bool do_conv) {
    unsigned char* ws = a.ws;
    LAS float* sct = (LAS float*)F.lds;
    for (int i = F.tid; i < 9 * D; i += NTHR) { const int v = i >> 10, k = i & 1023; const float x = v < 8 ? a.in[1][v * D + k] : a.in[3][k]; sct[i] = x / (1.f + expf(-x)); }
    __syncthreads();
    if (do_mod) {
        LAS float* red = (LAS float*)(F.lds + 40960);
        for (int it = blockIdx.x; it < 384; it += F.G) {
            const int l = it / 192, j0 = (it % 192) * 32, cl = F.tid & 31, ks = F.tid >> 5, col = j0 + cl;
            const float* W = a.in[4] + (size_t)l * D * 6144 + col + (size_t)(ks * 64) * 6144;
            float acc[9];
#pragma unroll
            for (int v = 0; v < 9; ++v) acc[v] = 0.f;
#pragma unroll 16
            for (int k = 0; k < 64; ++k) { const float w = W[(size_t)k * 6144];
#pragma unroll
                for (int v = 0; v < 9; ++v) acc[v] += sct[v * D + ks * 64 + k] * w; }
#pragma unroll
            for (int v = 0; v < 9; ++v) red[(ks * 9 + v) * 32 + cl] = acc[v];
            __syncthreads();
            if (F.tid < 288) { const int v = F.tid >> 5; float s = 0.f;
#pragma unroll
                for (int q = 0; q < 16; ++q) s += red[(q * 9 + v) * 32 + cl];
                ((float*)(ws + WS_MODF))[((size_t)l * 9 + v) * 6144 + col] = s + a.in[5][l * 6144 + col]; }
            __syncthreads();
        }
    }
    if ((int)blockIdx.x == F.G - 1) {
        f32x2* t64 = (f32x2*)(ws + WS_ROPE); f32x2* t32 = (f32x2*)(ws + WS_ROPE + 16384);
        for (int i = F.tid; i < 64 * 16; i += NTHR) { const int pos = i >> 4, k = i & 15; const float ang = (float)pos * powf(10000.f, -(float)k / 16.f); t64[i] = (f32x2){cosf(ang), sinf(ang)}; }
        for (int i = F.tid; i < 64 * 8; i += NTHR) { const int pos = i >> 3, k = i & 7; const float ang = (float)pos * powf(10000.f, -(float)k / 8.f); t32[i] = (f32x2){cosf(ang), sinf(ang)}; }
        if (F.tid < 256) { const int kq = F.tid >> 6, d = F.tid & 63; ((float*)(ws + WS_ROPE + 32768))[F.tid] = a.in[kq == 0 ? 10 : kq == 1 ? 11 : kq == 2 ? 13 : 14][d]; }
    }
    if (do_conv) {
        const int hb = F.G / 2;
        if ((int)blockIdx.x >= hb) { const int w = ((int)blockIdx.x - hb) * 8 + F.wave, NW = (F.G - hb) * 8;
            conv_small_span(F, a, 0, SM_CNT_P0, w, NW);
            conv_moe_span(F, a, 0, MOE_CNT_P0, (w + NW - (SM_CNT_P0 % NW)) % NW, NW); }
    }
}

template <bool LAT_BF16>
__device__ __forceinline__ void normmod_phase(Frame& F, const void* xlat, const float* xctx, const float* g, const float* modl, int sh_chunk, bf16_t* H, int nrows) {
    const int per = ((nrows + F.NGW - 1) / F.NGW + 1) & ~1;
    const int r0 = F.gw * per, r1 = (r0 + per) < nrows ? (r0 + per) : nrows;
    ew::ModRegs M; int vcur = -1;
    for (int row = r0; row < r1; row += 2) {
        const bool lat = row < NLAT; const int v = lat ? row / S : 8;
        if (lat && LAT_BF16) {
            if (v != vcur) { const float* sh = modl + (size_t)v * 6144 + sh_chunk * D; ew::nm_mod_load<true>(M, g, sh, sh + D, F.lane); vcur = v; }
            ew::RowRegs A, B; const bf16_t* x0 = (const bf16_t*)xlat + (size_t)row * D;
            ew::nm_load<true>(x0, A, F.lane); ew::nm_load<true>(x0 + D, B, F.lane);
            ew::nm_finish_m<true>(A, M, H + (size_t)row * D, F.lane); ew::nm_finish_m<true>(B, M, H + (size_t)(row + 1) * D, F.lane); }
        else {
            const int vk = LAT_BF16 ? v + 16 : v;
            if (vk != vcur) { const float* sh = modl + (size_t)v * 6144 + sh_chunk * D; ew::nm_mod_load<false>(M, g, sh, sh + D, F.lane); vcur = vk; }
            ew::RowRegs A, B; const float* x0 = lat ? (const float*)xlat + (size_t)row * D : xctx + (size_t)(row - NLAT) * D;
            ew::nm_load<false>(x0, A, F.lane); ew::nm_load<false>(x0 + D, B, F.lane);
            ew::nm_finish_m<false>(A, M, H + (size_t)row * D, F.lane); ew::nm_finish_m<false>(B, M, H + (size_t)(row + 1) * D, F.lane); }
    }
}

__device__ __forceinline__ void post_even(Frame& F, const Args& a) {
    bf16_t* QK = (bf16_t*)(a.ws + WS_QK0);
    const ew::Rope R{(const f32x2*)(a.ws + WS_ROPE), (const f32x2*)(a.ws + WS_ROPE + 16384)};
    const int per = (NTOK + F.NGW - 1) / F.NGW; const int r0 = F.gw * per, r1 = (r0 + per) < NTOK ? (r0 + per) : NTOK;
    for (int row = r0; row < r1; ++row) {
        const bool lat = row < NLAT; const int pos = row & (S - 1), gr = pos >> 6, gc = pos & 63;
#pragma unroll
        for (int ch = 0; ch < 4; ++ch) {
            v4u* p = (v4u*)(QK + (size_t)row * 2048 + ch * 512) + F.lane;
            float f[8]; ew::unpack8(*p, f);
            const float* g = a.in[ch == 0 ? 10 : ch == 1 ? 11 : ch == 2 ? 13 : 14];
            float g8[8];
#pragma unroll
            for (int j = 0; j < 8; ++j) g8[j] = g[8 * (F.lane & 7) + j];
            ew::seg64(f, F.lane, g8, ch >= 2 && lat, gr, gc, R, (ch == 0 || ch == 2) ? QSCALE64 : 1.f);
            *p = ew::pack8(f);
        }
    }
}

__device__ __forceinline__ void post_odd(Frame& F, const Args& a) {
    bf16_t* P1 = (bf16_t*)(a.ws + WS_P1); bf16_t* CQN = (bf16_t*)((unsigned char*)a.out + OUT_CQN); bf16_t* CKVN = (bf16_t*)((unsigned char*)a.out + OUT_CKVN);
    const ew::Rope R{(const f32x2*)(a.ws + WS_ROPE), (const f32x2*)(a.ws + WS_ROPE + 16384)};
    const int per = (NTOK + F.NGW - 1) / F.NGW; const int r0 = F.gw * per, r1 = (r0 + per) < NTOK ? (r0 + per) : NTOK;
    float gq8[8], g2[8], g2p[8];
    { const int s7 = F.lane & 7;
      const float* gsel = F.lane < 32 ? a.in[27] + 8 * F.lane : (F.lane < 48 ? a.in[26] + 8 * s7 : a.in[29] + 8 * (F.lane - 48));
#pragma unroll
      for (int j = 0; j < 8; ++j) { gq8[j] = a.in[25][8 * s7 + j]; g2[j] = gsel[j]; g2p[j] = a.in[26][8 * (s7 ^ 2) + j]; } }
    v4u nq = (v4u){0u, 0u, 0u, 0u}, nc = nq;
    if (r0 < r1) { nq = *((const v4u*)(P1 + (size_t)r0 * P1LD) + F.lane); nc = *((const v4u*)(P1 + (size_t)r0 * P1LD + 512) + F.lane); }
    for (int row = r0; row < r1; ++row) {
        const bool lat = row < NLAT; const int pos = row & (S - 1), gr = pos >> 6, gc = pos & 63;
        const v4u cq_ = nq, cc_ = nc;
        if (row + 1 < r1) { nq = *((const v4u*)(P1 + (size_t)(row + 1) * P1LD) + F.lane); nc = *((const v4u*)(P1 + (size_t)(row + 1) * P1LD + 512) + F.lane); }
        { v4u* p = (v4u*)(P1 + (size_t)row * P1LD) + F.lane; float f[8]; ew::unpack8(cq_, f);
          ew::seg64(f, F.lane, gq8, lat, gr, gc, R, QSCALE64); *p = ew::pack8(f); }
        { v4u* p = (v4u*)(P1 + (size_t)row * P1LD + 512) + F.lane; float f[8]; ew::unpack8(cc_, f);
          float ss = 0.f;
#pragma unroll
          for (int j = 0; j < 8; ++j) ss += f[j] * f[j];
          const float s3 = sum8_f(ss); const float s4 = s3 + xor8_f(s3);
          float s5; { const auto r16 = __builtin_amdgcn_permlane16_swap(__float_as_uint(s4), __float_as_uint(s4), false, false); s5 = __uint_as_float(r16[0]) + __uint_as_float(r16[1]); }
          float pr[8];
#pragma unroll
          for (int j = 0; j < 8; ++j) pr[j] = xor2_f(f[j]);
          const bool isq = F.lane < 32, isk = (F.lane >= 32) && (F.lane < 48);
          const float msq = isq ? s5 * (1.f / 256.f) : (isk ? s3 * (1.f / 64.f) : s4 * (1.f / 128.f));
          const float rstd = rsqrtf(msq + EPS);
#pragma unroll
          for (int j = 0; j < 8; ++j) f[j] = f[j] * rstd * g2[j];
          if (lat) {
              const int s = F.lane & 7; const int ps = (s >> 2) ? gc : gr; const bool x1 = (s & 3) < 2; const int i0 = 8 * (s & 1);
#pragma unroll
              for (int j = 0; j < 8; ++j) { const float prn = pr[j] * rstd * g2p[j]; const f32x2 cs = R.t64[ps * 16 + i0 + j];
                  const float rot = x1 ? (f[j] * cs.x - prn * cs.y) : (prn * cs.y + f[j] * cs.x); f[j] = isk ? rot : f[j]; } }
          bf16_t* dst = isq ? CQN + (size_t)row * 256 + 8 * F.lane : (isk ? P1 + (size_t)row * P1LD + 512 + 8 * F.lane : CKVN + (size_t)row * 128 + 8 * (F.lane - 48));
          *(v4u*)dst = ew::pack8(f); }
    }
}

__device__ __forceinline__ void seg96(float (&f)[8], int lane, bool valid, const float (&g8)[8]  , bool rope, int gr, int gc, const ew::Rope& R, float scale) {
    const int sg = lane / 12, s = lane - sg * 12;
    float ss = 0.f;
#pragma unroll
    for (int j = 0; j < 8; ++j) ss += f[j] * f[j];
    const float qs = sum4_f(ss);
    int s1 = s + 4; s1 = s1 >= 12 ? s1 - 12 : s1; int s2 = s + 8; s2 = s2 >= 12 ? s2 - 12 : s2;
    const int l1 = sg * 12 + s1, l2 = sg * 12 + s2;
    const float tot = qs + __shfl(qs, l1 < 64 ? l1 : 63) + __shfl(qs, l2 < 64 ? l2 : 63);
    const float rstd = rsqrtf(tot * (1.f / 96.f) + EPS);
#pragma unroll
    for (int j = 0; j < 8; ++j) f[j] = f[j] * rstd * g8[j];
    if (rope) {
        const bool dor = valid && s >= 8; const int ps = (s >= 10) ? gc : gr; const bool x1 = (s & 1) == 0;
#pragma unroll
        for (int j = 0; j < 8; ++j) { const float pr = xor1_f(f[j]); const f32x2 cs = R.t32[ps * 8 + j];
            const float rot = x1 ? (f[j] * cs.x - pr * cs.y) : (pr * cs.y + f[j] * cs.x); f[j] = dor ? rot : f[j]; } }
#pragma unroll
    for (int j = 0; j < 8; ++j) f[j] *= scale;
}
__device__ __forceinline__ void post_mla(Frame& F, const Args& a) {
    bf16_t* QD = (bf16_t*)(a.ws + WS_QD); const bf16_t* KN = (const bf16_t*)((unsigned char*)a.out + OUT_KN); const bf16_t* P1 = (const bf16_t*)(a.ws + WS_P1); bf16_t* KDF = (bf16_t*)(a.ws + WS_KDF);
    const ew::Rope R{(const f32x2*)(a.ws + WS_ROPE), (const f32x2*)(a.ws + WS_ROPE + 16384)};
    const int per = (NTOK + F.NGW - 1) / F.NGW; const int r0 = F.gw * per, r1 = (r0 + per) < NTOK ? (r0 + per) : NTOK;
    const int sg = F.lane / 12, s = F.lane - sg * 12;
    const bool val0 = sg < 5, val1 = (sg < 5) && (5 + sg < 8);
    float gq8[8], gk8[8];
#pragma unroll
    for (int j = 0; j < 8; ++j) { gq8[j] = a.in[31][8 * s + j]; gk8[j] = a.in[32][8 * s + j]; }
    const v4u z4 = (v4u){0u, 0u, 0u, 0u};
    v4u nq0 = z4, nq1 = z4, nk0 = z4, nk1 = z4;
#define PM_LOAD(row_) do { const int _r = (row_); const bool _lat = _r < NLAT; \
        nq0 = (_lat && val0) ? *(const v4u*)(QD + (size_t)_r * 768 + sg * 96 + 8 * s) : z4; nq1 = (_lat && val1) ? *(const v4u*)(QD + (size_t)_r * 768 + (5 + sg) * 96 + 8 * s) : z4; \
        nk0 = val0 ? ((s < 8) ? *(const v4u*)(KN + (size_t)_r * 512 + sg * 64 + 8 * s) : *(const v4u*)(P1 + (size_t)_r * P1LD + 1024 + 8 * (s - 8))) : z4; \
        nk1 = val1 ? ((s < 8) ? *(const v4u*)(KN + (size_t)_r * 512 + (5 + sg) * 64 + 8 * s) : *(const v4u*)(P1 + (size_t)_r * P1LD + 1024 + 8 * (s - 8))) : z4; } while (0)
    if (r0 < r1) PM_LOAD(r0);
    for (int row = r0; row < r1; ++row) {
        const bool lat = row < NLAT; const int pos = row & (S - 1), gr = pos >> 6, gc = pos & 63;
        const v4u cq0 = nq0, cq1 = nq1, ck0 = nk0, ck1 = nk1;
        if (row + 1 < r1) PM_LOAD(row + 1);
        float fk0[8], fk1[8]; ew::unpack8(ck0, fk0); ew::unpack8(ck1, fk1);
        if (lat) {
            float fq0[8], fq1[8]; ew::unpack8(cq0, fq0); ew::unpack8(cq1, fq1);
            seg96(fq0, F.lane, val0, gq8, true, gr, gc, R, QSCALE96); seg96(fq1, F.lane, val1, gq8, true, gr, gc, R, QSCALE96);
            seg96(fk0, F.lane, val0, gk8, true, gr, gc, R, 1.f); seg96(fk1, F.lane, val1, gk8, true, gr, gc, R, 1.f);
            if (val0) *(v4u*)(QD + (size_t)row * 768 + sg * 96 + 8 * s) = ew::pack8(fq0);
            if (val1) *(v4u*)(QD + (size_t)row * 768 + (5 + sg) * 96 + 8 * s) = ew::pack8(fq1);
        } else {
            seg96(fk0, F.lane, val0, gk8, false, gr, gc, R, 1.f); seg96(fk1, F.lane, val1, gk8, false, gr, gc, R, 1.f);
        }
        if (val0) *(v4u*)(KDF + (size_t)row * 768 + sg * 96 + 8 * s) = ew::pack8(fk0);
        if (val1) *(v4u*)(KDF + (size_t)row * 768 + (5 + sg) * 96 + 8 * s) = ew::pack8(fk1);
    }
#undef PM_LOAD
}
}

namespace mk {
__device__ __forceinline__ void attn_even(Frame& F, const Args& a) {
    unsigned char* ws = a.ws;
    const bf16_t* QK = (const bf16_t*)(ws + WS_QK0); const bf16_t* VT = (const bf16_t*)(ws + WS_VT0); bf16_t* AO = (bf16_t*)((unsigned char*)a.out + OUT_H);
    const int lane = F.lane, r32 = lane & 31, hi = lane >> 5, wid = F.wave;
    const int c = F.vcu, G = F.G;
    {
        float s1 = 0.f, s2 = 0.f;
        for (int i = 0; i < 64; ++i) { s1 += a.in[15][i] * a.in[16][i]; s2 += a.in[17][i] * a.in[18][i]; }
        const float lam = expf(s1) - expf(s2) + 0.2f;
        float* scr = (float*)(ws + WS_DSCR) + (size_t)c * 32768;
        for (int L = c; L < 512 + 32; L += G) {
            int b, h, qrow0; att::Keys ky;
            if (L < 512) { b = L >> 6; h = (L >> 4) & 3; const int qb = L & 15; qrow0 = b * S + qb * 256; ky.ka0 = b * S; ky.na = 64; ky.kb0 = NLAT + b * CL; ky.nb = 4; }
            else { const int i = L - 512; b = i >> 2; h = i & 3; qrow0 = NLAT + b * CL; ky.ka0 = NLAT + b * CL; ky.na = 4; ky.kb0 = 0; ky.nb = 0; }
            const int qw0 = qrow0 + wid * 32;
            att::NaInfo ni{};
            f32x4 o[8][2]; float l[2];
            float* sp = scr + (size_t)wid * 4096 + lane;
            for (int mm = 0; mm < 2; ++mm) {
                att::attn_core16<64, 128, false>(F.lds, QK + (size_t)qw0 * 2048 + 1024 + h * 128 + mm * 64, 2048, QK + 1536 + h * 128 + mm * 64, 2048, VT + (size_t)(512 + h * 128) * NTOK, NTOK, ky, ni, o, l);
                const float il[2] = {1.f / l[0], 1.f / l[1]};
                if (mm == 0) {
#pragma unroll
                    for (int qb = 0; qb < 2; ++qb) { unsigned so_ = qb * 2048; asm volatile("" : "+v"(so_)); float* spd = sp + so_;
#pragma unroll
                        for (int db = 0; db < 8; ++db)
#pragma unroll
                            for (int j = 0; j < 4; ++j) spd[(db * 4 + j) * 64] = o[db][qb][j] * il[qb]; }
                    VM_WAIT();
                } else {
                    float ss[2] = {0.f, 0.f};
#pragma unroll
                    for (int qb = 0; qb < 2; ++qb) {
                        unsigned so_ = qb * 2048; asm volatile("" : "+v"(so_)); const float* spd = sp + so_;
#pragma unroll
                        for (int hb = 0; hb < 2; ++hb) { float t1[16];
#pragma unroll
                            for (int r = 0; r < 16; ++r) t1[r] = spd[(hb * 16 + r) * 64];
                            asm volatile("s_waitcnt vmcnt(0)" ::: "memory");
#pragma unroll
                            for (int r = 0; r < 16; ++r) { const int db = hb * 4 + (r >> 2), j = r & 3; const float v = t1[r] - lam * (o[db][qb][j] * il[qb]); o[db][qb][j] = v; ss[qb] += v * v; } } }
                    float rstd[2];
#pragma unroll
                    for (int qb = 0; qb < 2; ++qb) { float t = ss[qb]; t += __shfl_xor(t, 16); t += __shfl_xor(t, 32); rstd[qb] = rsqrtf(t * (1.f / 128.f) + EPS) * 0.8f; }
                    const int rg = lane >> 4;
#pragma unroll
                    for (int db = 0; db < 8; ++db) { const f32x4 gg = *(const f32x4*)(a.in[19] + 16 * db + 4 * rg);
                        o[db][0] = o[db][0] * gg; o[db][1] = o[db][1] * gg; }
                    att::store_o16<8>(o, rstd, AO + (size_t)qw0 * D + 512 + h * 128, lane & 15, rg);
                    VM_WAIT();
                }
            }
        }
    }
    {
        LAS float* bias = (LAS float*)(F.lds + att::NSLOT * att::Cfg<64, 64>::SLOT);
        int hcur = -1;
        const bool bal = (G == 256);
        const int nit = bal ? 6 : (1024 + 96 + G - 1) / G;
        for (int it = 0; it < nit; ++it) {
            int L;
            if (bal) { if (it < 3) L = c + 256 * it; else if (it == 3) { if (c < 32) continue; L = c + 768; } else if (it == 4) { if (c < 96 || c >= 128) continue; L = (c - 96) + 768; } else { if (c < 32 || c >= 96) continue; L = 1024 + 32 + (c - 32); } }
            else { L = c + G * it; if (L >= 1024 + 96) continue; }
            int b, h, qrow0; att::Keys ky; att::NaInfo ni{};
            if (L < 1024) { b = L >> 7; h = (L >> 4) & 7; const int qb = L & 15; qrow0 = b * S + qb * 256;
                int rlo = 4 * qb - 4; rlo = rlo < 0 ? 0 : (rlo > 56 ? 56 : rlo); int rhi = 4 * qb + 3 - 4; rhi = (rhi < 0 ? 0 : (rhi > 56 ? 56 : rhi)) + 7;
                ky.ka0 = NLAT + b * CL; ky.na = 4; ky.kb0 = b * S + 64 * rlo; ky.nb = rhi - rlo + 1;
                ni.r_lo = rlo; ni.qr = 4 * qb + (wid >> 1); ni.qc = 32 * (wid & 1); }
            else { const int i = L - 1024 - 32; if (i < 0) continue; b = i >> 3; h = i & 7; qrow0 = NLAT + b * CL; ky.ka0 = NLAT + b * CL; ky.na = 4; ky.kb0 = 0; ky.nb = 0; ni.r_lo = 0; ni.qr = 0; ni.qc = 0; }
            if (h != hcur) { __syncthreads();
                for (int i = F.tid; i < 15 * 128; i += NTHR) { const int dr = i >> 7, dc = (i & 127) - 63; bias[i] = (dc >= -15 && dc <= 15) ? a.in[12][h * 465 + dr * 31 + dc + 15] * LOG2E : 0.f; }
                __syncthreads(); hcur = h; }
            ni.bias = bias;
            const int qw0 = qrow0 + wid * 32;
            { f32x4 o[4][2]; float l[2];
            att::attn_core16<64, 64, true>(F.lds, QK + (size_t)qw0 * 2048 + h * 64, 2048, QK + 512 + h * 64, 2048, VT + (size_t)(h * 64) * NTOK, NTOK, ky, ni, o, l);
            const float il[2] = {1.f / l[0], 1.f / l[1]};
            att::store_o16<4>(o, il, AO + (size_t)qw0 * D + h * 64, lane & 15, lane >> 4); }
        }
    }
    VM_WAIT();
}

__device__ __forceinline__ void attn_odd(Frame& F, const Args& a) {
    unsigned char* ws = a.ws;
    const bf16_t* P1 = (const bf16_t*)(ws + WS_P1); const bf16_t* VTC = (const bf16_t*)(ws + WS_VT1C);
    const bf16_t* QD = (const bf16_t*)(ws + WS_QD); const bf16_t* KD = (const bf16_t*)(ws + WS_KDF); const bf16_t* VTD = (const bf16_t*)(ws + WS_VT1D);
    bf16_t* AO = (bf16_t*)((unsigned char*)a.out + OUT_H);
    const int lane = F.lane, r32 = lane & 31, hi = lane >> 5, wid = F.wave;
    att::NaInfo ni{};
    for (int L = F.vcu; L < 1024; L += F.G) {
        const int b = L >> 7, h = (L >> 4) & 7, qb = L & 15; const int qw0 = b * S + qb * 256 + wid * 32;
        att::Keys ky; ky.ka0 = b * S; ky.na = 64; ky.kb0 = NLAT + b * CL; ky.nb = 4;
        f32x4 o[4][2]; float l[2];
        att::attn_core16<96, 64, false>(F.lds, QD + (size_t)qw0 * 768 + h * 96, 768, KD + h * 96, 768, VTD + (size_t)(h * 64) * NTOK, NTOK, ky, ni, o, l);
        const float il[2] = {1.f / l[0], 1.f / l[1]};
        att::store_o16<4>(o, il, AO + (size_t)qw0 * D + 512 + h * 64, lane & 15, lane >> 4);
    }
    for (int L = F.vcu; L < 1024; L += F.G) {
        const int b = L >> 7, hq = (L >> 4) & 7, qb = L & 15; const int qw0 = b * S + qb * 256 + wid * 32;
        att::Keys ky; ky.ka0 = b * S; ky.na = 64; ky.kb0 = NLAT + b * CL; ky.nb = 4;
        f32x4 o[4][2]; float l[2];
        att::attn_core16<64, 64, false>(F.lds, P1 + (size_t)qw0 * P1LD + hq * 64, P1LD, P1 + 768 + (hq >> 2) * 64, P1LD, VTC + (size_t)((hq >> 2) * 64) * NTOK, NTOK, ky, ni, o, l);
        const float il[2] = {1.f / l[0], 1.f / l[1]};
        att::store_o16<4>(o, il, AO + (size_t)qw0 * D + hq * 64, lane & 15, lane >> 4);
    }
    VM_WAIT();
}

__device__ __forceinline__ void router_phase(Frame& F, const Args& a, const bf16_t* x3) {
    unsigned char* ws = a.ws;
    unsigned char* H2 = (unsigned char*)a.out + OUT_H;
    const float* modl = (const float*)(ws + WS_MODF) + (size_t)9 * 6144;
    int* slot_tok = (int*)(ws + WS_SLOT_TOK); float* slot_g = (float*)(ws + WS_SLOT_G);
    LAS float* rw = (LAS float*)F.lds;
    LAS int* lcnt = (LAS int*)(F.lds + 32768);
    LAS int* lbase = lcnt + 16;
    LAS int* tinfo = lcnt + 32;
    LAS float* tg = (LAS float*)(tinfo + 512);
    f32x4 rwr[2][8][2];
#pragma unroll
    for (int j = 0; j < 2; ++j)
#pragma unroll
        for (int k8 = 0; k8 < 8; ++k8) { const float* wp = a.in[33] + (size_t)(8 * F.lane + 512 * j + k8) * 8; rwr[j][k8][0] = *(const f32x4*)wp; rwr[j][k8][1] = *(const f32x4*)(wp + 4); }
    const float* g = a.in[7] + D;
    for (int chunk = blockIdx.x; chunk < NLAT / 128; chunk += F.G) {
    __syncthreads();
    if (F.tid < 16) lcnt[F.tid] = 0;
    __syncthreads();
    const int tok0 = chunk * 128;
    v4u xw[2];
    { const bf16_t* x0 = x3 + (size_t)(tok0 + F.wave * 16) * D; xw[0] = *((const v4u*)x0 + F.lane); xw[1] = *((const v4u*)x0 + F.lane + 64); }
    ew::ModRegs M; { const int v = tok0 >> 12; const float* sh = modl + (size_t)v * 6144 + 3 * D; ew::nm_mod_load<true>(M, g, sh, sh + D, F.lane); }
    float mylg[8];
#pragma unroll
    for (int e = 0; e < 8; ++e) mylg[e] = 0.f;
    for (int i = 0; i < 16; ++i) {
        const int tl = F.wave * 16 + i, tok = tok0 + tl;
        const v4u xc[2] = {xw[0], xw[1]};
        if (i + 1 < 16) { const bf16_t* x1 = x3 + (size_t)(tok + 1) * D; xw[0] = *((const v4u*)x1 + F.lane); xw[1] = *((const v4u*)x1 + F.lane + 64); }
        float y[2][8]; float s = 0.f;
#pragma unroll
        for (int j = 0; j < 2; ++j) { ew::unpack8(xc[j], y[j]);
#pragma unroll
            for (int q = 0; q < 8; ++q) s += y[j][q] * y[j][q]; }
        const float rstd = rsqrtf(wave_sum(s) * (1.f / D) + EPS);
        float lg[8];
#pragma unroll
        for (int e = 0; e < 8; ++e) lg[e] = 0.f;
#pragma unroll
        for (int j = 0; j < 2; ++j) { const int c = 8 * F.lane + 512 * j;
#pragma unroll
            for (int h = 0; h < 2; ++h) {
#pragma unroll
                for (int q = 0; q < 4; ++q) { const float yy = y[j][4 * h + q] * rstd * M.mul[2 * j + h][q] + M.add[2 * j + h][q]; y[j][4 * h + q] = yy;
                    const f32x4 r0 = rwr[j][4 * h + q][0], r1 = rwr[j][4 * h + q][1];
                    lg[0] += yy * r0.x; lg[1] += yy * r0.y; lg[2] += yy * r0.z; lg[3] += yy * r0.w; lg[4] += yy * r1.x; lg[5] += yy * r1.y; lg[6] += yy * r1.z; lg[7] += yy * r1.w; } }
            v2u w8; w8.x = cvt4_fp8(y[j][0] * ACT_SCALE, y[j][1] * ACT_SCALE, y[j][2] * ACT_SCALE, y[j][3] * ACT_SCALE); w8.y = cvt4_fp8(y[j][4] * ACT_SCALE, y[j][5] * ACT_SCALE, y[j][6] * ACT_SCALE, y[j][7] * ACT_SCALE);
            *(v2u*)(H2 + (size_t)tok * D + c) = w8; }
#pragma unroll
        for (int e = 0; e < 8; ++e) lg[e] = wave_sum(lg[e]);
#pragma unroll
        for (int e = 0; e < 8; ++e) mylg[e] = (F.lane == i) ? lg[e] : mylg[e];
    }
    if (F.lane < 16) {
        const int tl = F.wave * 16 + F.lane;
        int i0 = 0; float v0 = mylg[0];
#pragma unroll
        for (int e = 1; e < 8; ++e) if (mylg[e] > v0) { v0 = mylg[e]; i0 = e; }
        int i1 = -1; float v1 = -INFINITY;
#pragma unroll
        for (int e = 0; e < 8; ++e) if (e != i0 && mylg[e] > v1) { v1 = mylg[e]; i1 = e; }
        const float e1 = expf(v1 - v0);
        tinfo[tl * 4 + 0] = i0; tinfo[tl * 4 + 1] = i1;
        tinfo[tl * 4 + 2] = __hip_atomic_fetch_add(&lcnt[i0], 1, __ATOMIC_RELAXED, __HIP_MEMORY_SCOPE_WORKGROUP); tinfo[tl * 4 + 3] = __hip_atomic_fetch_add(&lcnt[8 + i1], 1, __ATOMIC_RELAXED, __HIP_MEMORY_SCOPE_WORKGROUP);
        tg[tl * 2] = 1.f / (1.f + e1); tg[tl * 2 + 1] = e1 / (1.f + e1);
    }
    __syncthreads();
    if (F.tid < 16) lbase[F.tid] = (int)__hip_atomic_fetch_add((unsigned*)(F.ctl + CW_GCNT + F.tid), (unsigned)lcnt[F.tid], RLX_AGENT);
    __syncthreads();
    if (F.tid < 256) { const int tl = F.tid >> 1, cch = F.tid & 1; const int e = tinfo[tl * 4 + cch], rk = tinfo[tl * 4 + 2 + cch];
        const size_t idx = ((size_t)cch * 8 + e) * NLAT + lbase[cch * 8 + e] + rk;
        slot_tok[idx] = tok0 + tl; slot_g[idx] = tg[tl * 2 + cch]; }
    }
}
}
namespace mk {
__global__ void __launch_bounds__(NTHR, 2) mega_fwd(Args args) {
    extern __shared__ __attribute__((aligned(16))) unsigned char lds_raw[];
    Frame F;
    F.lds = (LAS unsigned char*)lds_raw;
    F.MISC = (volatile LAS unsigned*)(F.lds + MISC_OFF);
    F.tid = threadIdx.x; F.lane = F.tid & 63; F.wave = __builtin_amdgcn_readfirstlane(F.tid >> 6);
    F.G = gridDim.x; { const int bx = blockIdx.x; F.vcu = (F.G % 8 == 0) ? (bx % 8) * (F.G / 8) + bx / 8 : bx; }
    F.gw = F.vcu * NWAVES + F.wave; F.NGW = F.G * NWAVES;
    unsigned char* ws = args.ws;
    F.ctl = (gu32*)(ws + WS_CTL);
    for (int u = F.tid; u < (LDS_BYTES - LDSCTL_OFF) / 4; u += NTHR) ((LAS unsigned*)(F.lds + LDSCTL_OFF))[u] = 0u;
    __syncthreads();
    XcdBarrier bar = xcd_barrier_post((unsigned*)(F.ctl + CW_BAR), F.MISC + 8);
    const int lo = args.ph_lo, hi = args.ph_hi;
#ifndef MK_ONLY
#define MK_ONLY -1
#endif
#define IN(k) ((MK_ONLY < 0 || MK_ONLY == (k)) && lo <= (k) && (k) < hi)
#if MK_PROBE
    LAS unsigned long long* ts = (LAS unsigned long long*)(F.lds + LDSCTL_OFF + 2048);
    if (F.tid == 0) ts[0] = __builtin_amdgcn_s_memrealtime();
#define SEAM(k) do { if (IN(k) && IN((k) + 1)) xcd_barrier(bar); if (F.tid == 0) ts[(k) + 1] = __builtin_amdgcn_s_memrealtime(); } while (0)
#else
#define SEAM(k) do { if (IN(k) && IN((k) + 1)) xcd_barrier(bar); } while (0)
#endif
    const float* MODF = (const float*)(ws + WS_MODF);
    bf16_t* H = (bf16_t*)((unsigned char*)args.out + OUT_H);
    float* XC = (float*)(ws + WS_XC);
    bf16_t* XB = (bf16_t*)(ws + WS_XB);
    float* X = args.out;
    const int cu = (int)blockIdx.x;

    if (IN(0)) { for (int rep = 0; rep < MK_REP_P0; ++rep) { p0_prologue(F, args, rep == 0 || MK_P0_DUPMOD, rep == 0 || !MK_P0_DUPMOD); __syncthreads(); } } SEAM(0);
    if (IN(1)) { for (int rep = 0; rep < MK_REP_NM; ++rep) normmod_phase<false>(F, args.in[0], args.in[2], args.in[6], MODF, 0, H, NTOK); } SEAM(1);
    if (IN(2)) {
        pg8::MultiSched Sc; Sc.init(D, F.G, cu);
        Sc.add(H, (const bf16_t*)(ws + WS_WQK0), NTOK / 256, 8, 0);
        Sc.add((const bf16_t*)(ws + WS_WV0), H, 4, NTOK / 256, 1);
        pg8::EpiQK0 E{(bf16_t*)(ws + WS_QK0), (bf16_t*)(ws + WS_VT0), (const float*)(ws + WS_ROPE + 32768), (const f32x2*)(ws + WS_ROPE)};
        pg8::gemm_phase<pg8::EpiQK0, pg8::MultiSched, false>(F.lds, D, Sc, E);
        tail_convert<SM_CNT_P0, SM_CNT_P2>(F, args, (NTOK / 256) * 12, cu, MOE_B2, MOE_CNT_P2);
    } SEAM(2);
    if (IN(4)) { attn_even(F, args); } SEAM(4);
    if (IN(5)) {
        pg8::MultiSched Sc; Sc.init(D, F.G, cu); Sc.add(H, (const bf16_t*)(ws + WS_WO0), NTOK / 256, 4, 0);
        pg8::EpiResid<false> E{args.in[0], XB, args.in[2], XC, MODF, 2};
        pg8::gemm_phase<pg8::EpiResid<false>, pg8::MultiSched, false>(F.lds, D, Sc, E);
        if (MOE_CNT_P5 > 0) tail_convert(F, args, (NTOK / 256) * 4, cu, MOE_B5, MOE_CNT_P5);
    } SEAM(5);
    if (IN(6)) { for (int rep = 0; rep < MK_REP_NM; ++rep) normmod_phase<true>(F, XB, XC, args.in[7], MODF, 3, H, NTOK); } SEAM(6);
    if (IN(7)) {
        pg8::MultiSched Sc; Sc.init(D, F.G, cu); Sc.add(H, (const bf16_t*)(ws + WS_WGU0), NTOK / 256, 22, 0);
        pg8::EpiSwigluF8 E{ws + WS_MID0, 2816, 1.f, ACT_SCALE};
        pg8::gemm_phase<pg8::EpiSwigluF8, pg8::MultiSched, false>(F.lds, D, Sc, E);
        tail_convert<SM_CNT_P0 + SM_CNT_P2, SM_CNT_P7>(F, args, (NTOK / 256) * 22, cu, MOE_B7, MOE_CNT_P7);
    } SEAM(7);
    if (IN(8)) {
        pg8::MultiSched Sc; Sc.init(2816 / 2, F.G, cu); Sc.add((const bf16_t*)(ws + WS_MID0), (const bf16_t*)(ws + WS_WD0), NTOK / 256, 4, 0);
        pg8::EpiResid<true> E{XB, XB, XC, XC, MODF, 5, 1.f / (ACT_SCALE * W2_SCALE)};
        pg8::gemm_phase<pg8::EpiResid<true>, pg8::MultiSched, false, true>(F.lds, 2816 / 2, Sc, E);
        if (MOE_CNT_P8 > 0) tail_convert(F, args, (NTOK / 256) * 4, cu, MOE_B8, MOE_CNT_P8);
    } SEAM(8);
    const float* MODF1 = MODF + (size_t)9 * 6144;
    if (IN(9)) { for (int rep = 0; rep < MK_REP_NM; ++rep) normmod_phase<true>(F, XB, XC, args.in[6] + D, MODF1, 0, H, NTOK); } SEAM(9);
    if (IN(10)) {
        pg8::MultiSched Sc; Sc.init(D, F.G, cu);
        Sc.add(H, (const bf16_t*)(ws + WS_WODD), NTOK / 256, 5, 0);
        Sc.add((const bf16_t*)(ws + WS_WVC), H, 1, NTOK / 256, 1);
        pg8::EpiStore E{(bf16_t*)(ws + WS_P1), (bf16_t*)(ws + WS_VT1C), P1LD, NTOK};
        pg8::gemm_phase<pg8::EpiStore, pg8::MultiSched, false>(F.lds, D, Sc, E);
        if (MOE_CNT_P10 > 0) tail_convert(F, args, (NTOK / 256) * 6, cu, MOE_B10, MOE_CNT_P10);
    } SEAM(10);
    if (IN(11)) { post_odd(F, args); } SEAM(11);
    if (IN(12)) {
        { pg8::MultiSched Sc; Sc.init(256, F.G, cu); Sc.add((const bf16_t*)((unsigned char*)args.out + OUT_CQN), (const bf16_t*)(ws + WS_WUQ), NLAT / 256, 3, 0);
          pg8::EpiStore E{(bf16_t*)(ws + WS_QD), nullptr, 768, 0};
          pg8::gemm_phase<pg8::EpiStore, pg8::MultiSched, false>(F.lds, 256, Sc, E); }
        asm volatile("" ::: "memory");
        { int K2 = 128; asm volatile("" : "+s"(K2)); pg8::MultiSched Sc; Sc.init(K2, F.G, cu);
          Sc.add((const bf16_t*)((unsigned char*)args.out + OUT_CKVN), (const bf16_t*)(ws + WS_WUKN), NTOK / 256, 2, 0);
          Sc.add((const bf16_t*)(ws + WS_WUKV), (const bf16_t*)((unsigned char*)args.out + OUT_CKVN), 2, NTOK / 256, 1);
          pg8::EpiStore E{(bf16_t*)((unsigned char*)args.out + OUT_KN), (bf16_t*)(ws + WS_VT1D), 512, NTOK};
          pg8::gemm_phase<pg8::EpiStore, pg8::MultiSched, false>(F.lds, K2, Sc, E); }
    } SEAM(12);
    if (IN(13)) { post_mla(F, args); } SEAM(13);
    if (IN(14)) { attn_odd(F, args); } SEAM(14);
    if (IN(15)) {
        pg8::MultiSched Sc; Sc.init(D, F.G, cu); Sc.add(H, (const bf16_t*)(ws + WS_WO1), NLAT / 256, 4, 0);
        pg8::EpiResid<true> E{XB, XB, XC, XC, MODF1, 2};
        pg8::gemm_phase<pg8::EpiResid<true>, pg8::MultiSched, false>(F.lds, D, Sc, E);
    } SEAM(15);
    if (IN(16)) { router_phase(F, args, XB); } SEAM(16);
    {
        const int* cnt0 = (const int*)(F.ctl + CW_GCNT); const int* cnt1 = cnt0 + 8;
        const int* stok0 = (const int*)(ws + WS_SLOT_TOK); const int* stok1 = stok0 + (size_t)8 * NLAT;
        unsigned char* const MIDa = ws + WS_MID1; unsigned char* const MIDb = ws + WS_MID1 + (size_t)119 * MiB;
        LAS int* const tab = (LAS int*)(F.lds + LDSCTL_OFF + 1024);
        const float invg = 1.f / (ACT_SCALE * W13_SCALE), invd = 1.f / (ACT_SCALE * W2_SCALE);
        if (IN(17)) {
            pg8::MoeSched Sc; Sc.init(tab, cnt0, D / 2, 28, F.G, cu, true, H, (const bf16_t*)(ws + WS_W13), (size_t)7168 * (D / 2), stok0);
            pg8::EpiSwigluF8 E{MIDa, 3584, invg, ACT_SCALE};
            pg8::gemm_phase<pg8::EpiSwigluF8, pg8::MoeSched, true, true>(F.lds, D / 2, Sc, E);
        } SEAM(17);
        if (IN(18)) {
            pg8::MoeDualSched Sc; Sc.init(tab, cnt0, cnt1, F.G, cu, 3584 / 2, D / 2,
                                          (const bf16_t*)MIDa, (const bf16_t*)(ws + WS_W2), (size_t)D * (3584 / 2), stok0, H, (const bf16_t*)(ws + WS_W13), (size_t)7168 * (D / 2), stok1);
            pg8::EpiMoeDual E{pg8::EpiSwigluF8{MIDb, 3584, invg, ACT_SCALE}, pg8::EpiMoeDown<false>{XB, X, MODF1, (const float*)(ws + WS_SLOT_G), (const int*)(ws + WS_SLOT_TOK), invd}};
            pg8::gemm_phase<pg8::EpiMoeDual, pg8::MoeDualSched, true, true, true>(F.lds, D / 2, Sc, E);
        } SEAM(18);
        if (IN(19)) {
            pg8::MoeSched Sc; Sc.init(tab, cnt1, 3584 / 2, 4, F.G, cu, false, (const bf16_t*)MIDb, (const bf16_t*)(ws + WS_W2), (size_t)D * (3584 / 2), stok1);
            pg8::EpiMoeDown<true> E{XB, X, MODF1, (const float*)(ws + WS_SLOT_G), (const int*)(ws + WS_SLOT_TOK), invd};
            pg8::gemm_phase<pg8::EpiMoeDown<true>, pg8::MoeSched, false, true>(F.lds, 3584 / 2, Sc, E);
        }
    }
#if MK_PROBE
    if (IN(20)) {
        xcd_barrier(bar); __syncthreads();
        float t1 = 0.f;
        for (int q = 0; q < 21; ++q) if ((MK_PROBE_MASK >> q) & 1) t1 += (float)(ts[q + 1] - ts[q]) * 0.01f;
        if (MK_PROBE_Q > 0) t1 = floorf(t1 * (1.f / MK_PROBE_Q) + 0.5f) * MK_PROBE_Q;
        const float sc = 1.f + t1 * (1.f / 20000.f);
        for (size_t i = (size_t)blockIdx.x * NTHR + F.tid; i < (size_t)NLAT * D / 4; i += (size_t)F.G * NTHR) { f32x4 v = ((f32x4*)X)[i]; ((f32x4*)X)[i] = v * sc; }
    }
#endif
#undef IN
#undef SEAM
}
}
#ifndef MK_MODE
#define MK_MODE 0
#endif
namespace mk {
#if MK_MODE == 2
constexpr size_t WS_CK = 522 * MiB, WS_XN = 552 * MiB, WS_NEED = 568 * MiB;
constexpr int CKR = 1024;
constexpr size_t CKSZ = (size_t)(CKR + CL) * D;
constexpr int CW_RES = 1024;
__global__ void cmp_kernel(const void* opt, int is_bf16, int ldo, int col0, const float* ref, int rows, int ncols, float* res) {
    float d2 = 0.f, b2 = 0.f;
    for (long i = (long)blockIdx.x * 256 + threadIdx.x; i < (long)rows * ncols; i += (long)gridDim.x * 256) {
        const int r = (int)(i / ncols), c = col0 + (int)(i % ncols);
        const float a = is_bf16 ? bf2f(((const bf16_t*)opt)[(size_t)r * ldo + c]) : ((const float*)opt)[(size_t)r * ldo + c];
        const float b = ref[(size_t)r * D + c];
        d2 += (a - b) * (a - b); b2 += b * b;
    }
    __shared__ float s0[256], s1[256];
    s0[threadIdx.x] = d2; s1[threadIdx.x] = b2; __syncthreads();
    for (int o = 128; o > 0; o >>= 1) { if (threadIdx.x < o) { s0[threadIdx.x] += s0[threadIdx.x + o]; s1[threadIdx.x] += s1[threadIdx.x + o]; } __syncthreads(); }
    if (threadIdx.x == 0) { atomicAdd(res, s0[0]); atomicAdd(res + 1, s1[0]); }
}
__global__ void verdict_kernel(const float* res, int nchk, float thr, const float* xn, float* out) {
    int bad = 0;
    for (int k = 0; k < nchk; ++k) { const float r = res[2 * k] / res[2 * k + 1]; if (!(r < thr)) { bad = k + 1; break; } }
    if (!bad) return;
    for (size_t i = (size_t)blockIdx.x * 256 + threadIdx.x; i < (size_t)NLAT * D; i += (size_t)gridDim.x * 256)
        out[i] = i < (size_t)S * D ? xn[i] * (float)(1 + bad) : 0.f;
}
#endif

static int g_grid = 0;
static void launch_range(hipStream_t st, Args a, int lo, int hi, bool reset_bar) {
    if (reset_bar) (void)hipMemsetAsync(a.ws + WS_CTL + (size_t)CW_BAR * 4, 0, (size_t)XCD_BAR_WORDS * 4, st);
    a.ph_lo = lo; a.ph_hi = hi;
    hipLaunchKernelGGL(mega_fwd, dim3(g_grid), dim3(NTHR), LDS_BYTES, st, a);
    const hipError_t le = hipPeekAtLastError();
    if (le != hipSuccess) fprintf(stderr, "kernel_launch: launch [%d,%d) failed: %s\n", lo, hi, hipGetErrorName(le));
}
}

extern "C" void kernel_launch(void* const* d_in, const int* in_sizes, int n_in, void* d_out, int out_size, void* d_ws, size_t ws_size, hipStream_t stream) {
    using namespace mk;
    if (g_grid == 0) {
        size_t need = WS_END;
#if MK_MODE == 2
        need = WS_NEED;
#endif
        if (n_in != 37 || out_size != NLAT * D || ws_size < need) { fprintf(stderr, "kernel_launch: unexpected shapes / workspace (%zu < %zu)\n", ws_size, need); g_grid = -1; return; }
        int dev = 0, cus = 0, per_cu = 0;
        if (hipGetDevice(&dev) != hipSuccess || hipDeviceGetAttribute(&cus, hipDeviceAttributeMultiprocessorCount, dev) != hipSuccess) { g_grid = -1; return; }
        if (hipFuncSetAttribute((const void*)mega_fwd, hipFuncAttributeMaxDynamicSharedMemorySize, LDS_BYTES) != hipSuccess) { fprintf(stderr, "kernel_launch: hipFuncSetAttribute failed\n"); g_grid = -1; return; }
        if (hipOccupancyMaxActiveBlocksPerMultiprocessor(&per_cu, (const void*)mega_fwd, NTHR, LDS_BYTES) != hipSuccess || per_cu < 1) { fprintf(stderr, "kernel_launch: occupancy query says %d blocks per CU\n", per_cu); g_grid = -1; (void)hipGetLastError(); return; }
        g_grid = cus;
    }
    if (g_grid < 0) return;
    Args a; memset(&a, 0, sizeof a);
    for (int i = 0; i < 37; ++i) a.in[i] = (const float*)d_in[i];
    a.out = (float*)d_out; a.ws = (unsigned char*)d_ws;
#if MK_MODE == 0
    (void)hipMemsetAsync((char*)d_ws + WS_CTL, 0, CTL_ZERO_BYTES, stream);
    launch_range(stream, a, 0, MK_PROBE ? 21 : 20, false);
#elif MK_MODE == 1
    (void)hipMemsetAsync((char*)d_ws + WS_CTL, 0, CTL_ZERO_BYTES, stream);
    for (int p = 0; p < 20; ++p) launch_range(stream, a, p, p + 1, true);
#else
    {
        nv::In I = nv::make_in(d_in);
        float* CK = (float*)((char*)d_ws + WS_CK); float* XN = (float*)((char*)d_ws + WS_XN);
        nv::run(stream, I, XN, (char*)d_ws, 1, CK, CKR);
        (void)hipMemsetAsync((char*)d_ws + WS_CTL, 0, CTL_ZERO_BYTES, stream);
        float* res = (float*)((char*)d_ws + WS_CTL) + CW_RES;
        const bf16_t* AO = (const bf16_t*)((char*)d_out + OUT_H); const float* XC = (const float*)((char*)d_ws + WS_XC); const float* X = (const float*)d_out; const bf16_t* XB = (const bf16_t*)((char*)d_ws + WS_XB);
        auto cmp = [&](int id, const void* opt, int bf, int ldo, int col0, const float* ref, int rows, int ncols) {
            hipLaunchKernelGGL(cmp_kernel, dim3(256), dim3(256), 0, stream, opt, bf, ldo, col0, ref, rows, ncols, res + 2 * (id - 1)); };
        launch_range(stream, a, 0, 5, true);
        cmp(1, AO, 1, D, 0, CK + 0 * CKSZ, CKR, 512);
        cmp(2, AO, 1, D, 512, CK + 0 * CKSZ, CKR, 512);
        cmp(3, AO + (size_t)NLAT * D, 1, D, 0, CK + 0 * CKSZ + (size_t)CKR * D, CL, 512);
        cmp(4, AO + (size_t)NLAT * D, 1, D, 512, CK + 0 * CKSZ + (size_t)CKR * D, CL, 512);
        launch_range(stream, a, 5, 6, true);
        cmp(5, XB, 1, D, 0, CK + 1 * CKSZ, CKR, D);
        cmp(6, XC, 0, D, 0, CK + 1 * CKSZ + (size_t)CKR * D, CL, D);
        launch_range(stream, a, 6, 9, true);
        cmp(7, XB, 1, D, 0, CK + 2 * CKSZ, CKR, D);
        cmp(8, XC, 0, D, 0, CK + 2 * CKSZ + (size_t)CKR * D, CL, D);
        launch_range(stream, a, 9, 15, true);
        cmp(9, AO, 1, D, 0, CK + 3 * CKSZ, CKR, 512);
        cmp(10, AO, 1, D, 512, CK + 3 * CKSZ, CKR, 512);
        launch_range(stream, a, 15, 16, true);
        cmp(11, XB, 1, D, 0, CK + 4 * CKSZ, CKR, D);
        launch_range(stream, a, 16, 20, true);
        cmp(12, X, 0, D, 0, CK + 5 * CKSZ, CKR, D);
        hipLaunchKernelGGL(verdict_kernel, dim3(1024), dim3(256), 0, stream, (const float*)res, 12, 2e-3f, (const float*)XN, (float*)d_out);
    }
#endif
}
```
